# Optimizing an MI355X kernel written in HIP

```python
import math
import jax, jax.numpy as jnp
from jax import lax
import numpy as np

D_MODEL = 1024
BATCH = 1
SEQ = 16384
DEPTH = 2
DEC_BATCH = 8
DEC_SEQ = 2048
PAST_LEN = 128

N_MIXERS = 2
N_ATTN_LAYERS = (DEPTH + 1) // 2
N_FNET_LAYERS = DEPTH // 2
DA_HEADS = 8
DA_HEAD_DIM = D_MODEL // DA_HEADS // 2
DA_V_DIM = 2 * DA_HEAD_DIM
FN_GROUPS = 8
FN_GROUP_DIM = D_MODEL // FN_GROUPS
Q_BLOCK = 128
EPS = 1e-6
SUBLN_EPS = 1e-5
LAMBDA_STD = 0.1

kernel_name = "diffattn_fnet_interleaved_encoder"


def lambda_init_fn(layer_idx):
    return 0.8 - 0.6 * math.exp(-0.3 * layer_idx)


def rmsnorm(x, g, eps=EPS):
    xf = x.astype(jnp.float32)
    xf = xf * lax.rsqrt(jnp.mean(xf * xf, axis=-1, keepdims=True) + eps)
    return (xf * g.astype(jnp.float32)).astype(x.dtype)


def alibi_slopes(n_heads):
    return 2.0 ** (-(8.0 / n_heads) * jnp.arange(1, n_heads + 1, dtype=jnp.float32))


def diff_attn_branch(h, w_in, w_out, lq1, lk1, lq2, lk2, subln_g, lam_init):
    B, S, D = h.shape
    H, d = DA_HEADS, DA_HEAD_DIM
    proj = h @ w_in
    q, k, v, z = jnp.split(proj, 4, axis=-1)
    q = q.reshape(B, S, H, 2, d).transpose(0, 2, 3, 1, 4)
    k = k.reshape(B, S, H, 2, d).transpose(0, 2, 3, 1, 4)
    v = v.reshape(B, S, H, DA_V_DIM).transpose(0, 2, 1, 3)
    f32 = jnp.float32
    lam = (jnp.exp(jnp.sum(lq1.astype(f32) * lk1.astype(f32)))
           - jnp.exp(jnp.sum(lq2.astype(f32) * lk2.astype(f32))) + lam_init)
    slopes = alibi_slopes(H)
    kpos = jnp.arange(S, dtype=f32)
    scale = d ** -0.5

    def block(start):
        qb = lax.dynamic_slice_in_dim(q, start, Q_BLOCK, axis=3)
        s = jnp.einsum('bhmqd,bhmkd->bhmqk', qb, k,
                       preferred_element_type=f32) * scale
        qpos = start.astype(f32) + jnp.arange(Q_BLOCK, dtype=f32)
        dist = jnp.abs(qpos[:, None] - kpos[None, :])
        s = s - (slopes[:, None, None] * dist)[None, :, None]
        p = jax.nn.softmax(s, axis=-1)
        pd = p[:, :, 0] - lam * p[:, :, 1]
        return jnp.einsum('bhqk,bhkv->bhqv', pd.astype(v.dtype), v)

    starts = jnp.arange(S // Q_BLOCK, dtype=jnp.int32) * Q_BLOCK
    o = lax.map(block, starts)
    o = o.transpose(1, 0, 3, 2, 4).reshape(B, S, H, DA_V_DIM)
    o = rmsnorm(o, subln_g, SUBLN_EPS) * (1.0 - lam_init)
    o = o.reshape(B, S, D) * jax.nn.silu(z)
    return o @ w_out


def fourier_branch(h, w_in, w_out):
    B, S, D = h.shape
    u, z = jnp.split(h @ w_in, 2, axis=-1)
    ug = u.astype(jnp.float32).reshape(B, S, FN_GROUPS, FN_GROUP_DIM)
    f = jnp.fft.fft2(ug, axes=(1, 3), norm="ortho").real
    f = f.reshape(B, S, D).astype(h.dtype)
    return (f * jax.nn.silu(z)) @ w_out


def trunk(x, attn_norm, attn_w_in, attn_lambda_q1, attn_lambda_k1, attn_lambda_q2,
          attn_lambda_k2, attn_subln, attn_w_out, fnet_norm, fnet_w_in, fnet_w_out, final_norm):
    for i in range(DEPTH):
        j = i // N_MIXERS
        if i % N_MIXERS == 0:
            h = rmsnorm(x, attn_norm[j])
            x = x + diff_attn_branch(h, attn_w_in[j], attn_w_out[j], attn_lambda_q1[j],
                                     attn_lambda_k1[j], attn_lambda_q2[j], attn_lambda_k2[j],
                                     attn_subln[j], lambda_init_fn(i))
        else:
            h = rmsnorm(x, fnet_norm[j])
            x = x + fourier_branch(h, fnet_w_in[j], fnet_w_out[j])
    return rmsnorm(x, final_norm)


def setup_inputs(seed: int = 0) -> dict:
    key = jax.random.key(seed)
    ks = jax.random.split(key, 16)
    D = D_MODEL
    na, nf = N_ATTN_LAYERS, N_FNET_LAYERS
    nrm = jax.random.normal
    return {
        "x_prompt": nrm(ks[0], (BATCH, SEQ, D), jnp.float32),
        "x_sample": nrm(ks[1], (DEC_BATCH, DEC_SEQ, D), jnp.float32),
        "attn_norm": 1.0 + 0.01 * nrm(ks[2], (na, D), jnp.float32),
        "attn_w_in": nrm(ks[3], (na, D, 4 * D), jnp.float32) * D ** -0.5,
        "attn_lambda_q1": LAMBDA_STD * nrm(ks[4], (na, DA_HEAD_DIM), jnp.float32),
        "attn_lambda_k1": LAMBDA_STD * nrm(ks[5], (na, DA_HEAD_DIM), jnp.float32),
        "attn_lambda_q2": LAMBDA_STD * nrm(ks[6], (na, DA_HEAD_DIM), jnp.float32),
        "attn_lambda_k2": LAMBDA_STD * nrm(ks[7], (na, DA_HEAD_DIM), jnp.float32),
        "attn_subln": 1.0 + 0.01 * nrm(ks[8], (na, DA_V_DIM), jnp.float32),
        "attn_w_out": nrm(ks[9], (na, D, D), jnp.float32) * D ** -0.5,
        "fnet_norm": 1.0 + 0.01 * nrm(ks[10], (nf, D), jnp.float32),
        "fnet_w_in": nrm(ks[11], (nf, D, 2 * D), jnp.float32) * D ** -0.5,
        "fnet_w_out": nrm(ks[12], (nf, D, D), jnp.float32) * D ** -0.5,
        "final_norm": 1.0 + 0.01 * nrm(ks[13], (D,), jnp.float32),
    }


def reference(x_prompt, x_sample, attn_norm, attn_w_in, attn_lambda_q1, attn_lambda_k1,
              attn_lambda_q2, attn_lambda_k2, attn_subln, attn_w_out, fnet_norm, fnet_w_in,
              fnet_w_out, final_norm):
    y_prompt = trunk(x_prompt, attn_norm, attn_w_in, attn_lambda_q1, attn_lambda_k1,
                     attn_lambda_q2, attn_lambda_k2, attn_subln, attn_w_out, fnet_norm,
                     fnet_w_in, fnet_w_out, final_norm)
    y_sample = trunk(x_sample, attn_norm, attn_w_in, attn_lambda_q1, attn_lambda_k1,
                     attn_lambda_q2, attn_lambda_k2, attn_subln, attn_w_out, fnet_norm,
                     fnet_w_in, fnet_w_out, final_norm)
    return (y_prompt, y_sample)
```

```cpp
#include <hip/hip_runtime.h>
#include <hip/hip_cooperative_groups.h>
#include <cstdio>
#include <cstdint>
namespace cg = cooperative_groups;
namespace pg8 {
#define PG8_LAS __attribute__((address_space(3)))
typedef unsigned short bf16_t;
typedef short bf16x8 __attribute__((ext_vector_type(8)));
typedef float f32x4 __attribute__((ext_vector_type(4)));
typedef unsigned u32x4 __attribute__((ext_vector_type(4)));
constexpr int BM = 256, BK = 64, HALF = 128, HTB = HALF * BK * 2  , STAGE_BYTES = 8 * HTB, NXCD = 8, WGM = 8;

__host__ __device__ __forceinline__ int lds_byte(int r, int c) { const int st = (r >> 4) * 2 + (c >> 5), rr = r & 15, cc = c & 31, ob = rr * 64 + cc * 2; return st * 1024 + (ob ^ (((ob >> 9) & 1) << 5)); }
__host__ __device__ __forceinline__ void stage_rc(int b, int& R, int& C) { const int st = b / 1024, sb = b % 1024, swz = sb ^ (((sb >> 9) & 1) << 5); R = (st >> 1) * 16 + swz / 64; C = (st & 1) * 32 + (swz % 64) / 2; }
__host__ __device__ __forceinline__ int perm32(int rho) { const int n = rho >> 4, i = rho & 15; return 8 * (i >> 2) + 4 * n + (i & 3); }

struct Unit { int pm, pn; };
struct Gemm { const bf16_t* A; const bf16_t* Bt; int M, N, K, lda, ldb; };

struct StaticOrder {
    int nM, nN, nwg, G, c;
    __host__ __device__ void init(int M, int N, int G_, int c_) { nM = M / BM; nN = N / BM; nwg = nM * nN; G = G_; c = c_; }
    __host__ __device__ bool next(int i, Unit& u) const {
        const long L = (long)i * G + c; if (L >= nwg) return false;
        int wgid = (int)L; { const int q = nwg / NXCD, r = nwg % NXCD, xcd = wgid % NXCD, off = wgid / NXCD; wgid = (xcd < r ? xcd * (q + 1) : r * (q + 1) + (xcd - r) * q) + off; }
        const int nig = WGM * nN, gid = wgid / nig, fm = gid * WGM, gsz = (nM - fm) < WGM ? (nM - fm) : WGM;
        u.pm = fm + ((wgid % nig) % gsz); u.pn = (wgid % nig) / gsz; return true;
    }
    __device__ __forceinline__ void a_ready(const Unit&) const {}
    __device__ __forceinline__ void done(const Unit&) const {}
};
template <class Epi, class Sched, bool ALIGN_EPI = false, bool SP2 = false>
__device__ __forceinline__ void gemm_phase(PG8_LAS unsigned char* lds, const Gemm g, const Sched& S, const Epi& E) {
    const int tid = threadIdx.x, wid = __builtin_amdgcn_readfirstlane(tid >> 6), lane = tid & 63, wr = wid >> 2, wc = wid & 3, fr = lane & 15, fq = lane >> 4;
    const int K = g.K, nt = K / BK;
    unsigned voffA[2], voffB[2];
#pragma unroll
    for (int i = 0; i < 2; ++i) { int R, C; stage_rc(tid * 16 + i * 8192, R, C); const int Rb = Epi::PERM ? ((R & ~31) + perm32(R & 31)) : R;
        voffA[i] = (unsigned)(R * g.lda + C) * 2u; voffB[i] = (unsigned)(Rb * g.ldb + C) * 2u; }
    const size_t kstep = (size_t)(BK * 2);
    const size_t hstepA = (size_t)HALF * g.lda * 2, hstepB = (size_t)HALF * g.ldb * 2;
    const size_t tstepA = 2 * hstepA, tstepB = 2 * hstepB;
    const unsigned ldsw = (unsigned)wid * 1024u;
    const int aoff = lds_byte(wr * 64 + fr, fq * 8), boff = lds_byte(wc * 32 + fr, fq * 8);
#define PG8_SA(b, h) (((b) * 2 + (h)) * HTB)
#define PG8_SB(b, h) ((4 + (b) * 2 + (h)) * HTB)
#define PG8_STAGE(bufoff, gbase, voff) do { _Pragma("unroll") for (int _i = 0; _i < 2; ++_i) \
        __builtin_amdgcn_global_load_lds((const unsigned*)((const char*)(gbase) + (voff)[_i]), (PG8_LAS unsigned*)(lds + (bufoff) + ldsw + _i * 8192), 16, 0, 0); } while (0)
#define PG8_LDA(dst, b, h) do { _Pragma("unroll") for (int m = 0; m < 4; ++m) _Pragma("unroll") for (int k = 0; k < 2; ++k) dst[m][k] = *(const PG8_LAS bf16x8*)(lds + PG8_SA(b, h) + aoff + m * 2048 + k * 1024); } while (0)
#define PG8_LDB(dst, b, h) do { _Pragma("unroll") for (int n = 0; n < 2; ++n) _Pragma("unroll") for (int k = 0; k < 2; ++k) dst[n][k] = *(const PG8_LAS bf16x8*)(lds + PG8_SB(b, h) + boff + n * 2048 + k * 1024); } while (0)
#define PG8_MMA(ai, bj, At, Bt) do { __builtin_amdgcn_s_setprio(1); _Pragma("unroll") for (int m = 0; m < 4; ++m) _Pragma("unroll") for (int n = 0; n < 2; ++n) _Pragma("unroll") for (int k = 0; k < 2; ++k) \
        acc[ai][bj][m][n] = __builtin_amdgcn_mfma_f32_16x16x32_bf16(Bt[n][k], At[m][k], acc[ai][bj][m][n], 0, 0, 0); __builtin_amdgcn_s_setprio(0); } while (0)
#define PG8_WAIT_V(n) asm volatile("s_waitcnt vmcnt(" #n ")" ::: "memory")
#define PG8_WAIT_L(n) asm volatile("s_waitcnt lgkmcnt(" #n ")" ::: "memory")
#define PG8_BAR __builtin_amdgcn_s_barrier()
#define PG8_SCHED __builtin_amdgcn_sched_barrier(0)
    Unit cur, nxt; int ui = 0;
    if (!S.next(0, cur)) return;
    f32x4 acc[2][2][4][2];
#pragma unroll
    for (int a = 0; a < 2; ++a)
#pragma unroll
        for (int b = 0; b < 2; ++b)
#pragma unroll
            for (int m = 0; m < 4; ++m)
#pragma unroll
                for (int n = 0; n < 2; ++n) acc[a][b][m][n] = (f32x4){0.f, 0.f, 0.f, 0.f};
    bf16x8 At[4][2], B0[2][2], B1[2][2];
    const char* cA = (const char*)g.A + (size_t)cur.pm * tstepA; const char* cB = (const char*)g.Bt + (size_t)cur.pn * tstepB;
    S.a_ready(cur);
    if constexpr (SP2) {
        PG8_STAGE(PG8_SB(0, 0), cB, voffB); PG8_STAGE(PG8_SB(0, 1), cB + hstepB, voffB); PG8_STAGE(PG8_SA(0, 0), cA, voffA); PG8_STAGE(PG8_SA(0, 1), cA + hstepA, voffA);
        if (wr == 1) PG8_BAR;
        PG8_WAIT_V(2); PG8_BAR;
        PG8_STAGE(PG8_SB(1, 0), cB + kstep, voffB); PG8_STAGE(PG8_SA(1, 0), cA + kstep, voffA); PG8_STAGE(PG8_SB(1, 1), cB + hstepB + kstep, voffB);
        PG8_WAIT_V(6); PG8_BAR;
    } else {
        PG8_STAGE(PG8_SB(0, 0), cB, voffB); PG8_STAGE(PG8_SA(0, 0), cA, voffA); PG8_STAGE(PG8_SB(0, 1), cB + hstepB, voffB); PG8_STAGE(PG8_SA(0, 1), cA + hstepA, voffA);
        if (wr == 1) PG8_BAR;
        PG8_WAIT_V(4); PG8_BAR;
        PG8_STAGE(PG8_SB(1, 0), cB + kstep, voffB); PG8_STAGE(PG8_SA(1, 0), cA + kstep, voffA); PG8_STAGE(PG8_SB(1, 1), cB + hstepB + kstep, voffB);
        PG8_WAIT_V(6); PG8_BAR;
    }
    for (;;) {
        const bool has_next = S.next(ui + 1, nxt);
        const char* nA = has_next ? (const char*)g.A + (size_t)nxt.pm * tstepA : cA; const char* nB = has_next ? (const char*)g.Bt + (size_t)nxt.pn * tstepB : cB;
        for (int t = 0; t < nt; t += 2) {
            const bool last = (t == nt - 2);
            const char* a1 = cA + (size_t)(t + 1) * kstep;
            const char* a2 = last ? nA : cA + (size_t)(t + 2) * kstep; const char* b2 = last ? nB : cB + (size_t)(t + 2) * kstep;
            const char* a3 = a2 + kstep; const char* b3 = b2 + kstep;
            if (last && has_next) S.a_ready(nxt);
            if constexpr (SP2) {
            PG8_LDB(B0, 0, 0); PG8_LDB(B1, 0, 1); PG8_SCHED; PG8_LDA(At, 0, 0); PG8_STAGE(PG8_SA(1, 1), a1 + hstepA, voffA);
            PG8_WAIT_V(8); PG8_WAIT_L(0); PG8_BAR; PG8_MMA(0, 0, At, B0); PG8_MMA(0, 1, At, B1); PG8_BAR; PG8_SCHED;
            PG8_LDA(At, 0, 1); PG8_STAGE(PG8_SB(0, 0), b2, voffB); PG8_STAGE(PG8_SB(0, 1), b2 + hstepB, voffB); PG8_STAGE(PG8_SA(0, 0), a2, voffA);
            PG8_WAIT_V(8); PG8_WAIT_L(0); PG8_BAR; PG8_MMA(1, 0, At, B0); PG8_MMA(1, 1, At, B1); PG8_BAR; PG8_SCHED;
            PG8_LDB(B0, 1, 0); PG8_LDB(B1, 1, 1); PG8_SCHED; PG8_LDA(At, 1, 0); PG8_STAGE(PG8_SA(0, 1), a2 + hstepA, voffA);
            PG8_WAIT_V(8); PG8_WAIT_L(0); PG8_BAR; PG8_MMA(0, 0, At, B0); PG8_MMA(0, 1, At, B1); PG8_BAR; PG8_SCHED;
            PG8_LDA(At, 1, 1); PG8_STAGE(PG8_SB(1, 0), b3, voffB); PG8_STAGE(PG8_SB(1, 1), b3 + hstepB, voffB); PG8_STAGE(PG8_SA(1, 0), a3, voffA);
            PG8_WAIT_V(8); PG8_WAIT_L(0); PG8_BAR; PG8_MMA(1, 0, At, B0); PG8_MMA(1, 1, At, B1); PG8_BAR; PG8_SCHED;
            } else {
            PG8_LDB(B0, 0, 0); PG8_SCHED; PG8_LDA(At, 0, 0); PG8_STAGE(PG8_SA(1, 1), a1 + hstepA, voffA);
            PG8_WAIT_L(8); PG8_BAR; PG8_WAIT_L(0); PG8_MMA(0, 0, At, B0); PG8_BAR; PG8_SCHED;
            PG8_LDB(B1, 0, 1); PG8_STAGE(PG8_SB(0, 0), b2, voffB);
            PG8_BAR; PG8_WAIT_L(0); PG8_MMA(0, 1, At, B1); PG8_BAR;
            PG8_LDA(At, 0, 1); PG8_STAGE(PG8_SA(0, 0), a2, voffA);
            PG8_BAR; PG8_WAIT_L(0); PG8_MMA(1, 0, At, B0); PG8_BAR; PG8_SCHED;
            PG8_STAGE(PG8_SB(0, 1), b2 + hstepB, voffB);
            PG8_WAIT_V(6); PG8_BAR; PG8_MMA(1, 1, At, B1); PG8_BAR;
            PG8_LDB(B0, 1, 0); PG8_SCHED; PG8_LDA(At, 1, 0); PG8_STAGE(PG8_SA(0, 1), a2 + hstepA, voffA);
            PG8_WAIT_L(8); PG8_BAR; PG8_WAIT_L(0); PG8_MMA(0, 0, At, B0); PG8_BAR; PG8_SCHED;
            PG8_LDB(B1, 1, 1); PG8_STAGE(PG8_SB(1, 0), b3, voffB);
            PG8_BAR; PG8_WAIT_L(0); PG8_MMA(0, 1, At, B1); PG8_BAR;
            PG8_LDA(At, 1, 1); PG8_STAGE(PG8_SA(1, 0), a3, voffA);
            PG8_BAR; PG8_WAIT_L(0); PG8_MMA(1, 0, At, B0); PG8_BAR; PG8_SCHED;
            PG8_STAGE(PG8_SB(1, 1), b3 + hstepB, voffB);
            PG8_WAIT_V(6); PG8_BAR; PG8_MMA(1, 1, At, B1); PG8_BAR;
            }
        }
        if constexpr (ALIGN_EPI) { if (wr == 0) PG8_BAR; }
        if constexpr (!Epi::AFTER_DRAIN) { E(acc, cur, wr, wc, fr, fq); S.done(cur); }
        if (!has_next) break;
#pragma unroll
        for (int a = 0; a < 2; ++a)
#pragma unroll
            for (int b = 0; b < 2; ++b)
#pragma unroll
                for (int m = 0; m < 4; ++m)
#pragma unroll
                    for (int n = 0; n < 2; ++n) acc[a][b][m][n] = (f32x4){0.f, 0.f, 0.f, 0.f};
        cur = nxt; cA = nA; cB = nB; ++ui;
        if constexpr (ALIGN_EPI) { if (wr == 1) PG8_BAR; }
    }
    PG8_WAIT_V(0);
    if constexpr (!ALIGN_EPI) { if (wr == 0) PG8_BAR; }
    PG8_BAR;
    if constexpr (Epi::AFTER_DRAIN) { E.fused(acc, cur, wr, wc, fr, fq, lds, wid, lane); S.done(cur); }
#undef PG8_SA
#undef PG8_SB
#undef PG8_STAGE
#undef PG8_LDA
#undef PG8_LDB
#undef PG8_MMA
#undef PG8_WAIT_V
#undef PG8_WAIT_L
#undef PG8_BAR
#undef PG8_SCHED
}
}
#define LAS __attribute__((address_space(3)))
typedef unsigned short bf16_t;
typedef short bf16x8 __attribute__((ext_vector_type(8)));
typedef short s16x4 __attribute__((ext_vector_type(4)));
typedef float f32x4 __attribute__((ext_vector_type(4)));
typedef float f32x16 __attribute__((ext_vector_type(16)));
typedef unsigned u32x4 __attribute__((ext_vector_type(4)));
typedef unsigned u32x2 __attribute__((ext_vector_type(2)));
typedef float f32x2_t __attribute__((ext_vector_type(2)));
typedef __bf16 bf16x2_t __attribute__((ext_vector_type(2)));

constexpr int DM = 1024, MTOT = 32768, SEQP = 16384, SEQS = 2048;
constexpr int NTHR = 512;
constexpr float EPS = 1e-6f, SUBLN_EPS = 1e-5f, LOG2E = 1.4426950408889634f;
constexpr float QSCALE = 0.125f * LOG2E;
constexpr int LDS_TOTAL = 131072;

__device__ __attribute__((aligned(256))) bf16_t g_w0t[4096 * 1024];
__device__ __attribute__((aligned(256))) bf16_t g_wo0t[1024 * 1024];
__device__ __attribute__((aligned(256))) bf16_t g_ws1[1024 * 1024];
__device__ __attribute__((aligned(256))) bf16_t g_w1t[3072 * 1024];
__device__ __attribute__((aligned(256))) bf16_t g_wo1t[1024 * 1024];
__device__ __attribute__((aligned(256))) bf16_t g_tab128[256 * 128];
__device__ __attribute__((aligned(256))) bf16_t g_tab16[32 * 32];
__device__ __attribute__((aligned(256))) float g_r0[MTOT];
__device__ __attribute__((aligned(256))) float g_ss1[MTOT];
__device__ __attribute__((aligned(256))) float g_ss2[MTOT];

struct Params {
    const float* xp; const float* xs; const float* attn_norm; const float* w_in0; const float* lq1; const float* lk1; const float* lq2; const float* lk2;
    const float* subln; const float* w_out0; const float* fnet_norm; const float* w_in1; const float* w_out1; const float* final_norm;
    float* out; unsigned char* ws;
};

__device__ __forceinline__ unsigned pk2(float lo, float hi) { f32x2_t v = {lo, hi}; bf16x2_t b = __builtin_convertvector(v, bf16x2_t); return __builtin_bit_cast(unsigned, b); }
__device__ __forceinline__ float bf_lo(unsigned u) { return __uint_as_float(u << 16); }
__device__ __forceinline__ float bf_hi(unsigned u) { return __uint_as_float(u & 0xffff0000u); }
__device__ __forceinline__ float wave_sum(float v) { v += __shfl_xor(v, 32); v += __shfl_xor(v, 16); v += __shfl_xor(v, 8); v += __shfl_xor(v, 4); v += __shfl_xor(v, 2); v += __shfl_xor(v, 1); return v; }
__device__ __forceinline__ float silu_f(float z) { return z / (1.0f + __expf(-z)); }
__device__ __forceinline__ int crow(int r, int hi) { return (r & 3) + 8 * (r >> 2) + 4 * hi; }
#define BLK_SYNC() __syncthreads()

struct EpiRowBf16 {
    static constexpr bool PERM = true, AFTER_DRAIN = false;
    bf16_t* b0; bf16_t* b1; bf16_t* b2; bf16_t* b3; int ld0, ld1; int split_cols; const float* rstat; int stat_is_sumsq; float scale0;
    __device__ __forceinline__ void operator()(const pg8::f32x4 (&acc)[2][2][4][2], const pg8::Unit& u, int wr, int wc, int fr, int fq) const {
        const int row0 = u.pm * 256 + wr * 64 + fr; int colt = u.pn * 256; const int t = colt / split_cols; colt -= t * split_cols;
        bf16_t* b = (t == 0) ? b0 : (t == 1) ? b1 : (t == 2) ? b2 : b3; const int ld = (t == 0) ? ld0 : ld1; const float sc = (t == 0) ? scale0 : 1.0f;
        const int col0 = colt + wc * 32 + 8 * fq;
#pragma unroll
        for (int ai = 0; ai < 2; ++ai)
#pragma unroll
            for (int m = 0; m < 4; ++m) {
                const int row = row0 + ai * 128 + m * 16; float rs = rstat[row];
                if (stat_is_sumsq) rs = rsqrtf(rs * (1.0f / 1024.0f) + EPS);
                rs *= sc; bf16_t* rowp = b + (size_t)row * ld + col0;
#pragma unroll
                for (int bj = 0; bj < 2; ++bj) { const pg8::f32x4 v0 = acc[ai][bj][m][0] * rs, v1 = acc[ai][bj][m][1] * rs;
                    u32x4 w; w.x = pk2(v0[0], v0[1]); w.y = pk2(v0[2], v0[3]); w.z = pk2(v1[0], v1[1]); w.w = pk2(v1[2], v1[3]);
                    *(u32x4*)(rowp + bj * 128) = w; }
            }
    }
};
struct EpiFold {
    static constexpr bool PERM = true, AFTER_DRAIN = false;
    bf16_t* O; int g;
    __device__ __forceinline__ void operator()(const pg8::f32x4 (&acc)[2][2][4][2], const pg8::Unit& u, int wr, int wc, int fr, int fq) const {
        const int col0 = u.pn * 256 + wc * 32 + 8 * fq;
#pragma unroll
        for (int ai = 0; ai < 2; ++ai)
#pragma unroll
            for (int m = 0; m < 4; ++m) {
                const int j = wr * 64 + m * 16 + fr; bf16_t* rowp = O + (size_t)(ai * 1024 + g * 128 + j) * 1024 + col0;
#pragma unroll
                for (int bj = 0; bj < 2; ++bj) { const pg8::f32x4 v0 = acc[ai][bj][m][0], v1 = acc[ai][bj][m][1];
                    u32x4 w; w.x = pk2(v0[0], v0[1]); w.y = pk2(v0[2], v0[3]); w.z = pk2(v1[0], v1[1]); w.w = pk2(v1[2], v1[3]);
                    *(u32x4*)(rowp + bj * 128) = w; }
            }
    }
};
struct EpiResid {
    static constexpr bool PERM = false, AFTER_DRAIN = false;
    const float* resA; const float* resB; float* out; bf16_t* outb; float* ss;
    __device__ __forceinline__ void operator()(const pg8::f32x4 (&acc)[2][2][4][2], const pg8::Unit& u, int wr, int wc, int fr, int fq) const {
        const int row0 = u.pm * 256 + wr * 64 + fr; const int col0 = u.pn * 256 + wc * 32 + 4 * fq;
#pragma unroll
        for (int ai = 0; ai < 2; ++ai)
#pragma unroll
            for (int m = 0; m < 4; ++m) {
                const int row = row0 + ai * 128 + m * 16;
                const float* rp = (row < SEQP) ? (resA + (size_t)row * DM) : (resB + (size_t)(row - SEQP) * DM);
                float s = 0.f;
#pragma unroll
                for (int bj = 0; bj < 2; ++bj)
#pragma unroll
                    for (int n = 0; n < 2; ++n) { const int col = col0 + bj * 128 + n * 16;
                        const pg8::f32x4 r = *(const pg8::f32x4*)(rp + col); const pg8::f32x4 v = r + acc[ai][bj][m][n];
                        *(pg8::f32x4*)(out + (size_t)row * DM + col) = v;
                        if (outb) { u32x2 w; w.x = pk2(v[0], v[1]); w.y = pk2(v[2], v[3]); *(u32x2*)(outb + (size_t)row * DM + col) = w; }
                        s += (v[0] * v[0] + v[1] * v[1]) + (v[2] * v[2] + v[3] * v[3]); }
                s += __shfl_xor(s, 16); s += __shfl_xor(s, 32);
                if (fq == 0) atomicAdd(ss + row, s);
            }
    }
};
struct OneUnit { int pn; __device__ bool next(int i, pg8::Unit& u) const { if (i > 0) return false; u.pm = 0; u.pn = pn; return true; }
    __device__ __forceinline__ void a_ready(const pg8::Unit&) const {} __device__ __forceinline__ void done(const pg8::Unit&) const {} };

__device__ __forceinline__ void transpose_item(const float* W, int ldw, const float* gain, bf16_t* WT, LAS float* scr, int item, int nblk, int lane) {
    const int kb = item / nblk, nb = item % nblk, k0 = 64 * kb, n0 = 32 * nb;
#pragma unroll 8
    for (int i = 0; i < 32; ++i) { const int kk = 2 * i + (lane >> 5); const float gk = gain ? gain[k0 + kk] : 1.0f; scr[kk * 33 + (lane & 31)] = W[(size_t)(k0 + kk) * ldw + n0 + (lane & 31)] * gk; }
    asm volatile("s_waitcnt lgkmcnt(0)" ::: "memory");
    const int c = lane & 7;
#pragma unroll
    for (int j = 0; j < 4; ++j) { const int n = (lane >> 3) + 8 * j; const LAS float* s = scr + (8 * c) * 33 + n;
        u32x4 o; o.x = pk2(s[0 * 33], s[1 * 33]); o.y = pk2(s[2 * 33], s[3 * 33]); o.z = pk2(s[4 * 33], s[5 * 33]); o.w = pk2(s[6 * 33], s[7 * 33]);
        *(u32x4*)(WT + (size_t)(n0 + n) * 1024 + k0 + 8 * c) = o; }
    asm volatile("s_waitcnt lgkmcnt(0)" ::: "memory");
}

__device__ __forceinline__ void phase0(const Params& p, LAS unsigned char* lds, bf16_t* XB) {
    const int tid = threadIdx.x, lane = tid & 63, wave = tid >> 6;
    const int gw = blockIdx.x * 8 + wave, NGW = gridDim.x * 8;
    for (int row = gw; row < MTOT; row += NGW) {
        const float* xr = (row < SEQP) ? (p.xp + (size_t)row * DM) : (p.xs + (size_t)(row - SEQP) * DM);
        f32x4 v[4]; float ss = 0.f;
#pragma unroll
        for (int i = 0; i < 4; ++i) { v[i] = *(const f32x4*)(xr + 4 * (lane + 64 * i)); ss += (v[i][0] * v[i][0] + v[i][1] * v[i][1]) + (v[i][2] * v[i][2] + v[i][3] * v[i][3]); }
        ss = wave_sum(ss);
        if (lane == 0) g_r0[row] = rsqrtf(ss * (1.0f / 1024.0f) + EPS);
#pragma unroll
        for (int i = 0; i < 4; ++i) { u32x2 w; w.x = pk2(v[i][0], v[i][1]); w.y = pk2(v[i][2], v[i][3]); *(u32x2*)(XB + (size_t)row * DM + 4 * (lane + 64 * i)) = w; }
    }
    for (int i = blockIdx.x * NTHR + tid; i < MTOT; i += gridDim.x * NTHR) { g_ss1[i] = 0.f; g_ss2[i] = 0.f; }
    LAS float* scr = (LAS float*)(lds + wave * 8704);
    constexpr int I0 = 16 * 128, I1 = 16 * 32, NIT = I0 + 3 * I1;
    for (int it = gw; it < NIT; it += NGW) {
        int r = it;
        if (r < I0) { transpose_item(p.w_in0, 4096, p.attn_norm, g_w0t, scr, r, 128, lane); continue; } r -= I0;
        if (r < I1) { transpose_item(p.w_out0, 1024, nullptr, g_wo0t, scr, r, 32, lane); continue; } r -= I1;
        if (r < I1) { transpose_item(p.w_in1 + 1024, 2048, p.fnet_norm, g_w1t + (size_t)2048 * 1024, scr, r, 32, lane); continue; } r -= I1;
        transpose_item(p.w_out1, 1024, nullptr, g_wo1t, scr, r, 32, lane);
    }
    for (int i = blockIdx.x * NTHR + tid; i < 1024 * 256; i += gridDim.x * NTHR) {
        const int k = i >> 8, c4 = (i & 255) * 4; const f32x4 w = *(const f32x4*)(p.w_in1 + (size_t)k * 2048 + c4); const float gk = p.fnet_norm[k];
        u32x2 o; o.x = pk2(w[0] * gk, w[1] * gk); o.y = pk2(w[2] * gk, w[3] * gk); *(u32x2*)(g_ws1 + (size_t)k * 1024 + c4) = o;
    }
    for (int i = blockIdx.x * NTHR + tid; i < 256 * 128; i += gridDim.x * NTHR) {
        const int rr = i >> 7, n = i & 127, k = rr & 127, part = rr >> 7; const float th = (float)((k * n) & 127) * (6.283185307179586f / 128.0f);
        const float v = part ? sinf(th) : cosf(th); g_tab128[i] = (bf16_t)(pk2(v, 0.f) & 0xffffu);
    }
    for (int i = blockIdx.x * NTHR + tid; i < 32 * 32; i += gridDim.x * NTHR) {
        const int kk = i >> 5, j = i & 31, k1 = kk & 15, po = kk >> 4, n1 = j & 15, pi = j >> 4; const float th = (float)((k1 * n1) & 15) * (6.283185307179586f / 16.0f);
        float v; if (po == 0) v = pi ? -sinf(th) : cosf(th); else v = pi ? -cosf(th) : -sinf(th);
        g_tab16[i] = (bf16_t)(pk2(v, 0.f) & 0xffffu);
    }
}

constexpr int AT_KP = 144, AT_VP = 320, AT_K2 = 64 * AT_KP, AT_V = 2 * 64 * AT_KP, AT_STAGE = AT_V + 64 * AT_VP, AT_XP = 528;
typedef short v4i16_t __attribute__((ext_vector_type(4)));
__device__ __forceinline__ s16x4 tr_read(LAS const unsigned char* p) { return __builtin_bit_cast(s16x4, __builtin_amdgcn_ds_read_tr16_b64_v4i16((LAS v4i16_t*)p)); }
__device__ __forceinline__ bf16x8 cat8(s16x4 a, s16x4 b) { return (bf16x8){a[0], a[1], a[2], a[3], b[0], b[1], b[2], b[3]}; }
__device__ __forceinline__ bf16x8 neg8(bf16x8 a) { typedef int i32x4 __attribute__((ext_vector_type(4))); i32x4 v = __builtin_bit_cast(i32x4, a); v = v ^ (int)0x80008000; return __builtin_bit_cast(bf16x8, v); }
#define MFMA32(a, b, c) __builtin_amdgcn_mfma_f32_32x32x16_bf16((a), (b), (c), 0, 0, 0)

__device__ __forceinline__ void attn_phase(const Params& p, LAS unsigned char* lds, bf16_t* Qb, const bf16_t* Kb, const bf16_t* Vb, const bf16_t* Zb) {
    const int tid = threadIdx.x, lane = tid & 63, wave = __builtin_amdgcn_readfirstlane(tid >> 6), r32 = lane & 31, hi = lane >> 5;
    const int map = wave >> 2, qs = wave & 3;
    float lam;
    { const float a = wave_sum(p.lq1[lane] * p.lk1[lane]), b = wave_sum(p.lq2[lane] * p.lk2[lane]); lam = expf(a) - expf(b) + 0.2f; }
    const int g16 = lane >> 4, i16 = lane & 15, tq = i16 >> 2, tp = i16 & 3;
    for (int unit = blockIdx.x; unit < 2048; unit += gridDim.x) {
        int R0s, S, h, q0;
        if (unit < 1024) { R0s = 0; S = SEQP; h = unit >> 7; q0 = (unit & 127) * 128; }
        else { const int v = unit - 1024; R0s = SEQP + (v >> 7) * SEQS; S = SEQS; h = (v >> 4) & 7; q0 = (v & 15) * 128; }
        const int qrow = R0s + q0 + qs * 32 + r32;
        bf16x8 qf[4];
        { const bf16_t* qp = Qb + (size_t)qrow * DM + h * 128 + map * 64 + hi * 8;
#pragma unroll
          for (int st = 0; st < 4; ++st) qf[st] = *(const bf16x8*)(qp + st * 16); }
        const float slope2 = exp2f(-(float)(h + 1)) * LOG2E;
        const float qposf = (float)(q0 + qs * 32 + r32);
        float m = -INFINITY, l = 0.f;
        f32x16 o[4];
#pragma unroll
        for (int db = 0; db < 4; ++db)
#pragma unroll
            for (int r = 0; r < 16; ++r) o[db][r] = 0.f;
        const int NTL = S / 64;
        const bf16_t* gsrc[4]; int ldst[4];
#pragma unroll
        for (int i = 0; i < 4; ++i) { const int c = tid + 512 * i;
            if (i < 2) { const int row = c >> 4, ch = c & 15; gsrc[i] = Kb + (size_t)(R0s + row) * DM + h * 128 + ch * 8; ldst[i] = (ch >> 3) * AT_K2 + row * AT_KP + (ch & 7) * 16; }
            else { const int c2 = c - 1024, row = c2 >> 4, ch = c2 & 15; gsrc[i] = Vb + (size_t)(R0s + row) * DM + h * 128 + ch * 8; ldst[i] = AT_V + row * AT_VP + ch * 16; } }
        u32x4 stg[4];
#pragma unroll
        for (int i = 0; i < 4; ++i) stg[i] = *(const u32x4*)(gsrc[i]);
#pragma unroll
        for (int i = 0; i < 4; ++i) *(LAS u32x4*)(lds + ldst[i]) = stg[i];
        BLK_SYNC();
        for (int t = 0; t < NTL; ++t) {
            const int stage = t & 1;
            if (t + 1 < NTL) {
#pragma unroll
                for (int i = 0; i < 4; ++i) stg[i] = *(const u32x4*)(gsrc[i] + (size_t)(t + 1) * 64 * DM);
            }
            LAS const unsigned char* Kt = lds + stage * AT_STAGE + map * AT_K2 + r32 * AT_KP + hi * 16;
            f32x16 s0, s1;
#pragma unroll
            for (int r = 0; r < 16; ++r) { s0[r] = 0.f; s1[r] = 0.f; }
#pragma unroll
            for (int st = 0; st < 4; ++st) {
                const bf16x8 a0 = *(LAS const bf16x8*)(Kt + st * 32), a1 = *(LAS const bf16x8*)(Kt + 32 * AT_KP + st * 32);
                s0 = MFMA32(a0, qf[st], s0); s1 = MFMA32(a1, qf[st], s1);
            }
            const float d0 = qposf - (float)(t * 64 + 4 * hi);
            float mt = -INFINITY;
#pragma unroll
            for (int r = 0; r < 16; ++r) { const float c = (float)((r & 3) + 8 * (r >> 2));
                s0[r] = s0[r] - slope2 * fabsf(d0 - c); s1[r] = s1[r] - slope2 * fabsf(d0 - 32.0f - c);
                mt = fmaxf(mt, fmaxf(s0[r], s1[r])); }
            mt = fmaxf(mt, __shfl_xor(mt, 32));
            const float mnew = fmaxf(m, mt), alpha = __builtin_amdgcn_exp2f(m - mnew); m = mnew;
            float rs = 0.f;
#pragma unroll
            for (int r = 0; r < 16; ++r) { s0[r] = __builtin_amdgcn_exp2f(s0[r] - mnew); s1[r] = __builtin_amdgcn_exp2f(s1[r] - mnew); rs += s0[r] + s1[r]; }
            l = l * alpha + rs;
#pragma unroll
            for (int db = 0; db < 4; ++db)
#pragma unroll
                for (int r = 0; r < 16; ++r) o[db][r] *= alpha;
            bf16x8 pf[2][2];
#pragma unroll
            for (int s = 0; s < 2; ++s) {
                u32x4 w0, w1;
                w0.x = pk2(s0[8 * s + 0], s0[8 * s + 1]); w0.y = pk2(s0[8 * s + 2], s0[8 * s + 3]); w0.z = pk2(s0[8 * s + 4], s0[8 * s + 5]); w0.w = pk2(s0[8 * s + 6], s0[8 * s + 7]);
                w1.x = pk2(s1[8 * s + 0], s1[8 * s + 1]); w1.y = pk2(s1[8 * s + 2], s1[8 * s + 3]); w1.z = pk2(s1[8 * s + 4], s1[8 * s + 5]); w1.w = pk2(s1[8 * s + 6], s1[8 * s + 7]);
                pf[0][s] = __builtin_bit_cast(bf16x8, w0); pf[1][s] = __builtin_bit_cast(bf16x8, w1);
            }
            LAS const unsigned char* vbase = lds + stage * AT_STAGE + AT_V + (4 * hi + tq) * AT_VP + (16 * (g16 & 1) + 4 * tp) * 2;
#pragma unroll
            for (int db = 0; db < 4; ++db)
#pragma unroll
                for (int kb = 0; kb < 2; ++kb)
#pragma unroll
                    for (int s = 0; s < 2; ++s) {
                        LAS const unsigned char* a = vbase + (kb * 32 + 16 * s) * AT_VP + db * 64;
                        const bf16x8 vf = cat8(tr_read(a), tr_read(a + 8 * AT_VP));
                        o[db] = MFMA32(vf, pf[kb][s], o[db]);
                    }
            if (t + 1 < NTL) {
#pragma unroll
                for (int i = 0; i < 4; ++i) *(LAS u32x4*)(lds + (stage ^ 1) * AT_STAGE + ldst[i]) = stg[i];
            }
            BLK_SYNC();
        }
        l += __shfl_xor(l, 32);
        const float inv = 1.0f / l;
#pragma unroll
        for (int db = 0; db < 4; ++db)
#pragma unroll
            for (int r = 0; r < 16; ++r) o[db][r] *= inv;
        LAS unsigned char* xq = lds + (qs * 32 + r32) * AT_XP;
        if (map == 1) {
#pragma unroll
            for (int db = 0; db < 4; ++db)
#pragma unroll
                for (int rg = 0; rg < 4; ++rg) { const int d = 32 * db + 8 * rg + 4 * hi;
                    *(LAS f32x4*)(xq + d * 4) = (f32x4){o[db][4 * rg], o[db][4 * rg + 1], o[db][4 * rg + 2], o[db][4 * rg + 3]}; }
        }
        BLK_SYNC();
        if (map == 0) {
            float ss = 0.f;
#pragma unroll
            for (int db = 0; db < 4; ++db)
#pragma unroll
                for (int rg = 0; rg < 4; ++rg) { const int d = 32 * db + 8 * rg + 4 * hi; const f32x4 o2 = *(LAS const f32x4*)(xq + d * 4);
#pragma unroll
                    for (int e = 0; e < 4; ++e) { const float v = o[db][4 * rg + e] - lam * o2[e]; o[db][4 * rg + e] = v; ss += v * v; } }
            ss += __shfl_xor(ss, 32);
            const float rn = rsqrtf(ss * (1.0f / 128.0f) + SUBLN_EPS) * 0.8f;
            const bf16_t* zp = Zb + (size_t)qrow * DM + h * 128; bf16_t* op = Qb + (size_t)qrow * DM + h * 128;
#pragma unroll
            for (int db = 0; db < 4; ++db)
#pragma unroll
                for (int rg = 0; rg < 4; ++rg) { const int d = 32 * db + 8 * rg + 4 * hi;
                    const f32x4 gg = *(const f32x4*)(p.subln + d); const u32x2 zz = *(const u32x2*)(zp + d);
                    const float v0 = o[db][4 * rg] * rn * gg[0] * silu_f(bf_lo(zz.x)), v1 = o[db][4 * rg + 1] * rn * gg[1] * silu_f(bf_hi(zz.x));
                    const float v2 = o[db][4 * rg + 2] * rn * gg[2] * silu_f(bf_lo(zz.y)), v3 = o[db][4 * rg + 3] * rn * gg[3] * silu_f(bf_hi(zz.y));
                    u32x2 w; w.x = pk2(v0, v1); w.y = pk2(v2, v3); *(u32x2*)(op + d) = w; }
        }
        BLK_SYNC();
    }
}

constexpr int FT_P = 320;
template <int MODE> __device__ __forceinline__ void fft_rows(int unit, int& rbase, int& cc, int& a0, int& a1, int& a2) {
    cc = unit & 7;
    if (MODE == 0) { a0 = unit >> 3; rbase = 0; a1 = 0; a2 = 0; }
    else if (MODE == 1) { a0 = unit >> 7; a1 = (unit >> 3) & 15; rbase = SEQP + a0 * SEQS; a2 = 0; }
    else { if (unit < 1024) { rbase = 0; a0 = unit >> 3; a1 = 128; } else { const int v = unit - 1024; rbase = SEQP + (v >> 7) * SEQS; a0 = (v >> 3) & 15; a1 = 16; } a2 = 0; }
}
template <int MODE> __device__ __forceinline__ const bf16_t* fft_src(const bf16_t* AB, int rbase, int cc, int a0, int a1, int rho, int ch16) {
    int grow, part;
    if (MODE == 0) { part = rho >> 7; grow = (rho & 127) * 128 + a0; }
    else if (MODE == 1) { part = (rho >> 4) & 1; grow = rbase + (rho & 15) * 128 + a1 * 8 + (rho >> 5); }
    else { part = rho >> 7; grow = rbase + a0 * 128 + (rho & 127); }
    return AB + (size_t)grow * 2048 + part * 1024 + cc * 128 + ch16 * 8;
}

template <int MODE> __device__ __forceinline__ void fft_pass(LAS unsigned char* lds, bf16_t* AB, const bf16_t* Z1, bf16_t* FG, int nunits) {
    const int tid = threadIdx.x, lane = tid & 63, wave = __builtin_amdgcn_readfirstlane(tid >> 6), r32 = lane & 31, hi = lane >> 5;
    const int g16 = lane >> 4, i16 = lane & 15, tq = i16 >> 2, tp = i16 & 3;
    const int kb = wave & 3, cbh = wave >> 2;
    bf16x8 Cf[8], Sf[8];
    if (MODE != 1) {
        const int k = 32 * kb + r32;
#pragma unroll
        for (int s = 0; s < 8; ++s) { Cf[s] = *(const bf16x8*)(g_tab128 + k * 128 + 16 * s + 8 * hi); Sf[s] = *(const bf16x8*)(g_tab128 + (128 + k) * 128 + 16 * s + 8 * hi); }
    } else {
#pragma unroll
        for (int s = 0; s < 2; ++s) Cf[s] = *(const bf16x8*)(g_tab16 + r32 * 32 + 16 * s + 8 * hi);
    }
    int unit = blockIdx.x;
    if (unit >= nunits) return;
    int rbase, cc, a0, a1, a2;
    fft_rows<MODE>(unit, rbase, cc, a0, a1, a2);
    u32x4 stg[8];
#pragma unroll
    for (int i = 0; i < 8; ++i) { const int c = tid + 512 * i; stg[i] = *(const u32x4*)fft_src<MODE>(AB, rbase, cc, a0, a1, c >> 4, c & 15); }
    for (;;) {
#pragma unroll
        for (int i = 0; i < 8; ++i) { const int c = tid + 512 * i; *(LAS u32x4*)(lds + (c >> 4) * FT_P + (c & 15) * 16) = stg[i]; }
        BLK_SYNC();
        const int nunit = unit + gridDim.x; const bool has_next = nunit < nunits;
        int nrbase = 0, ncc = 0, na0 = 0, na1 = 0, na2 = 0;
        if (has_next) { fft_rows<MODE>(nunit, nrbase, ncc, na0, na1, na2);
#pragma unroll
            for (int i = 0; i < 8; ++i) { const int c = tid + 512 * i; stg[i] = *(const u32x4*)fft_src<MODE>(AB, nrbase, ncc, na0, na1, c >> 4, c & 15); } }
        if (MODE == 0) {
            const int k1 = 32 * kb + r32, n2 = a0;
            const float ph = (float)((k1 * n2) & 16383) * (1.0f / 16384.0f); const float tc = __builtin_amdgcn_cosf(ph), ts = __builtin_amdgcn_sinf(ph);
#pragma unroll 1
            for (int cbi = 0; cbi < 2; ++cbi) { const int cb = 2 * cbh + cbi;
                LAS const unsigned char* ab = lds + (8 * hi + tq) * FT_P + (32 * cb + 16 * (g16 & 1) + 4 * tp) * 2;
                f32x16 yr, yi;
#pragma unroll
                for (int r = 0; r < 16; ++r) { yr[r] = 0.f; yi[r] = 0.f; }
#pragma unroll
                for (int s = 0; s < 8; ++s) {
                    const bf16x8 af = cat8(tr_read(ab + (16 * s) * FT_P), tr_read(ab + (16 * s + 4) * FT_P));
                    const bf16x8 bf = cat8(tr_read(ab + (128 + 16 * s) * FT_P), tr_read(ab + (128 + 16 * s + 4) * FT_P));
                    const bf16x8 naf = neg8(af), nbf = neg8(bf);
                    yr = MFMA32(af, Cf[s], yr); yr = MFMA32(nbf, Sf[s], yr);
                    yi = MFMA32(naf, Sf[s], yi); yi = MFMA32(nbf, Cf[s], yi);
                }
                bf16_t* orow = AB + (size_t)(k1 * 128 + n2) * 2048 + cc * 128 + cb * 32 + 4 * hi;
#pragma unroll
                for (int rg = 0; rg < 4; ++rg) { float a[4], b[4];
#pragma unroll
                    for (int e = 0; e < 4; ++e) { const float vr = yr[4 * rg + e], vi = yi[4 * rg + e]; a[e] = vr * tc + vi * ts; b[e] = vi * tc - vr * ts; }
                    u32x2 w0, w1; w0.x = pk2(a[0], a[1]); w0.y = pk2(a[2], a[3]); w1.x = pk2(b[0], b[1]); w1.y = pk2(b[2], b[3]);
                    *(u32x2*)(orow + 8 * rg) = w0; *(u32x2*)(orow + 1024 + 8 * rg) = w1; }
            }
        } else if (MODE == 1) {
            const int k1 = r32 & 15, po = r32 >> 4, n2 = a1 * 8 + wave;
            const float ph = (float)((k1 * n2) & 2047) * (1.0f / 2048.0f); const float tc = __builtin_amdgcn_cosf(ph); float ts = __builtin_amdgcn_sinf(ph); if (po) ts = -ts;
#pragma unroll 1
            for (int cb = 0; cb < 4; ++cb) {
                LAS const unsigned char* ab = lds + (wave * 32 + 8 * hi + tq) * FT_P + (32 * cb + 16 * (g16 & 1) + 4 * tp) * 2;
                f32x16 y;
#pragma unroll
                for (int r = 0; r < 16; ++r) y[r] = 0.f;
                const bf16x8 f0 = cat8(tr_read(ab), tr_read(ab + 4 * FT_P)), f1 = cat8(tr_read(ab + 16 * FT_P), tr_read(ab + 20 * FT_P));
                y = MFMA32(f0, Cf[0], y); y = MFMA32(f1, Cf[1], y);
                bf16_t* orow = AB + (size_t)(rbase + k1 * 128 + n2) * 2048 + po * 1024 + cc * 128 + cb * 32 + 4 * hi;
#pragma unroll
                for (int rg = 0; rg < 4; ++rg) { float a[4];
#pragma unroll
                    for (int e = 0; e < 4; ++e) { const float own = y[4 * rg + e], oth = __shfl_xor(own, 16); a[e] = own * tc + oth * ts; }
                    u32x2 w0; w0.x = pk2(a[0], a[1]); w0.y = pk2(a[2], a[3]); *(u32x2*)(orow + 8 * rg) = w0; }
            }
        } else {
            const int k2 = 32 * kb + r32, k1 = a0, N1 = a1; const float nrm = (N1 == 128) ? 6.905339660024879e-4f : 1.953125e-3f;
            const size_t orow_i = (size_t)(rbase + k1 + N1 * k2);
#pragma unroll 1
            for (int cbi = 0; cbi < 2; ++cbi) { const int cb = 2 * cbh + cbi;
                LAS const unsigned char* ab = lds + (8 * hi + tq) * FT_P + (32 * cb + 16 * (g16 & 1) + 4 * tp) * 2;
                f32x16 y;
#pragma unroll
                for (int r = 0; r < 16; ++r) y[r] = 0.f;
#pragma unroll
                for (int s = 0; s < 8; ++s) {
                    const bf16x8 af = cat8(tr_read(ab + (16 * s) * FT_P), tr_read(ab + (16 * s + 4) * FT_P));
                    const bf16x8 bf = cat8(tr_read(ab + (128 + 16 * s) * FT_P), tr_read(ab + (128 + 16 * s + 4) * FT_P));
                    y = MFMA32(af, Cf[s], y); y = MFMA32(bf, Sf[s], y);
                }
                const bf16_t* zrow = Z1 + orow_i * DM + cc * 128 + cb * 32 + 4 * hi; bf16_t* orow = FG + orow_i * DM + cc * 128 + cb * 32 + 4 * hi;
#pragma unroll
                for (int rg = 0; rg < 4; ++rg) { const u32x2 zz = *(const u32x2*)(zrow + 8 * rg);
                    const float v0 = y[4 * rg] * nrm * silu_f(bf_lo(zz.x)), v1 = y[4 * rg + 1] * nrm * silu_f(bf_hi(zz.x));
                    const float v2 = y[4 * rg + 2] * nrm * silu_f(bf_lo(zz.y)), v3 = y[4 * rg + 3] * nrm * silu_f(bf_hi(zz.y));
                    u32x2 w; w.x = pk2(v0, v1); w.y = pk2(v2, v3); *(u32x2*)(orow + 8 * rg) = w; }
            }
        }
        BLK_SYNC();
        if (!has_next) break;
        unit = nunit; rbase = nrbase; cc = ncc; a0 = na0; a1 = na1; a2 = na2;
    }
}

#ifndef PHM
#define PHM 0xffff
#endif
__global__ void __launch_bounds__(NTHR, 2) fwd_kernel(Params p) {
    extern __shared__ __attribute__((aligned(16))) unsigned char lds_raw[];
    LAS unsigned char* lds = (LAS unsigned char*)lds_raw;
    cg::grid_group grid = cg::this_grid();
    const size_t REG = (size_t)MTOT * DM;
    bf16_t* R0 = (bf16_t*)p.ws; bf16_t* R1 = R0 + REG; bf16_t* R2 = R1 + REG; bf16_t* R3 = R2 + REG;
    bf16_t* XB = (bf16_t*)p.out;

    if (PHM & 1) phase0(p, lds, XB);
    grid.sync();
    if (PHM & 2) {
        pg8::Gemm gm{XB, g_w0t, MTOT, 4096, 1024, 1024, 1024}; pg8::StaticOrder S; S.init(MTOT, 4096, gridDim.x, blockIdx.x);
        EpiRowBf16 E{R0, R1, R2, R3, DM, DM, 1024, g_r0, 0, QSCALE};
        pg8::gemm_phase<EpiRowBf16, pg8::StaticOrder, true, true>(lds, gm, S, E);
    }
    grid.sync();
    if ((PHM & 512) && blockIdx.x < 32) {
        const int fu = blockIdx.x, g = fu >> 2; pg8::Gemm gm{g_tab128, g_ws1 + g * 128, 256, 1024, 128, 128, 1024}; OneUnit S{fu & 3}; EpiFold E{g_w1t, g};
        pg8::gemm_phase<EpiFold, OneUnit, false, true>(lds, gm, S, E);
    }
    if (PHM & 4) attn_phase(p, lds, R0, R1, R2, R3);
    grid.sync();
    if (PHM & 8) {
        pg8::Gemm gm{R0, g_wo0t, MTOT, 1024, 1024, 1024, 1024}; pg8::StaticOrder S; S.init(MTOT, 1024, gridDim.x, blockIdx.x);
        EpiResid E{p.xp, p.xs, p.out, R3, g_ss1};
        pg8::gemm_phase<EpiResid, pg8::StaticOrder, true, true>(lds, gm, S, E);
    }
    grid.sync();
    if (PHM & 16) {
        pg8::Gemm gm{R3, g_w1t, MTOT, 3072, 1024, 1024, 1024}; pg8::StaticOrder S; S.init(MTOT, 3072, gridDim.x, blockIdx.x);
        EpiRowBf16 E{R1, R0, R0, R0, 2048, DM, 2048, g_ss1, 1, 1.0f};
        pg8::gemm_phase<EpiRowBf16, pg8::StaticOrder, true, true>(lds, gm, S, E);
    }
    grid.sync();
    if (PHM & 32) fft_pass<0>(lds, R1, nullptr, nullptr, 1024);
    if (PHM & 64) fft_pass<1>(lds, R1, nullptr, nullptr, 1024);
    grid.sync();
    if (PHM & 128) fft_pass<2>(lds, R1, R0, R3, 2048);
    grid.sync();
    if (PHM & 256) {
        pg8::Gemm gm{R3, g_wo1t, MTOT, 1024, 1024, 1024, 1024}; pg8::StaticOrder S; S.init(MTOT, 1024, gridDim.x, blockIdx.x);
        EpiResid E{p.out, p.out + (size_t)SEQP * DM, p.out, nullptr, g_ss2};
        pg8::gemm_phase<EpiResid, pg8::StaticOrder, true, true>(lds, gm, S, E);
    }
    grid.sync();
    const int lane = threadIdx.x & 63, wave = threadIdx.x >> 6;
    for (int row = blockIdx.x * 8 + wave; row < MTOT; row += gridDim.x * 8) {
        const float rs = rsqrtf(g_ss2[row] * (1.0f / 1024.0f) + EPS); float* orow = p.out + (size_t)row * DM;
#pragma unroll
        for (int i = 0; i < 4; ++i) { const int c = 4 * (lane + 64 * i); f32x4 v = *(const f32x4*)(orow + c); const f32x4 gg = *(const f32x4*)(p.final_norm + c);
            v[0] *= rs * gg[0]; v[1] *= rs * gg[1]; v[2] *= rs * gg[2]; v[3] *= rs * gg[3]; *(f32x4*)(orow + c) = v; }
    }
}

extern "C" void kernel_launch(void* const* d_in, const int* in_sizes, int n_in, void* d_out, int out_size, void* d_ws, size_t ws_size, hipStream_t stream) {
    static int grid = 0;
    if (grid == 0) {
        int dev = 0, cus = 0, per_cu = 0;
        if (n_in != 14 || ws_size < (size_t)4 * MTOT * DM * 2) { fprintf(stderr, "kernel_launch: unexpected problem shape (n_in %d, ws %zu)\n", n_in, ws_size); grid = -1; return; }
        hipGetDevice(&dev); hipDeviceGetAttribute(&cus, hipDeviceAttributeMultiprocessorCount, dev);
        if (hipFuncSetAttribute((const void*)fwd_kernel, hipFuncAttributeMaxDynamicSharedMemorySize, LDS_TOTAL) != hipSuccess) { fprintf(stderr, "kernel_launch: hipFuncSetAttribute failed\n"); grid = -1; return; }
        if (hipOccupancyMaxActiveBlocksPerMultiprocessor(&per_cu, (const void*)fwd_kernel, NTHR, LDS_TOTAL) != hipSuccess || per_cu < 1) { fprintf(stderr, "kernel_launch: occupancy query says %d blocks per CU\n", per_cu); per_cu = 1; }
        (void)hipGetLastError();
        grid = cus * 1;
    }
    if (grid < 0) return;
    Params p{};
    p.xp = (const float*)d_in[0]; p.xs = (const float*)d_in[1]; p.attn_norm = (const float*)d_in[2]; p.w_in0 = (const float*)d_in[3];
    p.lq1 = (const float*)d_in[4]; p.lk1 = (const float*)d_in[5]; p.lq2 = (const float*)d_in[6]; p.lk2 = (const float*)d_in[7];
    p.subln = (const float*)d_in[8]; p.w_out0 = (const float*)d_in[9]; p.fnet_norm = (const float*)d_in[10]; p.w_in1 = (const float*)d_in[11];
    p.w_out1 = (const float*)d_in[12]; p.final_norm = (const float*)d_in[13];
    p.out = (float*)d_out; p.ws = (unsigned char*)d_ws;
    void* args[] = {&p};
    const hipError_t e = hipLaunchCooperativeKernel((const void*)fwd_kernel, dim3(grid), dim3(NTHR), args, LDS_TOTAL, stream);
    if (e != hipSuccess) fprintf(stderr, "kernel_launch: cooperative launch failed: %s (grid %d)\n", hipGetErrorString(e), grid);
}
```

```cpp
#include <hip/hip_runtime.h>
#include <hip/hip_cooperative_groups.h>
#include <cstdio>
#include <cstdint>
namespace cg = cooperative_groups;
namespace pg8 {
#define PG8_LAS __attribute__((address_space(3)))
typedef unsigned short bf16_t;
typedef short bf16x8 __attribute__((ext_vector_type(8)));
typedef float f32x4 __attribute__((ext_vector_type(4)));
typedef unsigned u32x4 __attribute__((ext_vector_type(4)));
constexpr int BM = 256, BK = 64, HALF = 128, HTB = HALF * BK * 2  , STAGE_BYTES = 8 * HTB, NXCD = 8, WGM = 8;

__host__ __device__ __forceinline__ int lds_byte(int r, int c) { const int st = (r >> 4) * 2 + (c >> 5), rr = r & 15, cc = c & 31, ob = rr * 64 + cc * 2; return st * 1024 + (ob ^ (((ob >> 9) & 1) << 5)); }
__host__ __device__ __forceinline__ void stage_rc(int b, int& R, int& C) { const int st = b / 1024, sb = b % 1024, swz = sb ^ (((sb >> 9) & 1) << 5); R = (st >> 1) * 16 + swz / 64; C = (st & 1) * 32 + (swz % 64) / 2; }
__host__ __device__ __forceinline__ int perm32(int rho) { const int n = rho >> 4, i = rho & 15; return 8 * (i >> 2) + 4 * n + (i & 3); }

struct Unit { int pm, pn; };
struct Gemm { const bf16_t* A; const bf16_t* Bt; int M, N, K, lda, ldb; };

struct StaticOrder {
    int nM, nN, nwg, G, c;
    __host__ __device__ void init(int M, int N, int G_, int c_) { nM = M / BM; nN = N / BM; nwg = nM * nN; G = G_; c = c_; }
    __host__ __device__ bool next(int i, Unit& u) const {
        const long L = (long)i * G + c; if (L >= nwg) return false;
        int wgid = (int)L; { const int q = nwg / NXCD, r = nwg % NXCD, xcd = wgid % NXCD, off = wgid / NXCD; wgid = (xcd < r ? xcd * (q + 1) : r * (q + 1) + (xcd - r) * q) + off; }
        const int nig = WGM * nN, gid = wgid / nig, fm = gid * WGM, gsz = (nM - fm) < WGM ? (nM - fm) : WGM;
        u.pm = fm + ((wgid % nig) % gsz); u.pn = (wgid % nig) / gsz; return true;
    }
    __device__ __forceinline__ void a_ready(const Unit&) const {}
    __device__ __forceinline__ void done(const Unit&) const {}
};
template <class Epi, class Sched, bool ALIGN_EPI = false, bool SP2 = false>
__device__ __forceinline__ void gemm_phase(PG8_LAS unsigned char* lds, const Gemm g, const Sched& S, const Epi& E) {
    const int tid = threadIdx.x, wid = __builtin_amdgcn_readfirstlane(tid >> 6), lane = tid & 63, wr = wid >> 2, wc = wid & 3, fr = lane & 15, fq = lane >> 4;
    const int K = g.K, nt = K / BK;
    unsigned voffA[2], voffB[2];
#pragma unroll
    for (int i = 0; i < 2; ++i) { int R, C; stage_rc(tid * 16 + i * 8192, R, C); const int Rb = Epi::PERM ? ((R & ~31) + perm32(R & 31)) : R;
        voffA[i] = (unsigned)(R * g.lda + C) * 2u; voffB[i] = (unsigned)(Rb * g.ldb + C) * 2u; }
    const size_t kstep = (size_t)(BK * 2);
    const size_t hstepA = (size_t)HALF * g.lda * 2, hstepB = (size_t)HALF * g.ldb * 2;
    const size_t tstepA = 2 * hstepA, tstepB = 2 * hstepB;
    const unsigned ldsw = (unsigned)wid * 1024u;
    const int aoff = lds_byte(wr * 64 + fr, fq * 8), boff = lds_byte(wc * 32 + fr, fq * 8);
#define PG8_SA(b, h) (((b) * 2 + (h)) * HTB)
#define PG8_SB(b, h) ((4 + (b) * 2 + (h)) * HTB)
#define PG8_STAGE(bufoff, gbase, voff) do { _Pragma("unroll") for (int _i = 0; _i < 2; ++_i) \
        __builtin_amdgcn_global_load_lds((const unsigned*)((const char*)(gbase) + (voff)[_i]), (PG8_LAS unsigned*)(lds + (bufoff) + ldsw + _i * 8192), 16, 0, 0); } while (0)
#define PG8_LDA(dst, b, h) do { _Pragma("unroll") for (int m = 0; m < 4; ++m) _Pragma("unroll") for (int k = 0; k < 2; ++k) dst[m][k] = *(const PG8_LAS bf16x8*)(lds + PG8_SA(b, h) + aoff + m * 2048 + k * 1024); } while (0)
#define PG8_LDB(dst, b, h) do { _Pragma("unroll") for (int n = 0; n < 2; ++n) _Pragma("unroll") for (int k = 0; k < 2; ++k) dst[n][k] = *(const PG8_LAS bf16x8*)(lds + PG8_SB(b, h) + boff + n * 2048 + k * 1024); } while (0)
#define PG8_MMA(ai, bj, At, Bt) do { __builtin_amdgcn_s_setprio(1); _Pragma("unroll") for (int m = 0; m < 4; ++m) _Pragma("unroll") for (int n = 0; n < 2; ++n) _Pragma("unroll") for (int k = 0; k < 2; ++k) \
        acc[ai][bj][m][n] = __builtin_amdgcn_mfma_f32_16x16x32_bf16(Bt[n][k], At[m][k], acc[ai][bj][m][n], 0, 0, 0); __builtin_amdgcn_s_setprio(0); } while (0)
#define PG8_WAIT_V(n) asm volatile("s_waitcnt vmcnt(" #n ")" ::: "memory")
#define PG8_WAIT_L(n) asm volatile("s_waitcnt lgkmcnt(" #n ")" ::: "memory")
#define PG8_BAR __builtin_amdgcn_s_barrier()
#define PG8_SCHED __builtin_amdgcn_sched_barrier(0)
    Unit cur, nxt; int ui = 0;
    if (!S.next(0, cur)) return;
    f32x4 acc[2][2][4][2];
#pragma unroll
    for (int a = 0; a < 2; ++a)
#pragma unroll
        for (int b = 0; b < 2; ++b)
#pragma unroll
            for (int m = 0; m < 4; ++m)
#pragma unroll
                for (int n = 0; n < 2; ++n) acc[a][b][m][n] = (f32x4){0.f, 0.f, 0.f, 0.f};
    bf16x8 At[4][2], B0[2][2], B1[2][2];
    const char* cA = (const char*)g.A + (size_t)cur.pm * tstepA; const char* cB = (const char*)g.Bt + (size_t)cur.pn * tstepB;
    S.a_ready(cur);
    if constexpr (SP2) {
        PG8_STAGE(PG8_SB(0, 0), cB, voffB); PG8_STAGE(PG8_SB(0, 1), cB + hstepB, voffB); PG8_STAGE(PG8_SA(0, 0), cA, voffA); PG8_STAGE(PG8_SA(0, 1), cA + hstepA, voffA);
        if (wr == 1) PG8_BAR;
        PG8_WAIT_V(2); PG8_BAR;
        PG8_STAGE(PG8_SB(1, 0), cB + kstep, voffB); PG8_STAGE(PG8_SA(1, 0), cA + kstep, voffA); PG8_STAGE(PG8_SB(1, 1), cB + hstepB + kstep, voffB);
        PG8_WAIT_V(6); PG8_BAR;
    } else {
        PG8_STAGE(PG8_SB(0, 0), cB, voffB); PG8_STAGE(PG8_SA(0, 0), cA, voffA); PG8_STAGE(PG8_SB(0, 1), cB + hstepB, voffB); PG8_STAGE(PG8_SA(0, 1), cA + hstepA, voffA);
        if (wr == 1) PG8_BAR;
        PG8_WAIT_V(4); PG8_BAR;
        PG8_STAGE(PG8_SB(1, 0), cB + kstep, voffB); PG8_STAGE(PG8_SA(1, 0), cA + kstep, voffA); PG8_STAGE(PG8_SB(1, 1), cB + hstepB + kstep, voffB);
        PG8_WAIT_V(6); PG8_BAR;
    }
    for (;;) {
        const bool has_next = S.next(ui + 1, nxt);
        const char* nA = has_next ? (const char*)g.A + (size_t)nxt.pm * tstepA : cA; const char* nB = has_next ? (const char*)g.Bt + (size_t)nxt.pn * tstepB : cB;
        for (int t = 0; t < nt; t += 2) {
            const bool last = (t == nt - 2);
            const char* a1 = cA + (size_t)(t + 1) * kstep;
            const char* a2 = last ? nA : cA + (size_t)(t + 2) * kstep; const char* b2 = last ? nB : cB + (size_t)(t + 2) * kstep;
            const char* a3 = a2 + kstep; const char* b3 = b2 + kstep;
            if (last && has_next) S.a_ready(nxt);
            if constexpr (SP2) {
            PG8_LDB(B0, 0, 0); PG8_LDB(B1, 0, 1); PG8_SCHED; PG8_LDA(At, 0, 0); PG8_STAGE(PG8_SA(1, 1), a1 + hstepA, voffA);
            PG8_WAIT_V(8); PG8_WAIT_L(0); PG8_BAR; PG8_MMA(0, 0, At, B0); PG8_MMA(0, 1, At, B1); PG8_BAR; PG8_SCHED;
            PG8_LDA(At, 0, 1); PG8_STAGE(PG8_SB(0, 0), b2, voffB); PG8_STAGE(PG8_SB(0, 1), b2 + hstepB, voffB); PG8_STAGE(PG8_SA(0, 0), a2, voffA);
            PG8_WAIT_V(8); PG8_WAIT_L(0); PG8_BAR; PG8_MMA(1, 0, At, B0); PG8_MMA(1, 1, At, B1); PG8_BAR; PG8_SCHED;
            PG8_LDB(B0, 1, 0); PG8_LDB(B1, 1, 1); PG8_SCHED; PG8_LDA(At, 1, 0); PG8_STAGE(PG8_SA(0, 1), a2 + hstepA, voffA);
            PG8_WAIT_V(8); PG8_WAIT_L(0); PG8_BAR; PG8_MMA(0, 0, At, B0); PG8_MMA(0, 1, At, B1); PG8_BAR; PG8_SCHED;
            PG8_LDA(At, 1, 1); PG8_STAGE(PG8_SB(1, 0), b3, voffB); PG8_STAGE(PG8_SB(1, 1), b3 + hstepB, voffB); PG8_STAGE(PG8_SA(1, 0), a3, voffA);
            PG8_WAIT_V(8); PG8_WAIT_L(0); PG8_BAR; PG8_MMA(1, 0, At, B0); PG8_MMA(1, 1, At, B1); PG8_BAR; PG8_SCHED;
            } else {
            PG8_LDB(B0, 0, 0); PG8_SCHED; PG8_LDA(At, 0, 0); PG8_STAGE(PG8_SA(1, 1), a1 + hstepA, voffA);
            PG8_WAIT_L(8); PG8_BAR; PG8_WAIT_L(0); PG8_MMA(0, 0, At, B0); PG8_BAR; PG8_SCHED;
            PG8_LDB(B1, 0, 1); PG8_STAGE(PG8_SB(0, 0), b2, voffB);
            PG8_BAR; PG8_WAIT_L(0); PG8_MMA(0, 1, At, B1); PG8_BAR;
            PG8_LDA(At, 0, 1); PG8_STAGE(PG8_SA(0, 0), a2, voffA);
            PG8_BAR; PG8_WAIT_L(0); PG8_MMA(1, 0, At, B0); PG8_BAR; PG8_SCHED;
            PG8_STAGE(PG8_SB(0, 1), b2 + hstepB, voffB);
            PG8_WAIT_V(6); PG8_BAR; PG8_MMA(1, 1, At, B1); PG8_BAR;
            PG8_LDB(B0, 1, 0); PG8_SCHED; PG8_LDA(At, 1, 0); PG8_STAGE(PG8_SA(0, 1), a2 + hstepA, voffA);
            PG8_WAIT_L(8); PG8_BAR; PG8_WAIT_L(0); PG8_MMA(0, 0, At, B0); PG8_BAR; PG8_SCHED;
            PG8_LDB(B1, 1, 1); PG8_STAGE(PG8_SB(1, 0), b3, voffB);
            PG8_BAR; PG8_WAIT_L(0); PG8_MMA(0, 1, At, B1); PG8_BAR;
            PG8_LDA(At, 1, 1); PG8_STAGE(PG8_SA(1, 0), a3, voffA);
            PG8_BAR; PG8_WAIT_L(0); PG8_MMA(1, 0, At, B0); PG8_BAR; PG8_SCHED;
            PG8_STAGE(PG8_SB(1, 1), b3 + hstepB, voffB);
            PG8_WAIT_V(6); PG8_BAR; PG8_MMA(1, 1, At, B1); PG8_BAR;
            }
        }
        if constexpr (ALIGN_EPI) { if (wr == 0) PG8_BAR; }
        if constexpr (!Epi::AFTER_DRAIN) { E(acc, cur, wr, wc, fr, fq); S.done(cur); }
        if (!has_next) break;
#pragma unroll
        for (int a = 0; a < 2; ++a)
#pragma unroll
            for (int b = 0; b < 2; ++b)
#pragma unroll
                for (int m = 0; m < 4; ++m)
#pragma unroll
                    for (int n = 0; n < 2; ++n) acc[a][b][m][n] = (f32x4){0.f, 0.f, 0.f, 0.f};
        cur = nxt; cA = nA; cB = nB; ++ui;
        if constexpr (ALIGN_EPI) { if (wr == 1) PG8_BAR; }
    }
    PG8_WAIT_V(0);
    if constexpr (!ALIGN_EPI) { if (wr == 0) PG8_BAR; }
    PG8_BAR;
    if constexpr (Epi::AFTER_DRAIN) { E.fused(acc, cur, wr, wc, fr, fq, lds, wid, lane); S.done(cur); }
#undef PG8_SA
#undef PG8_SB
#undef PG8_STAGE
#undef PG8_LDA
#undef PG8_LDB
#undef PG8_MMA
#undef PG8_WAIT_V
#undef PG8_WAIT_L
#undef PG8_BAR
#undef PG8_SCHED
}
}
#define LAS __attribute__((address_space(3)))
typedef unsigned short bf16_t;
typedef short bf16x8 __attribute__((ext_vector_type(8)));
typedef short s16x4 __attribute__((ext_vector_type(4)));
typedef float f32x4 __attribute__((ext_vector_type(4)));
typedef float f32x16 __attribute__((ext_vector_type(16)));
typedef unsigned u32x4 __attribute__((ext_vector_type(4)));
typedef unsigned u32x2 __attribute__((ext_vector_type(2)));
typedef float f32x2_t __attribute__((ext_vector_type(2)));
typedef __bf16 bf16x2_t __attribute__((ext_vector_type(2)));

constexpr int DM = 1024, MTOT = 32768, SEQP = 16384, SEQS = 2048;
constexpr int NTHR = 512;
constexpr float EPS = 1e-6f, SUBLN_EPS = 1e-5f, LOG2E = 1.4426950408889634f;
constexpr float QSCALE = 0.125f * LOG2E;
constexpr int LDS_TOTAL = 131072;

__device__ __attribute__((aligned(256))) bf16_t g_w0t[4096 * 1024];
__device__ __attribute__((aligned(256))) bf16_t g_wo0t[1024 * 1024];
__device__ __attribute__((aligned(256))) bf16_t g_ws1[1024 * 1024];
__device__ __attribute__((aligned(256))) bf16_t g_w1t[3072 * 1024];
__device__ __attribute__((aligned(256))) bf16_t g_wo1t[1024 * 1024];
__device__ __attribute__((aligned(256))) bf16_t g_tab128[256 * 128];
__device__ __attribute__((aligned(256))) bf16_t g_tab16[32 * 32];
__device__ __attribute__((aligned(256))) float g_r0[MTOT];
__device__ __attribute__((aligned(256))) float g_ss1[MTOT];
__device__ __attribute__((aligned(256))) float g_ss2[MTOT];
__device__ __attribute__((aligned(256))) unsigned g_nrm[64];
__device__ __attribute__((aligned(256))) unsigned g_ctr[4];

struct Params {
    const float* xp; const float* xs; const float* attn_norm; const float* w_in0; const float* lq1; const float* lk1; const float* lq2; const float* lk2;
    const float* subln; const float* w_out0; const float* fnet_norm; const float* w_in1; const float* w_out1; const float* final_norm;
    float* out; unsigned char* ws;
};

__device__ __forceinline__ unsigned pk2(float lo, float hi) { f32x2_t v = {lo, hi}; bf16x2_t b = __builtin_convertvector(v, bf16x2_t); return __builtin_bit_cast(unsigned, b); }
__device__ __forceinline__ float bf_lo(unsigned u) { return __uint_as_float(u << 16); }
__device__ __forceinline__ float bf_hi(unsigned u) { return __uint_as_float(u & 0xffff0000u); }
__device__ __forceinline__ float wave_sum(float v) { v += __shfl_xor(v, 32); v += __shfl_xor(v, 16); v += __shfl_xor(v, 8); v += __shfl_xor(v, 4); v += __shfl_xor(v, 2); v += __shfl_xor(v, 1); return v; }
__device__ __forceinline__ float silu_f(float z) { return z / (1.0f + __expf(-z)); }
__device__ __forceinline__ int crow(int r, int hi) { return (r & 3) + 8 * (r >> 2) + 4 * hi; }
#define BLK_SYNC() __syncthreads()

struct EpiRowBf16 {
    static constexpr bool PERM = true, AFTER_DRAIN = false;
    bf16_t* b0; bf16_t* b1; bf16_t* b2; bf16_t* b3; int ld0, ld1; int split_cols; const float* rstat; int stat_is_sumsq; float scale0; unsigned* nrm;
    __device__ __forceinline__ void operator()(const pg8::f32x4 (&acc)[2][2][4][2], const pg8::Unit& u, int wr, int wc, int fr, int fq) const {
        const int row0 = u.pm * 256 + wr * 64 + fr; int colt = u.pn * 256; const int t = colt / split_cols; colt -= t * split_cols;
        bf16_t* b = (t == 0) ? b0 : (t == 1) ? b1 : (t == 2) ? b2 : b3; const int ld = (t == 0) ? ld0 : ld1; const float sc = (t == 0) ? scale0 : 1.0f;
        const int col0 = colt + wc * 32 + 8 * fq; const bool donrm = (nrm != nullptr) && (t < 2); float mx[2] = {0.f, 0.f};
#pragma unroll
        for (int ai = 0; ai < 2; ++ai)
#pragma unroll
            for (int m = 0; m < 4; ++m) {
                const int row = row0 + ai * 128 + m * 16; float rs = rstat[row];
                if (stat_is_sumsq) rs = rsqrtf(rs * (1.0f / 1024.0f) + EPS);
                rs *= sc; bf16_t* rowp = b + (size_t)row * ld + col0;
#pragma unroll
                for (int bj = 0; bj < 2; ++bj) { const pg8::f32x4 v0 = acc[ai][bj][m][0] * rs, v1 = acc[ai][bj][m][1] * rs;
                    u32x4 w; w.x = pk2(v0[0], v0[1]); w.y = pk2(v0[2], v0[3]); w.z = pk2(v1[0], v1[1]); w.w = pk2(v1[2], v1[3]);
                    *(u32x4*)(rowp + bj * 128) = w;
                    if (donrm) { float ps = (v0[0] * v0[0] + v0[1] * v0[1]) + (v0[2] * v0[2] + v0[3] * v0[3]) + (v1[0] * v1[0] + v1[1] * v1[1]) + (v1[2] * v1[2] + v1[3] * v1[3]);
                        ps += __shfl_xor(ps, 16); ps += __shfl_xor(ps, 32); mx[bj] = fmaxf(mx[bj], ps); } }
            }
        if (donrm) {
#pragma unroll
            for (int bj = 0; bj < 2; ++bj) { float v = mx[bj]; v = fmaxf(v, __shfl_xor(v, 1)); v = fmaxf(v, __shfl_xor(v, 2)); v = fmaxf(v, __shfl_xor(v, 4)); v = fmaxf(v, __shfl_xor(v, 8));
                if ((threadIdx.x & 63) == 0) atomicMax(nrm + t * 32 + ((colt + bj * 128 + wc * 32) >> 6) * 2 + (wc & 1), __float_as_uint(v)); }
        }
    }
};
struct EpiFold {
    static constexpr bool PERM = true, AFTER_DRAIN = false;
    bf16_t* O; int g;
    __device__ __forceinline__ void operator()(const pg8::f32x4 (&acc)[2][2][4][2], const pg8::Unit& u, int wr, int wc, int fr, int fq) const {
        const int col0 = u.pn * 256 + wc * 32 + 8 * fq;
#pragma unroll
        for (int ai = 0; ai < 2; ++ai)
#pragma unroll
            for (int m = 0; m < 4; ++m) {
                const int j = wr * 64 + m * 16 + fr; bf16_t* rowp = O + (size_t)(ai * 1024 + g * 128 + j) * 1024 + col0;
#pragma unroll
                for (int bj = 0; bj < 2; ++bj) { const pg8::f32x4 v0 = acc[ai][bj][m][0], v1 = acc[ai][bj][m][1];
                    u32x4 w; w.x = pk2(v0[0], v0[1]); w.y = pk2(v0[2], v0[3]); w.z = pk2(v1[0], v1[1]); w.w = pk2(v1[2], v1[3]);
                    *(u32x4*)(rowp + bj * 128) = w; }
            }
    }
};
struct EpiResid {
    static constexpr bool PERM = false, AFTER_DRAIN = false;
    const float* resA; const float* resB; float* out; bf16_t* outb; float* ss;
    __device__ __forceinline__ void operator()(const pg8::f32x4 (&acc)[2][2][4][2], const pg8::Unit& u, int wr, int wc, int fr, int fq) const {
        const int row0 = u.pm * 256 + wr * 64 + fr; const int col0 = u.pn * 256 + wc * 32 + 4 * fq;
#pragma unroll
        for (int ai = 0; ai < 2; ++ai)
#pragma unroll
            for (int m = 0; m < 4; ++m) {
                const int row = row0 + ai * 128 + m * 16;
                const float* rp = (row < SEQP) ? (resA + (size_t)row * DM) : (resB + (size_t)(row - SEQP) * DM);
                float s = 0.f;
#pragma unroll
                for (int bj = 0; bj < 2; ++bj)
#pragma unroll
                    for (int n = 0; n < 2; ++n) { const int col = col0 + bj * 128 + n * 16;
                        const pg8::f32x4 r = *(const pg8::f32x4*)(rp + col); const pg8::f32x4 v = r + acc[ai][bj][m][n];
                        *(pg8::f32x4*)(out + (size_t)row * DM + col) = v;
                        if (outb) { u32x2 w; w.x = pk2(v[0], v[1]); w.y = pk2(v[2], v[3]); *(u32x2*)(outb + (size_t)row * DM + col) = w; }
                        s += (v[0] * v[0] + v[1] * v[1]) + (v[2] * v[2] + v[3] * v[3]); }
                s += __shfl_xor(s, 16); s += __shfl_xor(s, 32);
                if (fq == 0) atomicAdd(ss + row, s);
            }
    }
};
struct OneUnit { int pn; __device__ bool next(int i, pg8::Unit& u) const { if (i > 0) return false; u.pm = 0; u.pn = pn; return true; }
    __device__ __forceinline__ void a_ready(const pg8::Unit&) const {} __device__ __forceinline__ void done(const pg8::Unit&) const {} };

__device__ __forceinline__ void transpose_item(const float* W, int ldw, const float* gain, bf16_t* WT, LAS float* scr, int item, int nblk, int lane) {
    const int kb = item / nblk, nb = item % nblk, k0 = 64 * kb, n0 = 32 * nb;
#pragma unroll 8
    for (int i = 0; i < 32; ++i) { const int kk = 2 * i + (lane >> 5); const float gk = gain ? gain[k0 + kk] : 1.0f; scr[kk * 33 + (lane & 31)] = W[(size_t)(k0 + kk) * ldw + n0 + (lane & 31)] * gk; }
    asm volatile("s_waitcnt lgkmcnt(0)" ::: "memory");
    const int c = lane & 7;
#pragma unroll
    for (int j = 0; j < 4; ++j) { const int n = (lane >> 3) + 8 * j; const LAS float* s = scr + (8 * c) * 33 + n;
        u32x4 o; o.x = pk2(s[0 * 33], s[1 * 33]); o.y = pk2(s[2 * 33], s[3 * 33]); o.z = pk2(s[4 * 33], s[5 * 33]); o.w = pk2(s[6 * 33], s[7 * 33]);
        *(u32x4*)(WT + (size_t)(n0 + n) * 1024 + k0 + 8 * c) = o; }
    asm volatile("s_waitcnt lgkmcnt(0)" ::: "memory");
}

__device__ __forceinline__ void phase0(const Params& p, LAS unsigned char* lds, bf16_t* XB) {
    const int tid = threadIdx.x, lane = tid & 63, wave = tid >> 6;
    const int gw = blockIdx.x * 8 + wave, NGW = gridDim.x * 8;
    for (int row = gw; row < MTOT; row += NGW) {
        const float* xr = (row < SEQP) ? (p.xp + (size_t)row * DM) : (p.xs + (size_t)(row - SEQP) * DM);
        f32x4 v[4]; float ss = 0.f;
#pragma unroll
        for (int i = 0; i < 4; ++i) { v[i] = *(const f32x4*)(xr + 4 * (lane + 64 * i)); ss += (v[i][0] * v[i][0] + v[i][1] * v[i][1]) + (v[i][2] * v[i][2] + v[i][3] * v[i][3]); }
        ss = wave_sum(ss);
        if (lane == 0) g_r0[row] = rsqrtf(ss * (1.0f / 1024.0f) + EPS);
#pragma unroll
        for (int i = 0; i < 4; ++i) { u32x2 w; w.x = pk2(v[i][0], v[i][1]); w.y = pk2(v[i][2], v[i][3]); *(u32x2*)(XB + (size_t)row * DM + 4 * (lane + 64 * i)) = w; }
    }
    for (int i = blockIdx.x * NTHR + tid; i < MTOT; i += gridDim.x * NTHR) { g_ss1[i] = 0.f; g_ss2[i] = 0.f; }
    if (blockIdx.x == 0 && tid < 64) { g_nrm[tid] = 0u; if (tid < 4) g_ctr[tid] = 0u; }
    LAS float* scr = (LAS float*)(lds + wave * 8704);
    constexpr int I0 = 16 * 128, I1 = 16 * 32, NIT = I0 + 3 * I1;
    for (int it = gw; it < NIT; it += NGW) {
        int r = it;
        if (r < I0) { transpose_item(p.w_in0, 4096, p.attn_norm, g_w0t, scr, r, 128, lane); continue; } r -= I0;
        if (r < I1) { transpose_item(p.w_out0, 1024, nullptr, g_wo0t, scr, r, 32, lane); continue; } r -= I1;
        if (r < I1) { transpose_item(p.w_in1 + 1024, 2048, p.fnet_norm, g_w1t + (size_t)2048 * 1024, scr, r, 32, lane); continue; } r -= I1;
        transpose_item(p.w_out1, 1024, nullptr, g_wo1t, scr, r, 32, lane);
    }
    for (int i = blockIdx.x * NTHR + tid; i < 1024 * 256; i += gridDim.x * NTHR) {
        const int k = i >> 8, c4 = (i & 255) * 4; const f32x4 w = *(const f32x4*)(p.w_in1 + (size_t)k * 2048 + c4); const float gk = p.fnet_norm[k];
        u32x2 o; o.x = pk2(w[0] * gk, w[1] * gk); o.y = pk2(w[2] * gk, w[3] * gk); *(u32x2*)(g_ws1 + (size_t)k * 1024 + c4) = o;
    }
    for (int i = blockIdx.x * NTHR + tid; i < 256 * 128; i += gridDim.x * NTHR) {
        const int rr = i >> 7, n = i & 127, k = rr & 127, part = rr >> 7; const float th = (float)((k * n) & 127) * (6.283185307179586f / 128.0f);
        const float v = part ? sinf(th) : cosf(th); g_tab128[i] = (bf16_t)(pk2(v, 0.f) & 0xffffu);
    }
    for (int i = blockIdx.x * NTHR + tid; i < 32 * 32; i += gridDim.x * NTHR) {
        const int kk = i >> 5, j = i & 31, k1 = kk & 15, po = kk >> 4, n1 = j & 15, pi = j >> 4; const float th = (float)((k1 * n1) & 15) * (6.283185307179586f / 16.0f);
        float v; if (po == 0) v = pi ? -sinf(th) : cosf(th); else v = pi ? -cosf(th) : -sinf(th);
        g_tab16[i] = (bf16_t)(pk2(v, 0.f) & 0xffffu);
    }
}

constexpr int AT_KP = 144, AT_VP = 320, AT_K2 = 64 * AT_KP, AT_V = 2 * 64 * AT_KP, AT_STAGE = AT_V + 64 * AT_VP, AT_XP = 528;
typedef short v4i16_t __attribute__((ext_vector_type(4)));
__device__ __forceinline__ s16x4 tr_read(LAS const unsigned char* p) { return __builtin_bit_cast(s16x4, __builtin_amdgcn_ds_read_tr16_b64_v4i16((LAS v4i16_t*)p)); }
__device__ __forceinline__ bf16x8 cat8(s16x4 a, s16x4 b) { return (bf16x8){a[0], a[1], a[2], a[3], b[0], b[1], b[2], b[3]}; }
__device__ __forceinline__ bf16x8 neg8(bf16x8 a) { typedef int i32x4 __attribute__((ext_vector_type(4))); i32x4 v = __builtin_bit_cast(i32x4, a); v = v ^ (int)0x80008000; return __builtin_bit_cast(bf16x8, v); }
#define MFMA32(a, b, c) __builtin_amdgcn_mfma_f32_32x32x16_bf16((a), (b), (c), 0, 0, 0)

__device__ __forceinline__ void attn_phase(const Params& p, LAS unsigned char* lds, bf16_t* Qb, const bf16_t* Kb, const bf16_t* Vb, const bf16_t* Zb) {
    const int tid = threadIdx.x, lane = tid & 63, wave = __builtin_amdgcn_readfirstlane(tid >> 6), r32 = lane & 31, hi = lane >> 5;
    const int map = wave >> 2, qs = wave & 3;
    float lam;
    { const float a = wave_sum(p.lq1[lane] * p.lk1[lane]), b = wave_sum(p.lq2[lane] * p.lk2[lane]); lam = expf(a) - expf(b) + 0.2f; }
    const int g16 = lane >> 4, i16 = lane & 15, tq = i16 >> 2, tp = i16 & 3;
    LAS unsigned* qword = (LAS unsigned*)(lds + 2 * AT_STAGE);
    for (;;) {
        if (tid == 0) *qword = atomicAdd(&g_ctr[0], 1u);
        BLK_SYNC();
        const int unit = (int)*qword;
        if (unit >= 2048) break;
        int R0s, S, h, q0;
        if (unit < 1024) { R0s = 0; S = SEQP; h = 7 - (unit >> 7); q0 = (unit & 127) * 128; }
        else { const int v = unit - 1024; h = 7 - (v >> 7); R0s = SEQP + ((v >> 4) & 7) * SEQS; S = SEQS; q0 = (v & 15) * 128; }
        const float slope2 = exp2f(-(float)(h + 1)) * LOG2E;
        int t_lo, t_hi;
        { float B2 = 0.f;
#pragma unroll
          for (int mm = 0; mm < 2; ++mm) { const int e = (2 * h + mm) * 2;
              const float qn2 = __uint_as_float(g_nrm[e]) + __uint_as_float(g_nrm[e + 1]), kn2 = __uint_as_float(g_nrm[32 + e]) + __uint_as_float(g_nrm[32 + e + 1]);
              B2 = fmaxf(B2, sqrtf(qn2 * kn2) * 1.02f); }
          const float thr = 2.0f * B2 + 25.0f - log2f(1.0f - exp2f(-slope2));
          const float dminf = fminf(ceilf(thr / slope2), 1.0e6f); const int dmin = (int)dminf;
          const int NTL = S / 64; int lo = q0 - dmin + 1; lo = lo < 0 ? 0 : lo; int hiK = q0 + 127 + dmin - 1; hiK = hiK > S - 1 ? S - 1 : hiK;
          t_lo = lo >> 6; t_hi = hiK >> 6; if (t_hi > NTL - 1) t_hi = NTL - 1; }
        const int qrow = R0s + q0 + qs * 32 + r32;
        bf16x8 qf[4];
        { const bf16_t* qp = Qb + (size_t)qrow * DM + h * 128 + map * 64 + hi * 8;
#pragma unroll
          for (int st = 0; st < 4; ++st) qf[st] = *(const bf16x8*)(qp + st * 16); }
        const float nslope2 = -slope2;
        const float qposf = (float)(q0 + qs * 32 + r32 - 4 * hi);
        float l = 0.f;
        f32x16 o[4];
#pragma unroll
        for (int db = 0; db < 4; ++db)
#pragma unroll
            for (int r = 0; r < 16; ++r) o[db][r] = 0.f;
        const bf16_t* gsrc[4]; int ldst[4];
#pragma unroll
        for (int i = 0; i < 4; ++i) { const int c = tid + 512 * i;
            if (i < 2) { const int row = c >> 4, ch = c & 15; gsrc[i] = Kb + (size_t)(R0s + t_lo * 64 + row) * DM + h * 128 + ch * 8; ldst[i] = (ch >> 3) * AT_K2 + row * AT_KP + (ch & 7) * 16; }
            else { const int c2 = c - 1024, row = c2 >> 4, ch = c2 & 15; gsrc[i] = Vb + (size_t)(R0s + t_lo * 64 + row) * DM + h * 128 + ch * 8; ldst[i] = AT_V + row * AT_VP + ch * 16; } }
        u32x4 stg[4];
#pragma unroll
        for (int i = 0; i < 4; ++i) stg[i] = *(const u32x4*)(gsrc[i]);
#pragma unroll
        for (int i = 0; i < 4; ++i) *(LAS u32x4*)(lds + ldst[i]) = stg[i];
        BLK_SYNC();
        const int ntl = t_hi - t_lo + 1;
        for (int tt = 0; tt < ntl; ++tt) {
            const int stage = tt & 1;
            if (tt + 1 < ntl) {
#pragma unroll
                for (int i = 0; i < 4; ++i) stg[i] = *(const u32x4*)(gsrc[i] + (size_t)(tt + 1) * 64 * DM);
            }
            LAS const unsigned char* Kt = lds + stage * AT_STAGE + map * AT_K2 + r32 * AT_KP + hi * 16;
            f32x16 s0, s1;
#pragma unroll
            for (int r = 0; r < 16; ++r) { s0[r] = 0.f; s1[r] = 0.f; }
#pragma unroll
            for (int st = 0; st < 4; ++st) {
                const bf16x8 a0 = *(LAS const bf16x8*)(Kt + st * 32), a1 = *(LAS const bf16x8*)(Kt + 32 * AT_KP + st * 32);
                s0 = MFMA32(a0, qf[st], s0); s1 = MFMA32(a1, qf[st], s1);
            }
            const float d0 = qposf - (float)((t_lo + tt) * 64);
            float rs = 0.f;
#pragma unroll
            for (int r = 0; r < 16; ++r) { const float c = (float)((r & 3) + 8 * (r >> 2));
                s0[r] = __builtin_amdgcn_exp2f(__builtin_fmaf(nslope2, fabsf(d0 - c), s0[r]));
                s1[r] = __builtin_amdgcn_exp2f(__builtin_fmaf(nslope2, fabsf(d0 - (32.0f + c)), s1[r]));
                rs += s0[r] + s1[r]; }
            l += rs;
            bf16x8 pf[2][2];
#pragma unroll
            for (int s = 0; s < 2; ++s) {
                u32x4 w0, w1;
                w0.x = pk2(s0[8 * s + 0], s0[8 * s + 1]); w0.y = pk2(s0[8 * s + 2], s0[8 * s + 3]); w0.z = pk2(s0[8 * s + 4], s0[8 * s + 5]); w0.w = pk2(s0[8 * s + 6], s0[8 * s + 7]);
                w1.x = pk2(s1[8 * s + 0], s1[8 * s + 1]); w1.y = pk2(s1[8 * s + 2], s1[8 * s + 3]); w1.z = pk2(s1[8 * s + 4], s1[8 * s + 5]); w1.w = pk2(s1[8 * s + 6], s1[8 * s + 7]);
                pf[0][s] = __builtin_bit_cast(bf16x8, w0); pf[1][s] = __builtin_bit_cast(bf16x8, w1);
            }
            LAS const unsigned char* vbase = lds + stage * AT_STAGE + AT_V + (4 * hi + tq) * AT_VP + (16 * (g16 & 1) + 4 * tp) * 2;
#pragma unroll
            for (int db = 0; db < 4; ++db)
#pragma unroll
                for (int kb = 0; kb < 2; ++kb)
#pragma unroll
                    for (int s = 0; s < 2; ++s) {
                        LAS const unsigned char* a = vbase + (kb * 32 + 16 * s) * AT_VP + db * 64;
                        const bf16x8 vf = cat8(tr_read(a), tr_read(a + 8 * AT_VP));
                        o[db] = MFMA32(vf, pf[kb][s], o[db]);
                    }
            if (tt + 1 < ntl) {
#pragma unroll
                for (int i = 0; i < 4; ++i) *(LAS u32x4*)(lds + (stage ^ 1) * AT_STAGE + ldst[i]) = stg[i];
            }
            BLK_SYNC();
        }
        l += __shfl_xor(l, 32);
        const float inv = 1.0f / l;
#pragma unroll
        for (int db = 0; db < 4; ++db)
#pragma unroll
            for (int r = 0; r < 16; ++r) o[db][r] *= inv;
        LAS unsigned char* xq = lds + (qs * 32 + r32) * AT_XP;
        if (map == 1) {
#pragma unroll
            for (int db = 0; db < 4; ++db)
#pragma unroll
                for (int rg = 0; rg < 4; ++rg) { const int d = 32 * db + 8 * rg + 4 * hi;
                    *(LAS f32x4*)(xq + d * 4) = (f32x4){o[db][4 * rg], o[db][4 * rg + 1], o[db][4 * rg + 2], o[db][4 * rg + 3]}; }
        }
        BLK_SYNC();
        if (map == 0) {
            float ss = 0.f;
#pragma unroll
            for (int db = 0; db < 4; ++db)
#pragma unroll
                for (int rg = 0; rg < 4; ++rg) { const int d = 32 * db + 8 * rg + 4 * hi; const f32x4 o2 = *(LAS const f32x4*)(xq + d * 4);
#pragma unroll
                    for (int e = 0; e < 4; ++e) { const float v = o[db][4 * rg + e] - lam * o2[e]; o[db][4 * rg + e] = v; ss += v * v; } }
            ss += __shfl_xor(ss, 32);
            const float rn = rsqrtf(ss * (1.0f / 128.0f) + SUBLN_EPS) * 0.8f;
            const bf16_t* zp = Zb + (size_t)qrow * DM + h * 128; bf16_t* op = Qb + (size_t)qrow * DM + h * 128;
#pragma unroll
            for (int db = 0; db < 4; ++db)
#pragma unroll
                for (int rg = 0; rg < 4; ++rg) { const int d = 32 * db + 8 * rg + 4 * hi;
                    const f32x4 gg = *(const f32x4*)(p.subln + d); const u32x2 zz = *(const u32x2*)(zp + d);
                    const float v0 = o[db][4 * rg] * rn * gg[0] * silu_f(bf_lo(zz.x)), v1 = o[db][4 * rg + 1] * rn * gg[1] * silu_f(bf_hi(zz.x));
                    const float v2 = o[db][4 * rg + 2] * rn * gg[2] * silu_f(bf_lo(zz.y)), v3 = o[db][4 * rg + 3] * rn * gg[3] * silu_f(bf_hi(zz.y));
                    u32x2 w; w.x = pk2(v0, v1); w.y = pk2(v2, v3); *(u32x2*)(op + d) = w; }
        }
        BLK_SYNC();
    }
}

constexpr int FT_P = 320;
template <int MODE> __device__ __forceinline__ void fft_rows(int unit, int& rbase, int& cc, int& a0, int& a1, int& a2) {
    cc = unit & 7;
    if (MODE == 0) { a0 = unit >> 3; rbase = 0; a1 = 0; a2 = 0; }
    else if (MODE == 1) { a0 = unit >> 7; a1 = (unit >> 3) & 15; rbase = SEQP + a0 * SEQS; a2 = 0; }
    else { if (unit < 1024) { rbase = 0; a0 = unit >> 3; a1 = 128; } else { const int v = unit - 1024; rbase = SEQP + (v >> 7) * SEQS; a0 = (v >> 3) & 15; a1 = 16; } a2 = 0; }
}
template <int MODE> __device__ __forceinline__ const bf16_t* fft_src(const bf16_t* AB, int rbase, int cc, int a0, int a1, int rho, int ch16) {
    int grow, part;
    if (MODE == 0) { part = rho >> 7; grow = (rho & 127) * 128 + a0; }
    else if (MODE == 1) { part = (rho >> 4) & 1; grow = rbase + (rho & 15) * 128 + a1 * 8 + (rho >> 5); }
    else { part = rho >> 7; grow = rbase + a0 * 128 + (rho & 127); }
    return AB + (size_t)grow * 2048 + part * 1024 + cc * 128 + ch16 * 8;
}

template <int MODE> __device__ __forceinline__ void fft_pass(LAS unsigned char* lds, bf16_t* AB, const bf16_t* Z1, bf16_t* FG, int nunits) {
    const int tid = threadIdx.x, lane = tid & 63, wave = __builtin_amdgcn_readfirstlane(tid >> 6), r32 = lane & 31, hi = lane >> 5;
    const int g16 = lane >> 4, i16 = lane & 15, tq = i16 >> 2, tp = i16 & 3;
    const int kb = wave & 3, cbh = wave >> 2;
    bf16x8 Cf[8], Sf[8];
    if (MODE != 1) {
        const int k = 32 * kb + r32;
#pragma unroll
        for (int s = 0; s < 8; ++s) { Cf[s] = *(const bf16x8*)(g_tab128 + k * 128 + 16 * s + 8 * hi); Sf[s] = *(const bf16x8*)(g_tab128 + (128 + k) * 128 + 16 * s + 8 * hi); }
    } else {
#pragma unroll
        for (int s = 0; s < 2; ++s) Cf[s] = *(const bf16x8*)(g_tab16 + r32 * 32 + 16 * s + 8 * hi);
    }
    int unit = blockIdx.x;
    if (unit >= nunits) return;
    int rbase, cc, a0, a1, a2;
    fft_rows<MODE>(unit, rbase, cc, a0, a1, a2);
    u32x4 stg[8];
#pragma unroll
    for (int i = 0; i < 8; ++i) { const int c = tid + 512 * i; stg[i] = *(const u32x4*)fft_src<MODE>(AB, rbase, cc, a0, a1, c >> 4, c & 15); }
    for (;;) {
#pragma unroll
        for (int i = 0; i < 8; ++i) { const int c = tid + 512 * i; *(LAS u32x4*)(lds + (c >> 4) * FT_P + (c & 15) * 16) = stg[i]; }
        BLK_SYNC();
        const int nunit = unit + gridDim.x; const bool has_next = nunit < nunits;
        int nrbase = 0, ncc = 0, na0 = 0, na1 = 0, na2 = 0;
        if (has_next) { fft_rows<MODE>(nunit, nrbase, ncc, na0, na1, na2);
#pragma unroll
            for (int i = 0; i < 8; ++i) { const int c = tid + 512 * i; stg[i] = *(const u32x4*)fft_src<MODE>(AB, nrbase, ncc, na0, na1, c >> 4, c & 15); } }
        if (MODE == 0) {
            const int k1 = 32 * kb + r32, n2 = a0;
            const float ph = (float)((k1 * n2) & 16383) * (1.0f / 16384.0f); const float tc = __builtin_amdgcn_cosf(ph), ts = __builtin_amdgcn_sinf(ph);
#pragma unroll 1
            for (int cbi = 0; cbi < 2; ++cbi) { const int cb = 2 * cbh + cbi;
                LAS const unsigned char* ab = lds + (8 * hi + tq) * FT_P + (32 * cb + 16 * (g16 & 1) + 4 * tp) * 2;
                f32x16 yr, yi;
#pragma unroll
                for (int r = 0; r < 16; ++r) { yr[r] = 0.f; yi[r] = 0.f; }
#pragma unroll
                for (int s = 0; s < 8; ++s) {
                    const bf16x8 af = cat8(tr_read(ab + (16 * s) * FT_P), tr_read(ab + (16 * s + 4) * FT_P));
                    const bf16x8 bf = cat8(tr_read(ab + (128 + 16 * s) * FT_P), tr_read(ab + (128 + 16 * s + 4) * FT_P));
                    const bf16x8 naf = neg8(af), nbf = neg8(bf);
                    yr = MFMA32(af, Cf[s], yr); yr = MFMA32(nbf, Sf[s], yr);
                    yi = MFMA32(naf, Sf[s], yi); yi = MFMA32(nbf, Cf[s], yi);
                }
                bf16_t* orow = AB + (size_t)(k1 * 128 + n2) * 2048 + cc * 128 + cb * 32 + 4 * hi;
#pragma unroll
                for (int rg = 0; rg < 4; ++rg) { float a[4], b[4];
#pragma unroll
                    for (int e = 0; e < 4; ++e) { const float vr = yr[4 * rg + e], vi = yi[4 * rg + e]; a[e] = vr * tc + vi * ts; b[e] = vi * tc - vr * ts; }
                    u32x2 w0, w1; w0.x = pk2(a[0], a[1]); w0.y = pk2(a[2], a[3]); w1.x = pk2(b[0], b[1]); w1.y = pk2(b[2], b[3]);
                    *(u32x2*)(orow + 8 * rg) = w0; *(u32x2*)(orow + 1024 + 8 * rg) = w1; }
            }
        } else if (MODE == 1) {
            const int k1 = r32 & 15, po = r32 >> 4, n2 = a1 * 8 + wave;
            const float ph = (float)((k1 * n2) & 2047) * (1.0f / 2048.0f); const float tc = __builtin_amdgcn_cosf(ph); float ts = __builtin_amdgcn_sinf(ph); if (po) ts = -ts;
#pragma unroll 1
            for (int cb = 0; cb < 4; ++cb) {
                LAS const unsigned char* ab = lds + (wave * 32 + 8 * hi + tq) * FT_P + (32 * cb + 16 * (g16 & 1) + 4 * tp) * 2;
                f32x16 y;
#pragma unroll
                for (int r = 0; r < 16; ++r) y[r] = 0.f;
                const bf16x8 f0 = cat8(tr_read(ab), tr_read(ab + 4 * FT_P)), f1 = cat8(tr_read(ab + 16 * FT_P), tr_read(ab + 20 * FT_P));
                y = MFMA32(f0, Cf[0], y); y = MFMA32(f1, Cf[1], y);
                bf16_t* orow = AB + (size_t)(rbase + k1 * 128 + n2) * 2048 + po * 1024 + cc * 128 + cb * 32 + 4 * hi;
#pragma unroll
                for (int rg = 0; rg < 4; ++rg) { float a[4];
#pragma unroll
                    for (int e = 0; e < 4; ++e) { const float own = y[4 * rg + e], oth = __shfl_xor(own, 16); a[e] = own * tc + oth * ts; }
                    u32x2 w0; w0.x = pk2(a[0], a[1]); w0.y = pk2(a[2], a[3]); *(u32x2*)(orow + 8 * rg) = w0; }
            }
        } else {
            const int k2 = 32 * kb + r32, k1 = a0, N1 = a1; const float nrm = (N1 == 128) ? 6.905339660024879e-4f : 1.953125e-3f;
            const size_t orow_i = (size_t)(rbase + k1 + N1 * k2);
#pragma unroll 1
            for (int cbi = 0; cbi < 2; ++cbi) { const int cb = 2 * cbh + cbi;
                LAS const unsigned char* ab = lds + (8 * hi + tq) * FT_P + (32 * cb + 16 * (g16 & 1) + 4 * tp) * 2;
                f32x16 y;
#pragma unroll
                for (int r = 0; r < 16; ++r) y[r] = 0.f;
#pragma unroll
                for (int s = 0; s < 8; ++s) {
                    const bf16x8 af = cat8(tr_read(ab + (16 * s) * FT_P), tr_read(ab + (16 * s + 4) * FT_P));
                    const bf16x8 bf = cat8(tr_read(ab + (128 + 16 * s) * FT_P), tr_read(ab + (128 + 16 * s + 4) * FT_P));
                    y = MFMA32(af, Cf[s], y); y = MFMA32(bf, Sf[s], y);
                }
                const bf16_t* zrow = Z1 + orow_i * DM + cc * 128 + cb * 32 + 4 * hi; bf16_t* orow = FG + orow_i * DM + cc * 128 + cb * 32 + 4 * hi;
#pragma unroll
                for (int rg = 0; rg < 4; ++rg) { const u32x2 zz = *(const u32x2*)(zrow + 8 * rg);
                    const float v0 = y[4 * rg] * nrm * silu_f(bf_lo(zz.x)), v1 = y[4 * rg + 1] * nrm * silu_f(bf_hi(zz.x));
                    const float v2 = y[4 * rg + 2] * nrm * silu_f(bf_lo(zz.y)), v3 = y[4 * rg + 3] * nrm * silu_f(bf_hi(zz.y));
                    u32x2 w; w.x = pk2(v0, v1); w.y = pk2(v2, v3); *(u32x2*)(orow + 8 * rg) = w; }
            }
        }
        BLK_SYNC();
        if (!has_next) break;
        unit = nunit; rbase = nrbase; cc = ncc; a0 = na0; a1 = na1; a2 = na2;
    }
}

#ifndef PHM
#define PHM 0xffff
#endif
__global__ void __launch_bounds__(NTHR, 2) fwd_kernel(Params p) {
    extern __shared__ __attribute__((aligned(16))) unsigned char lds_raw[];
    LAS unsigned char* lds = (LAS unsigned char*)lds_raw;
    cg::grid_group grid = cg::this_grid();
    const size_t REG = (size_t)MTOT * DM;
    bf16_t* R0 = (bf16_t*)p.ws; bf16_t* R1 = R0 + REG; bf16_t* R2 = R1 + REG; bf16_t* R3 = R2 + REG;
    bf16_t* XB = (bf16_t*)p.out;

    if (PHM & 1) phase0(p, lds, XB);
    grid.sync();
    if (PHM & 2) {
        pg8::Gemm gm{XB, g_w0t, MTOT, 4096, 1024, 1024, 1024}; pg8::StaticOrder S; S.init(MTOT, 4096, gridDim.x, blockIdx.x);
        EpiRowBf16 E{R0, R1, R2, R3, DM, DM, 1024, g_r0, 0, QSCALE, g_nrm};
        pg8::gemm_phase<EpiRowBf16, pg8::StaticOrder, true, true>(lds, gm, S, E);
    }
    grid.sync();
    if ((PHM & 512) && blockIdx.x < 32) {
        const int fu = blockIdx.x, g = fu >> 2; pg8::Gemm gm{g_tab128, g_ws1 + g * 128, 256, 1024, 128, 128, 1024}; OneUnit S{fu & 3}; EpiFold E{g_w1t, g};
        pg8::gemm_phase<EpiFold, OneUnit, false, true>(lds, gm, S, E);
    }
    if (PHM & 4) attn_phase(p, lds, R0, R1, R2, R3);
    grid.sync();
    if (PHM & 8) {
        pg8::Gemm gm{R0, g_wo0t, MTOT, 1024, 1024, 1024, 1024}; pg8::StaticOrder S; S.init(MTOT, 1024, gridDim.x, blockIdx.x);
        EpiResid E{p.xp, p.xs, p.out, R3, g_ss1};
        pg8::gemm_phase<EpiResid, pg8::StaticOrder, true, true>(lds, gm, S, E);
    }
    grid.sync();
    if (PHM & 16) {
        pg8::Gemm gm{R3, g_w1t, MTOT, 3072, 1024, 1024, 1024}; pg8::StaticOrder S; S.init(MTOT, 3072, gridDim.x, blockIdx.x);
        EpiRowBf16 E{R1, R0, R0, R0, 2048, DM, 2048, g_ss1, 1, 1.0f, nullptr};
        pg8::gemm_phase<EpiRowBf16, pg8::StaticOrder, true, true>(lds, gm, S, E);
    }
    grid.sync();
    if (PHM & 32) fft_pass<0>(lds, R1, nullptr, nullptr, 1024);
    if (PHM & 64) fft_pass<1>(lds, R1, nullptr, nullptr, 1024);
    grid.sync();
    if (PHM & 128) fft_pass<2>(lds, R1, R0, R3, 2048);
    grid.sync();
    if (PHM & 256) {
        pg8::Gemm gm{R3, g_wo1t, MTOT, 1024, 1024, 1024, 1024}; pg8::StaticOrder S; S.init(MTOT, 1024, gridDim.x, blockIdx.x);
        EpiResid E{p.out, p.out + (size_t)SEQP * DM, p.out, nullptr, g_ss2};
        pg8::gemm_phase<EpiResid, pg8::StaticOrder, true, true>(lds, gm, S, E);
    }
    grid.sync();
    const int lane = threadIdx.x & 63, wave = threadIdx.x >> 6;
    for (int row = blockIdx.x * 8 + wave; row < MTOT; row += gridDim.x * 8) {
        const float rs = rsqrtf(g_ss2[row] * (1.0f / 1024.0f) + EPS); float* orow = p.out + (size_t)row * DM;
#pragma unroll
        for (int i = 0; i < 4; ++i) { const int c = 4 * (lane + 64 * i); f32x4 v = *(const f32x4*)(orow + c); const f32x4 gg = *(const f32x4*)(p.final_norm + c);
            v[0] *= rs * gg[0]; v[1] *= rs * gg[1]; v[2] *= rs * gg[2]; v[3] *= rs * gg[3]; *(f32x4*)(orow + c) = v; }
    }
}

extern "C" void kernel_launch(void* const* d_in, const int* in_sizes, int n_in, void* d_out, int out_size, void* d_ws, size_t ws_size, hipStream_t stream) {
    static int grid = 0;
    if (grid == 0) {
        int dev = 0, cus = 0, per_cu = 0;
        if (n_in != 14 || ws_size < (size_t)4 * MTOT * DM * 2) { fprintf(stderr, "kernel_launch: unexpected problem shape (n_in %d, ws %zu)\n", n_in, ws_size); grid = -1; return; }
        hipGetDevice(&dev); hipDeviceGetAttribute(&cus, hipDeviceAttributeMultiprocessorCount, dev);
        if (hipFuncSetAttribute((const void*)fwd_kernel, hipFuncAttributeMaxDynamicSharedMemorySize, LDS_TOTAL) != hipSuccess) { fprintf(stderr, "kernel_launch: hipFuncSetAttribute failed\n"); grid = -1; return; }
        if (hipOccupancyMaxActiveBlocksPerMultiprocessor(&per_cu, (const void*)fwd_kernel, NTHR, LDS_TOTAL) != hipSuccess || per_cu < 1) { fprintf(stderr, "kernel_launch: occupancy query says %d blocks per CU\n", per_cu); per_cu = 1; }
        (void)hipGetLastError();
        grid = cus * 1;
    }
    if (grid < 0) return;
    Params p{};
    p.xp = (const float*)d_in[0]; p.xs = (const float*)d_in[1]; p.attn_norm = (const float*)d_in[2]; p.w_in0 = (const float*)d_in[3];
    p.lq1 = (const float*)d_in[4]; p.lk1 = (const float*)d_in[5]; p.lq2 = (const float*)d_in[6]; p.lk2 = (const float*)d_in[7];
    p.subln = (const float*)d_in[8]; p.w_out0 = (const float*)d_in[9]; p.fnet_norm = (const float*)d_in[10]; p.w_in1 = (const float*)d_in[11];
    p.w_out1 = (const float*)d_in[12]; p.final_norm = (const float*)d_in[13];
    p.out = (float*)d_out; p.ws = (unsigned char*)d_ws;
    void* args[] = {&p};
    const hipError_t e = hipLaunchCooperativeKernel((const void*)fwd_kernel, dim3(grid), dim3(NTHR), args, LDS_TOTAL, stream);
    if (e != hipSuccess) fprintf(stderr, "kernel_launch: cooperative launch failed: %s (grid %d)\n", hipGetErrorString(e), grid);
}
```

```cpp
#include <hip/hip_runtime.h>
#include <hip/hip_cooperative_groups.h>
#include <cstdio>
#include <cstdint>
namespace cg = cooperative_groups;
namespace pg8 {
#define PG8_LAS __attribute__((address_space(3)))
typedef unsigned short bf16_t;
typedef short bf16x8 __attribute__((ext_vector_type(8)));
typedef float f32x4 __attribute__((ext_vector_type(4)));
typedef unsigned u32x4 __attribute__((ext_vector_type(4)));
constexpr int BM = 256, BK = 64, HALF = 128, HTB = HALF * BK * 2  , STAGE_BYTES = 8 * HTB, NXCD = 8, WGM = 8;

__host__ __device__ __forceinline__ int lds_byte(int r, int c) { const int st = (r >> 4) * 2 + (c >> 5), rr = r & 15, cc = c & 31, ob = rr * 64 + cc * 2; return st * 1024 + (ob ^ (((ob >> 9) & 1) << 5)); }
__host__ __device__ __forceinline__ void stage_rc(int b, int& R, int& C) { const int st = b / 1024, sb = b % 1024, swz = sb ^ (((sb >> 9) & 1) << 5); R = (st >> 1) * 16 + swz / 64; C = (st & 1) * 32 + (swz % 64) / 2; }
__host__ __device__ __forceinline__ int perm32(int rho) { const int n = rho >> 4, i = rho & 15; return 8 * (i >> 2) + 4 * n + (i & 3); }

struct Unit { int pm, pn; };
struct Gemm { const bf16_t* A; const bf16_t* Bt; int M, N, K, lda, ldb; };

struct StaticOrder {
    int nM, nN, nwg, G, c;
    __host__ __device__ void init(int M, int N, int G_, int c_) { nM = M / BM; nN = N / BM; nwg = nM * nN; G = G_; c = c_; }
    __host__ __device__ bool next(int i, Unit& u) const {
        const long L = (long)i * G + c; if (L >= nwg) return false;
        int wgid = (int)L; { const int q = nwg / NXCD, r = nwg % NXCD, xcd = wgid % NXCD, off = wgid / NXCD; wgid = (xcd < r ? xcd * (q + 1) : r * (q + 1) + (xcd - r) * q) + off; }
        const int nig = WGM * nN, gid = wgid / nig, fm = gid * WGM, gsz = (nM - fm) < WGM ? (nM - fm) : WGM;
        u.pm = fm + ((wgid % nig) % gsz); u.pn = (wgid % nig) / gsz; return true;
    }
    __device__ __forceinline__ void a_ready(const Unit&) const {}
    __device__ __forceinline__ void done(const Unit&) const {}
};
template <class Epi, class Sched, bool ALIGN_EPI = false, bool SP2 = false>
__device__ __forceinline__ void gemm_phase(PG8_LAS unsigned char* lds, const Gemm g, const Sched& S, const Epi& E) {
    const int tid = threadIdx.x, wid = __builtin_amdgcn_readfirstlane(tid >> 6), lane = tid & 63, wr = wid >> 2, wc = wid & 3, fr = lane & 15, fq = lane >> 4;
    const int K = g.K, nt = K / BK;
    unsigned voffA[2], voffB[2];
#pragma unroll
    for (int i = 0; i < 2; ++i) { int R, C; stage_rc(tid * 16 + i * 8192, R, C); const int Rb = Epi::PERM ? ((R & ~31) + perm32(R & 31)) : R;
        voffA[i] = (unsigned)(R * g.lda + C) * 2u; voffB[i] = (unsigned)(Rb * g.ldb + C) * 2u; }
    const size_t kstep = (size_t)(BK * 2);
    const size_t hstepA = (size_t)HALF * g.lda * 2, hstepB = (size_t)HALF * g.ldb * 2;
    const size_t tstepA = 2 * hstepA, tstepB = 2 * hstepB;
    const unsigned ldsw = (unsigned)wid * 1024u;
    const int aoff = lds_byte(wr * 64 + fr, fq * 8), boff = lds_byte(wc * 32 + fr, fq * 8);
#define PG8_SA(b, h) (((b) * 2 + (h)) * HTB)
#define PG8_SB(b, h) ((4 + (b) * 2 + (h)) * HTB)
#define PG8_STAGE(bufoff, gbase, voff) do { _Pragma("unroll") for (int _i = 0; _i < 2; ++_i) \
        __builtin_amdgcn_global_load_lds((const unsigned*)((const char*)(gbase) + (voff)[_i]), (PG8_LAS unsigned*)(lds + (bufoff) + ldsw + _i * 8192), 16, 0, 0); } while (0)
#define PG8_LDA(dst, b, h) do { _Pragma("unroll") for (int m = 0; m < 4; ++m) _Pragma("unroll") for (int k = 0; k < 2; ++k) dst[m][k] = *(const PG8_LAS bf16x8*)(lds + PG8_SA(b, h) + aoff + m * 2048 + k * 1024); } while (0)
#define PG8_LDB(dst, b, h) do { _Pragma("unroll") for (int n = 0; n < 2; ++n) _Pragma("unroll") for (int k = 0; k < 2; ++k) dst[n][k] = *(const PG8_LAS bf16x8*)(lds + PG8_SB(b, h) + boff + n * 2048 + k * 1024); } while (0)
#define PG8_MMA(ai, bj, At, Bt) do { __builtin_amdgcn_s_setprio(1); _Pragma("unroll") for (int m = 0; m < 4; ++m) _Pragma("unroll") for (int n = 0; n < 2; ++n) _Pragma("unroll") for (int k = 0; k < 2; ++k) \
        acc[ai][bj][m][n] = __builtin_amdgcn_mfma_f32_16x16x32_bf16(Bt[n][k], At[m][k], acc[ai][bj][m][n], 0, 0, 0); __builtin_amdgcn_s_setprio(0); } while (0)
#define PG8_WAIT_V(n) asm volatile("s_waitcnt vmcnt(" #n ")" ::: "memory")
#define PG8_WAIT_L(n) asm volatile("s_waitcnt lgkmcnt(" #n ")" ::: "memory")
#define PG8_BAR __builtin_amdgcn_s_barrier()
#define PG8_SCHED __builtin_amdgcn_sched_barrier(0)
    Unit cur, nxt; int ui = 0;
    if (!S.next(0, cur)) return;
    f32x4 acc[2][2][4][2];
#pragma unroll
    for (int a = 0; a < 2; ++a)
#pragma unroll
        for (int b = 0; b < 2; ++b)
#pragma unroll
            for (int m = 0; m < 4; ++m)
#pragma unroll
                for (int n = 0; n < 2; ++n) acc[a][b][m][n] = (f32x4){0.f, 0.f, 0.f, 0.f};
    bf16x8 At[4][2], B0[2][2], B1[2][2];
    const char* cA = (const char*)g.A + (size_t)cur.pm * tstepA; const char* cB = (const char*)g.Bt + (size_t)cur.pn * tstepB;
    S.a_ready(cur);
    if constexpr (SP2) {
        PG8_STAGE(PG8_SB(0, 0), cB, voffB); PG8_STAGE(PG8_SB(0, 1), cB + hstepB, voffB); PG8_STAGE(PG8_SA(0, 0), cA, voffA); PG8_STAGE(PG8_SA(0, 1), cA + hstepA, voffA);
        if (wr == 1) PG8_BAR;
        PG8_WAIT_V(2); PG8_BAR;
        PG8_STAGE(PG8_SB(1, 0), cB + kstep, voffB); PG8_STAGE(PG8_SA(1, 0), cA + kstep, voffA); PG8_STAGE(PG8_SB(1, 1), cB + hstepB + kstep, voffB);
        PG8_WAIT_V(6); PG8_BAR;
    } else {
        PG8_STAGE(PG8_SB(0, 0), cB, voffB); PG8_STAGE(PG8_SA(0, 0), cA, voffA); PG8_STAGE(PG8_SB(0, 1), cB + hstepB, voffB); PG8_STAGE(PG8_SA(0, 1), cA + hstepA, voffA);
        if (wr == 1) PG8_BAR;
        PG8_WAIT_V(4); PG8_BAR;
        PG8_STAGE(PG8_SB(1, 0), cB + kstep, voffB); PG8_STAGE(PG8_SA(1, 0), cA + kstep, voffA); PG8_STAGE(PG8_SB(1, 1), cB + hstepB + kstep, voffB);
        PG8_WAIT_V(6); PG8_BAR;
    }
    for (;;) {
        const bool has_next = S.next(ui + 1, nxt);
        const char* nA = has_next ? (const char*)g.A + (size_t)nxt.pm * tstepA : cA; const char* nB = has_next ? (const char*)g.Bt + (size_t)nxt.pn * tstepB : cB;
        for (int t = 0; t < nt; t += 2) {
            const bool last = (t == nt - 2);
            const char* a1 = cA + (size_t)(t + 1) * kstep;
            const char* a2 = last ? nA : cA + (size_t)(t + 2) * kstep; const char* b2 = last ? nB : cB + (size_t)(t + 2) * kstep;
            const char* a3 = a2 + kstep; const char* b3 = b2 + kstep;
            if (last && has_next) S.a_ready(nxt);
            if constexpr (SP2) {
            PG8_LDB(B0, 0, 0); PG8_LDB(B1, 0, 1); PG8_SCHED; PG8_LDA(At, 0, 0); PG8_STAGE(PG8_SA(1, 1), a1 + hstepA, voffA);
            PG8_WAIT_V(8); PG8_WAIT_L(0); PG8_BAR; PG8_MMA(0, 0, At, B0); PG8_MMA(0, 1, At, B1); PG8_BAR; PG8_SCHED;
            PG8_LDA(At, 0, 1); PG8_STAGE(PG8_SB(0, 0), b2, voffB); PG8_STAGE(PG8_SB(0, 1), b2 + hstepB, voffB); PG8_STAGE(PG8_SA(0, 0), a2, voffA);
            PG8_WAIT_V(8); PG8_WAIT_L(0); PG8_BAR; PG8_MMA(1, 0, At, B0); PG8_MMA(1, 1, At, B1); PG8_BAR; PG8_SCHED;
            PG8_LDB(B0, 1, 0); PG8_LDB(B1, 1, 1); PG8_SCHED; PG8_LDA(At, 1, 0); PG8_STAGE(PG8_SA(0, 1), a2 + hstepA, voffA);
            PG8_WAIT_V(8); PG8_WAIT_L(0); PG8_BAR; PG8_MMA(0, 0, At, B0); PG8_MMA(0, 1, At, B1); PG8_BAR; PG8_SCHED;
            PG8_LDA(At, 1, 1); PG8_STAGE(PG8_SB(1, 0), b3, voffB); PG8_STAGE(PG8_SB(1, 1), b3 + hstepB, voffB); PG8_STAGE(PG8_SA(1, 0), a3, voffA);
            PG8_WAIT_V(8); PG8_WAIT_L(0); PG8_BAR; PG8_MMA(1, 0, At, B0); PG8_MMA(1, 1, At, B1); PG8_BAR; PG8_SCHED;
            } else {
            PG8_LDB(B0, 0, 0); PG8_SCHED; PG8_LDA(At, 0, 0); PG8_STAGE(PG8_SA(1, 1), a1 + hstepA, voffA);
            PG8_WAIT_L(8); PG8_BAR; PG8_WAIT_L(0); PG8_MMA(0, 0, At, B0); PG8_BAR; PG8_SCHED;
            PG8_LDB(B1, 0, 1); PG8_STAGE(PG8_SB(0, 0), b2, voffB);
            PG8_BAR; PG8_WAIT_L(0); PG8_MMA(0, 1, At, B1); PG8_BAR;
            PG8_LDA(At, 0, 1); PG8_STAGE(PG8_SA(0, 0), a2, voffA);
            PG8_BAR; PG8_WAIT_L(0); PG8_MMA(1, 0, At, B0); PG8_BAR; PG8_SCHED;
            PG8_STAGE(PG8_SB(0, 1), b2 + hstepB, voffB);
            PG8_WAIT_V(6); PG8_BAR; PG8_MMA(1, 1, At, B1); PG8_BAR;
            PG8_LDB(B0, 1, 0); PG8_SCHED; PG8_LDA(At, 1, 0); PG8_STAGE(PG8_SA(0, 1), a2 + hstepA, voffA);
            PG8_WAIT_L(8); PG8_BAR; PG8_WAIT_L(0); PG8_MMA(0, 0, At, B0); PG8_BAR; PG8_SCHED;
            PG8_LDB(B1, 1, 1); PG8_STAGE(PG8_SB(1, 0), b3, voffB);
            PG8_BAR; PG8_WAIT_L(0); PG8_MMA(0, 1, At, B1); PG8_BAR;
            PG8_LDA(At, 1, 1); PG8_STAGE(PG8_SA(1, 0), a3, voffA);
            PG8_BAR; PG8_WAIT_L(0); PG8_MMA(1, 0, At, B0); PG8_BAR; PG8_SCHED;
            PG8_STAGE(PG8_SB(1, 1), b3 + hstepB, voffB);
            PG8_WAIT_V(6); PG8_BAR; PG8_MMA(1, 1, At, B1); PG8_BAR;
            }
        }
        if constexpr (ALIGN_EPI) { if (wr == 0) PG8_BAR; }
        if constexpr (!Epi::AFTER_DRAIN) { E(acc, cur, wr, wc, fr, fq); S.done(cur); }
        if (!has_next) break;
#pragma unroll
        for (int a = 0; a < 2; ++a)
#pragma unroll
            for (int b = 0; b < 2; ++b)
#pragma unroll
                for (int m = 0; m < 4; ++m)
#pragma unroll
                    for (int n = 0; n < 2; ++n) acc[a][b][m][n] = (f32x4){0.f, 0.f, 0.f, 0.f};
        cur = nxt; cA = nA; cB = nB; ++ui;
        if constexpr (ALIGN_EPI) { if (wr == 1) PG8_BAR; }
    }
    PG8_WAIT_V(0);
    if constexpr (!ALIGN_EPI) { if (wr == 0) PG8_BAR; }
    PG8_BAR;
    if constexpr (Epi::AFTER_DRAIN) { E.fused(acc, cur, wr, wc, fr, fq, lds, wid, lane); S.done(cur); }
#undef PG8_SA
#undef PG8_SB
#undef PG8_STAGE
#undef PG8_LDA
#undef PG8_LDB
#undef PG8_MMA
#undef PG8_WAIT_V
#undef PG8_WAIT_L
#undef PG8_BAR
#undef PG8_SCHED
}
}
#define LAS __attribute__((address_space(3)))
typedef unsigned short bf16_t;
typedef short bf16x8 __attribute__((ext_vector_type(8)));
typedef short s16x4 __attribute__((ext_vector_type(4)));
typedef float f32x4 __attribute__((ext_vector_type(4)));
typedef float f32x16 __attribute__((ext_vector_type(16)));
typedef unsigned u32x4 __attribute__((ext_vector_type(4)));
typedef unsigned u32x2 __attribute__((ext_vector_type(2)));
typedef float f32x2_t __attribute__((ext_vector_type(2)));
typedef __bf16 bf16x2_t __attribute__((ext_vector_type(2)));

constexpr int DM = 1024, MTOT = 32768, SEQP = 16384, SEQS = 2048;
constexpr int NTHR = 512;
constexpr float EPS = 1e-6f, SUBLN_EPS = 1e-5f, LOG2E = 1.4426950408889634f;
constexpr float QSCALE = 0.125f * LOG2E;
constexpr int LDS_TOTAL = 131072;

__device__ __attribute__((aligned(256))) bf16_t g_w0t[4096 * 1024];
__device__ __attribute__((aligned(256))) bf16_t g_wo0t[1024 * 1024];
__device__ __attribute__((aligned(256))) bf16_t g_ws1[1024 * 1024];
__device__ __attribute__((aligned(256))) bf16_t g_w1t[3072 * 1024];
__device__ __attribute__((aligned(256))) bf16_t g_wo1t[1024 * 1024];
__device__ __attribute__((aligned(256))) bf16_t g_tab128[256 * 128];
__device__ __attribute__((aligned(256))) bf16_t g_tab16[32 * 32];
__device__ __attribute__((aligned(256))) float g_r0[MTOT];
__device__ __attribute__((aligned(256))) float g_ss1[MTOT];
__device__ __attribute__((aligned(256))) float g_ss2[MTOT];
__device__ __attribute__((aligned(256))) unsigned g_nrm[64];
__device__ __attribute__((aligned(256))) unsigned g_ctr[4];

struct Params {
    const float* xp; const float* xs; const float* attn_norm; const float* w_in0; const float* lq1; const float* lk1; const float* lq2; const float* lk2;
    const float* subln; const float* w_out0; const float* fnet_norm; const float* w_in1; const float* w_out1; const float* final_norm;
    float* out; unsigned char* ws;
};

__device__ __forceinline__ unsigned pk2(float lo, float hi) { f32x2_t v = {lo, hi}; bf16x2_t b = __builtin_convertvector(v, bf16x2_t); return __builtin_bit_cast(unsigned, b); }
__device__ __forceinline__ float bf_lo(unsigned u) { return __uint_as_float(u << 16); }
__device__ __forceinline__ float bf_hi(unsigned u) { return __uint_as_float(u & 0xffff0000u); }
__device__ __forceinline__ float wave_sum(float v) { v += __shfl_xor(v, 32); v += __shfl_xor(v, 16); v += __shfl_xor(v, 8); v += __shfl_xor(v, 4); v += __shfl_xor(v, 2); v += __shfl_xor(v, 1); return v; }
__device__ __forceinline__ float silu_f(float z) { return z / (1.0f + __expf(-z)); }
__device__ __forceinline__ int crow(int r, int hi) { return (r & 3) + 8 * (r >> 2) + 4 * hi; }
#define BLK_SYNC() __syncthreads()

struct EpiRowBf16 {
    static constexpr bool PERM = true, AFTER_DRAIN = false;
    bf16_t* b0; bf16_t* b1; bf16_t* b2; bf16_t* b3; int ld0, ld1; int split_cols; const float* rstat; int stat_is_sumsq; float scale0; unsigned* nrm;
    __device__ __forceinline__ void operator()(const pg8::f32x4 (&acc)[2][2][4][2], const pg8::Unit& u, int wr, int wc, int fr, int fq) const {
        const int row0 = u.pm * 256 + wr * 64 + fr; int colt = u.pn * 256; const int t = colt / split_cols; colt -= t * split_cols;
        bf16_t* b = (t == 0) ? b0 : (t == 1) ? b1 : (t == 2) ? b2 : b3; const int ld = (t == 0) ? ld0 : ld1; const float sc = (t == 0) ? scale0 : 1.0f;
        const int col0 = colt + wc * 32 + 8 * fq; const bool donrm = (nrm != nullptr) && (t < 2); float mx[2] = {0.f, 0.f};
#pragma unroll
        for (int ai = 0; ai < 2; ++ai)
#pragma unroll
            for (int m = 0; m < 4; ++m) {
                const int row = row0 + ai * 128 + m * 16; float rs = rstat[row];
                if (stat_is_sumsq) rs = rsqrtf(rs * (1.0f / 1024.0f) + EPS);
                rs *= sc; bf16_t* rowp = b + (size_t)row * ld + col0;
#pragma unroll
                for (int bj = 0; bj < 2; ++bj) { const pg8::f32x4 v0 = acc[ai][bj][m][0] * rs, v1 = acc[ai][bj][m][1] * rs;
                    u32x4 w; w.x = pk2(v0[0], v0[1]); w.y = pk2(v0[2], v0[3]); w.z = pk2(v1[0], v1[1]); w.w = pk2(v1[2], v1[3]);
                    *(u32x4*)(rowp + bj * 128) = w;
                    if (donrm) { float ps = (v0[0] * v0[0] + v0[1] * v0[1]) + (v0[2] * v0[2] + v0[3] * v0[3]) + (v1[0] * v1[0] + v1[1] * v1[1]) + (v1[2] * v1[2] + v1[3] * v1[3]);
                        ps += __shfl_xor(ps, 16); ps += __shfl_xor(ps, 32); mx[bj] = fmaxf(mx[bj], ps); } }
            }
        if (donrm) {
#pragma unroll
            for (int bj = 0; bj < 2; ++bj) { float v = mx[bj]; v = fmaxf(v, __shfl_xor(v, 1)); v = fmaxf(v, __shfl_xor(v, 2)); v = fmaxf(v, __shfl_xor(v, 4)); v = fmaxf(v, __shfl_xor(v, 8));
                if ((threadIdx.x & 63) == 0) atomicMax(nrm + t * 32 + ((colt + bj * 128 + wc * 32) >> 6) * 2 + (wc & 1), __float_as_uint(v)); }
        }
    }
};
struct EpiFold {
    static constexpr bool PERM = true, AFTER_DRAIN = false;
    bf16_t* O; int g;
    __device__ __forceinline__ void operator()(const pg8::f32x4 (&acc)[2][2][4][2], const pg8::Unit& u, int wr, int wc, int fr, int fq) const {
        const int col0 = u.pn * 256 + wc * 32 + 8 * fq;
#pragma unroll
        for (int ai = 0; ai < 2; ++ai)
#pragma unroll
            for (int m = 0; m < 4; ++m) {
                const int j = wr * 64 + m * 16 + fr; bf16_t* rowp = O + (size_t)(ai * 1024 + g * 128 + j) * 1024 + col0;
#pragma unroll
                for (int bj = 0; bj < 2; ++bj) { const pg8::f32x4 v0 = acc[ai][bj][m][0], v1 = acc[ai][bj][m][1];
                    u32x4 w; w.x = pk2(v0[0], v0[1]); w.y = pk2(v0[2], v0[3]); w.z = pk2(v1[0], v1[1]); w.w = pk2(v1[2], v1[3]);
                    *(u32x4*)(rowp + bj * 128) = w; }
            }
    }
};
struct EpiResid {
    static constexpr bool PERM = false, AFTER_DRAIN = false;
    const float* resA; const float* resB; float* out; bf16_t* outb; float* ss;
    __device__ __forceinline__ void operator()(const pg8::f32x4 (&acc)[2][2][4][2], const pg8::Unit& u, int wr, int wc, int fr, int fq) const {
        const int row0 = u.pm * 256 + wr * 64 + fr; const int col0 = u.pn * 256 + wc * 32 + 4 * fq;
#pragma unroll
        for (int ai = 0; ai < 2; ++ai)
#pragma unroll
            for (int m = 0; m < 4; ++m) {
                const int row = row0 + ai * 128 + m * 16;
                const float* rp = (row < SEQP) ? (resA + (size_t)row * DM) : (resB + (size_t)(row - SEQP) * DM);
                float s = 0.f;
#pragma unroll
                for (int bj = 0; bj < 2; ++bj)
#pragma unroll
                    for (int n = 0; n < 2; ++n) { const int col = col0 + bj * 128 + n * 16;
                        const pg8::f32x4 r = *(const pg8::f32x4*)(rp + col); const pg8::f32x4 v = r + acc[ai][bj][m][n];
                        *(pg8::f32x4*)(out + (size_t)row * DM + col) = v;
                        if (outb) { u32x2 w; w.x = pk2(v[0], v[1]); w.y = pk2(v[2], v[3]); *(u32x2*)(outb + (size_t)row * DM + col) = w; }
                        s += (v[0] * v[0] + v[1] * v[1]) + (v[2] * v[2] + v[3] * v[3]); }
                s += __shfl_xor(s, 16); s += __shfl_xor(s, 32);
                if (fq == 0) atomicAdd(ss + row, s);
            }
    }
};
struct OneUnit { int pn; __device__ bool next(int i, pg8::Unit& u) const { if (i > 0) return false; u.pm = 0; u.pn = pn; return true; }
    __device__ __forceinline__ void a_ready(const pg8::Unit&) const {} __device__ __forceinline__ void done(const pg8::Unit&) const {} };

__device__ __forceinline__ void transpose_item(const float* W, int ldw, const float* gain, bf16_t* WT, LAS float* scr, int item, int nblk, int lane) {
    const int kb = item / nblk, nb = item % nblk, k0 = 64 * kb, n0 = 32 * nb;
#pragma unroll 8
    for (int i = 0; i < 32; ++i) { const int kk = 2 * i + (lane >> 5); const float gk = gain ? gain[k0 + kk] : 1.0f; scr[kk * 33 + (lane & 31)] = W[(size_t)(k0 + kk) * ldw + n0 + (lane & 31)] * gk; }
    asm volatile("s_waitcnt lgkmcnt(0)" ::: "memory");
    const int c = lane & 7;
#pragma unroll
    for (int j = 0; j < 4; ++j) { const int n = (lane >> 3) + 8 * j; const LAS float* s = scr + (8 * c) * 33 + n;
        u32x4 o; o.x = pk2(s[0 * 33], s[1 * 33]); o.y = pk2(s[2 * 33], s[3 * 33]); o.z = pk2(s[4 * 33], s[5 * 33]); o.w = pk2(s[6 * 33], s[7 * 33]);
        *(u32x4*)(WT + (size_t)(n0 + n) * 1024 + k0 + 8 * c) = o; }
    asm volatile("s_waitcnt lgkmcnt(0)" ::: "memory");
}

__device__ __forceinline__ void phase0(const Params& p, LAS unsigned char* lds, bf16_t* XB) {
    const int tid = threadIdx.x, lane = tid & 63, wave = tid >> 6;
    const int gw = blockIdx.x * 8 + wave, NGW = gridDim.x * 8;
    for (int row = gw; row < MTOT; row += NGW) {
        const float* xr = (row < SEQP) ? (p.xp + (size_t)row * DM) : (p.xs + (size_t)(row - SEQP) * DM);
        f32x4 v[4]; float ss = 0.f;
#pragma unroll
        for (int i = 0; i < 4; ++i) { v[i] = *(const f32x4*)(xr + 4 * (lane + 64 * i)); ss += (v[i][0] * v[i][0] + v[i][1] * v[i][1]) + (v[i][2] * v[i][2] + v[i][3] * v[i][3]); }
        ss = wave_sum(ss);
        if (lane == 0) g_r0[row] = rsqrtf(ss * (1.0f / 1024.0f) + EPS);
#pragma unroll
        for (int i = 0; i < 4; ++i) { u32x2 w; w.x = pk2(v[i][0], v[i][1]); w.y = pk2(v[i][2], v[i][3]); *(u32x2*)(XB + (size_t)row * DM + 4 * (lane + 64 * i)) = w; }
    }
    for (int i = blockIdx.x * NTHR + tid; i < MTOT; i += gridDim.x * NTHR) { g_ss1[i] = 0.f; g_ss2[i] = 0.f; }
    if (blockIdx.x == 0 && tid < 64) { g_nrm[tid] = 0u; if (tid < 4) g_ctr[tid] = 0u; }
    LAS float* scr = (LAS float*)(lds + wave * 8704);
    constexpr int I0 = 16 * 128, I1 = 16 * 32, NIT = I0 + 3 * I1;
    for (int it = gw; it < NIT; it += NGW) {
        int r = it;
        if (r < I0) { transpose_item(p.w_in0, 4096, p.attn_norm, g_w0t, scr, r, 128, lane); continue; } r -= I0;
        if (r < I1) { transpose_item(p.w_out0, 1024, nullptr, g_wo0t, scr, r, 32, lane); continue; } r -= I1;
        if (r < I1) { transpose_item(p.w_in1 + 1024, 2048, p.fnet_norm, g_w1t + (size_t)2048 * 1024, scr, r, 32, lane); continue; } r -= I1;
        transpose_item(p.w_out1, 1024, nullptr, g_wo1t, scr, r, 32, lane);
    }
    for (int i = blockIdx.x * NTHR + tid; i < 1024 * 256; i += gridDim.x * NTHR) {
        const int k = i >> 8, c4 = (i & 255) * 4; const f32x4 w = *(const f32x4*)(p.w_in1 + (size_t)k * 2048 + c4); const float gk = p.fnet_norm[k];
        u32x2 o; o.x = pk2(w[0] * gk, w[1] * gk); o.y = pk2(w[2] * gk, w[3] * gk); *(u32x2*)(g_ws1 + (size_t)k * 1024 + c4) = o;
    }
    for (int i = blockIdx.x * NTHR + tid; i < 256 * 128; i += gridDim.x * NTHR) {
        const int rr = i >> 7, n = i & 127, k = rr & 127, part = rr >> 7; const float th = (float)((k * n) & 127) * (6.283185307179586f / 128.0f);
        const float v = part ? sinf(th) : cosf(th); g_tab128[i] = (bf16_t)(pk2(v, 0.f) & 0xffffu);
    }
    for (int i = blockIdx.x * NTHR + tid; i < 32 * 32; i += gridDim.x * NTHR) {
        const int kk = i >> 5, j = i & 31, k1 = kk & 15, po = kk >> 4, n1 = j & 15, pi = j >> 4; const float th = (float)((k1 * n1) & 15) * (6.283185307179586f / 16.0f);
        float v; if (po == 0) v = pi ? -sinf(th) : cosf(th); else v = pi ? -cosf(th) : -sinf(th);
        g_tab16[i] = (bf16_t)(pk2(v, 0.f) & 0xffffu);
    }
}

constexpr int AT_KP = 144, AT_VP = 320, AT_K2 = 64 * AT_KP, AT_V = 2 * 64 * AT_KP, AT_STAGE = AT_V + 64 * AT_VP, AT_XP = 528;
typedef short v4i16_t __attribute__((ext_vector_type(4)));
__device__ __forceinline__ s16x4 tr_read(LAS const unsigned char* p) { return __builtin_bit_cast(s16x4, __builtin_amdgcn_ds_read_tr16_b64_v4i16((LAS v4i16_t*)p)); }
__device__ __forceinline__ bf16x8 cat8(s16x4 a, s16x4 b) { return (bf16x8){a[0], a[1], a[2], a[3], b[0], b[1], b[2], b[3]}; }
__device__ __forceinline__ bf16x8 neg8(bf16x8 a) { typedef int i32x4 __attribute__((ext_vector_type(4))); i32x4 v = __builtin_bit_cast(i32x4, a); v = v ^ (int)0x80008000; return __builtin_bit_cast(bf16x8, v); }
#define MFMA32(a, b, c) __builtin_amdgcn_mfma_f32_32x32x16_bf16((a), (b), (c), 0, 0, 0)

__device__ __forceinline__ void attn_phase(const Params& p, LAS unsigned char* lds, const bf16_t* Qb, const bf16_t* Kb, const bf16_t* Vb, const bf16_t* Zb, bf16_t* Ob, unsigned* ctr) {
    const int tid = threadIdx.x, lane = tid & 63, wave = __builtin_amdgcn_readfirstlane(tid >> 6), r32 = lane & 31, hi = lane >> 5;
    const int map = wave >> 2, qs = wave & 3;
    float lam;
    { const float a = wave_sum(p.lq1[lane] * p.lk1[lane]), b = wave_sum(p.lq2[lane] * p.lk2[lane]); lam = expf(a) - expf(b) + 0.2f; }
    const int g16 = lane >> 4, i16 = lane & 15, tq = i16 >> 2, tp = i16 & 3;
    LAS unsigned* qword = (LAS unsigned*)(lds + 2 * AT_STAGE);
    for (;;) {
        if (tid == 0) *qword = atomicAdd(ctr, 1u);
        BLK_SYNC();
        const int unit = (int)*qword;
        if (unit >= 2048) break;
        int R0s, S, h, q0;
        if (unit < 1024) { R0s = 0; S = SEQP; h = 7 - (unit >> 7); q0 = (unit & 127) * 128; }
        else { const int v = unit - 1024; h = 7 - (v >> 7); R0s = SEQP + ((v >> 4) & 7) * SEQS; S = SEQS; q0 = (v & 15) * 128; }
        const float slope2 = exp2f(-(float)(h + 1)) * LOG2E;
        int t_lo, t_hi;
        { float B2 = 0.f;
#pragma unroll
          for (int mm = 0; mm < 2; ++mm) { const int e = (2 * h + mm) * 2;
              const float qn2 = __uint_as_float(g_nrm[e]) + __uint_as_float(g_nrm[e + 1]), kn2 = __uint_as_float(g_nrm[32 + e]) + __uint_as_float(g_nrm[32 + e + 1]);
              B2 = fmaxf(B2, sqrtf(qn2 * kn2) * 1.02f); }
          const float thr = 2.0f * B2 + 25.0f - log2f(1.0f - exp2f(-slope2));
          const float dminf = fminf(ceilf(thr / slope2), 1.0e6f); const int dmin = (int)dminf;
          const int NTL = S / 64; int lo = q0 - dmin + 1; lo = lo < 0 ? 0 : lo; int hiK = q0 + 127 + dmin - 1; hiK = hiK > S - 1 ? S - 1 : hiK;
          t_lo = lo >> 6; t_hi = hiK >> 6; if (t_hi > NTL - 1) t_hi = NTL - 1; }
        const int qrow = R0s + q0 + qs * 32 + r32;
        bf16x8 qf[4];
        { const bf16_t* qp = Qb + (size_t)qrow * DM + h * 128 + map * 64 + hi * 8;
#pragma unroll
          for (int st = 0; st < 4; ++st) qf[st] = *(const bf16x8*)(qp + st * 16); }
        const float nslope2 = -slope2;
        const float qposf = (float)(q0 + qs * 32 + r32 - 4 * hi);
        float l = 0.f;
        f32x16 o[4];
#pragma unroll
        for (int db = 0; db < 4; ++db)
#pragma unroll
            for (int r = 0; r < 16; ++r) o[db][r] = 0.f;
        const bf16_t* gsrc[4]; int ldst[4];
#pragma unroll
        for (int i = 0; i < 4; ++i) { const int c = tid + 512 * i;
            if (i < 2) { const int row = c >> 4, ch = c & 15; gsrc[i] = Kb + (size_t)(R0s + t_lo * 64 + row) * DM + h * 128 + ch * 8; ldst[i] = (ch >> 3) * AT_K2 + row * AT_KP + (ch & 7) * 16; }
            else { const int c2 = c - 1024, row = c2 >> 4, ch = c2 & 15; gsrc[i] = Vb + (size_t)(R0s + t_lo * 64 + row) * DM + h * 128 + ch * 8; ldst[i] = AT_V + row * AT_VP + ch * 16; } }
        u32x4 stg[4];
#pragma unroll
        for (int i = 0; i < 4; ++i) stg[i] = *(const u32x4*)(gsrc[i]);
#pragma unroll
        for (int i = 0; i < 4; ++i) *(LAS u32x4*)(lds + ldst[i]) = stg[i];
        __builtin_amdgcn_s_waitcnt(0x0F70);
        BLK_SYNC();
        const int ntl = t_hi - t_lo + 1;
        for (int tt = 0; tt < ntl; ++tt) {
            const int stage = tt & 1;
            if (tt + 1 < ntl) {
#pragma unroll
                for (int i = 0; i < 4; ++i) stg[i] = *(const u32x4*)(gsrc[i] + (size_t)(tt + 1) * 64 * DM);
            }
            LAS const unsigned char* Kt = lds + stage * AT_STAGE + map * AT_K2 + r32 * AT_KP + hi * 16;
            LAS const unsigned char* vbase = lds + stage * AT_STAGE + AT_V + (4 * hi + tq) * AT_VP + (16 * (g16 & 1) + 4 * tp) * 2;
            bf16x8 kf0[4], kf1[4];
#pragma unroll
            for (int st = 0; st < 4; ++st) { kf0[st] = *(LAS const bf16x8*)(Kt + st * 32); kf1[st] = *(LAS const bf16x8*)(Kt + 32 * AT_KP + st * 32); }
            __builtin_amdgcn_sched_barrier(0);
            f32x16 s0, s1;
#pragma unroll
            for (int r = 0; r < 16; ++r) { s0[r] = 0.f; s1[r] = 0.f; }
#pragma unroll
            for (int st = 0; st < 4; ++st) { s0 = MFMA32(kf0[st], qf[st], s0); s1 = MFMA32(kf1[st], qf[st], s1); }
            bf16x8 vf[2][4];
#pragma unroll
            for (int ks = 0; ks < 4; ++ks) { LAS const unsigned char* a = vbase + (16 * ks) * AT_VP; vf[0][ks] = cat8(tr_read(a), tr_read(a + 8 * AT_VP)); }
            __builtin_amdgcn_sched_barrier(0);
            const float d0 = qposf - (float)((t_lo + tt) * 64);
            float rs = 0.f;
#pragma unroll
            for (int r = 0; r < 16; ++r) { const float c = (float)((r & 3) + 8 * (r >> 2));
                s0[r] = __builtin_amdgcn_exp2f(__builtin_fmaf(nslope2, fabsf(d0 - c), s0[r]));
                s1[r] = __builtin_amdgcn_exp2f(__builtin_fmaf(nslope2, fabsf(d0 - (32.0f + c)), s1[r]));
                rs += s0[r] + s1[r]; }
            l += rs;
            bf16x8 pf[4];
#pragma unroll
            for (int s = 0; s < 2; ++s) {
                u32x4 w0, w1;
                w0.x = pk2(s0[8 * s + 0], s0[8 * s + 1]); w0.y = pk2(s0[8 * s + 2], s0[8 * s + 3]); w0.z = pk2(s0[8 * s + 4], s0[8 * s + 5]); w0.w = pk2(s0[8 * s + 6], s0[8 * s + 7]);
                w1.x = pk2(s1[8 * s + 0], s1[8 * s + 1]); w1.y = pk2(s1[8 * s + 2], s1[8 * s + 3]); w1.z = pk2(s1[8 * s + 4], s1[8 * s + 5]); w1.w = pk2(s1[8 * s + 6], s1[8 * s + 7]);
                pf[s] = __builtin_bit_cast(bf16x8, w0); pf[2 + s] = __builtin_bit_cast(bf16x8, w1);
            }
            __builtin_amdgcn_sched_barrier(0);
#pragma unroll
            for (int db = 0; db < 4; ++db) {
                if (db < 3) {
#pragma unroll
                    for (int ks = 0; ks < 4; ++ks) { LAS const unsigned char* a = vbase + (16 * ks) * AT_VP + (db + 1) * 64; vf[(db + 1) & 1][ks] = cat8(tr_read(a), tr_read(a + 8 * AT_VP)); }
                }
#pragma unroll
                for (int ks = 0; ks < 4; ++ks) o[db] = MFMA32(vf[db & 1][ks], pf[ks], o[db]);
                __builtin_amdgcn_sched_barrier(0);
            }
            if (tt + 1 < ntl) {
#pragma unroll
                for (int i = 0; i < 4; ++i) *(LAS u32x4*)(lds + (stage ^ 1) * AT_STAGE + ldst[i]) = stg[i];
            }
            BLK_SYNC();
        }
        l += __shfl_xor(l, 32);
        const float inv = 1.0f / l;
#pragma unroll
        for (int db = 0; db < 4; ++db)
#pragma unroll
            for (int r = 0; r < 16; ++r) o[db][r] *= inv;
        LAS unsigned char* xq = lds + (qs * 32 + r32) * AT_XP;
        if (map == 1) {
#pragma unroll
            for (int db = 0; db < 4; ++db)
#pragma unroll
                for (int rg = 0; rg < 4; ++rg) { const int d = 32 * db + 8 * rg + 4 * hi;
                    *(LAS f32x4*)(xq + d * 4) = (f32x4){o[db][4 * rg], o[db][4 * rg + 1], o[db][4 * rg + 2], o[db][4 * rg + 3]}; }
        }
        BLK_SYNC();
        if (map == 0) {
            float ss = 0.f;
#pragma unroll
            for (int db = 0; db < 4; ++db)
#pragma unroll
                for (int rg = 0; rg < 4; ++rg) { const int d = 32 * db + 8 * rg + 4 * hi; const f32x4 o2 = *(LAS const f32x4*)(xq + d * 4);
#pragma unroll
                    for (int e = 0; e < 4; ++e) { const float v = o[db][4 * rg + e] - lam * o2[e]; o[db][4 * rg + e] = v; ss += v * v; } }
            ss += __shfl_xor(ss, 32);
            const float rn = rsqrtf(ss * (1.0f / 128.0f) + SUBLN_EPS) * 0.8f;
            const bf16_t* zp = Zb + (size_t)qrow * DM + h * 128; bf16_t* op = Ob + (size_t)qrow * DM + h * 128;
#pragma unroll
            for (int db = 0; db < 4; ++db)
#pragma unroll
                for (int rg = 0; rg < 4; ++rg) { const int d = 32 * db + 8 * rg + 4 * hi;
                    const f32x4 gg = *(const f32x4*)(p.subln + d); const u32x2 zz = *(const u32x2*)(zp + d);
                    const float v0 = o[db][4 * rg] * rn * gg[0] * silu_f(bf_lo(zz.x)), v1 = o[db][4 * rg + 1] * rn * gg[1] * silu_f(bf_hi(zz.x));
                    const float v2 = o[db][4 * rg + 2] * rn * gg[2] * silu_f(bf_lo(zz.y)), v3 = o[db][4 * rg + 3] * rn * gg[3] * silu_f(bf_hi(zz.y));
                    u32x2 w; w.x = pk2(v0, v1); w.y = pk2(v2, v3); *(u32x2*)(op + d) = w; }
        }
        BLK_SYNC();
    }
}

constexpr int FT_P = 320;
template <int MODE> __device__ __forceinline__ void fft_rows(int unit, int& rbase, int& cc, int& a0, int& a1, int& a2) {
    cc = unit & 7;
    if (MODE == 0) { a0 = unit >> 3; rbase = 0; a1 = 0; a2 = 0; }
    else if (MODE == 1) { a0 = unit >> 7; a1 = (unit >> 3) & 15; rbase = SEQP + a0 * SEQS; a2 = 0; }
    else { if (unit < 1024) { rbase = 0; a0 = unit >> 3; a1 = 128; } else { const int v = unit - 1024; rbase = SEQP + (v >> 7) * SEQS; a0 = (v >> 3) & 15; a1 = 16; } a2 = 0; }
}
template <int MODE> __device__ __forceinline__ const bf16_t* fft_src(const bf16_t* AB, int rbase, int cc, int a0, int a1, int rho, int ch16) {
    int grow, part;
    if (MODE == 0) { part = rho >> 7; grow = (rho & 127) * 128 + a0; }
    else if (MODE == 1) { part = (rho >> 4) & 1; grow = rbase + (rho & 15) * 128 + a1 * 8 + (rho >> 5); }
    else { part = rho >> 7; grow = rbase + a0 * 128 + (rho & 127); }
    return AB + (size_t)grow * 2048 + part * 1024 + cc * 128 + ch16 * 8;
}

template <int MODE> __device__ __forceinline__ void fft_pass(LAS unsigned char* lds, bf16_t* AB, const bf16_t* Z1, bf16_t* FG, int nunits) {
    const int tid = threadIdx.x, lane = tid & 63, wave = __builtin_amdgcn_readfirstlane(tid >> 6), r32 = lane & 31, hi = lane >> 5;
    const int g16 = lane >> 4, i16 = lane & 15, tq = i16 >> 2, tp = i16 & 3;
    const int kb = wave & 3, cbh = wave >> 2;
    bf16x8 Cf[8], Sf[8];
    if (MODE != 1) {
        const int k = 32 * kb + r32;
#pragma unroll
        for (int s = 0; s < 8; ++s) { Cf[s] = *(const bf16x8*)(g_tab128 + k * 128 + 16 * s + 8 * hi); Sf[s] = *(const bf16x8*)(g_tab128 + (128 + k) * 128 + 16 * s + 8 * hi); }
    } else {
#pragma unroll
        for (int s = 0; s < 2; ++s) Cf[s] = *(const bf16x8*)(g_tab16 + r32 * 32 + 16 * s + 8 * hi);
    }
    int unit = blockIdx.x;
    if (unit >= nunits) return;
    int rbase, cc, a0, a1, a2;
    fft_rows<MODE>(unit, rbase, cc, a0, a1, a2);
    u32x4 stg[8];
#pragma unroll
    for (int i = 0; i < 8; ++i) { const int c = tid + 512 * i; stg[i] = *(const u32x4*)fft_src<MODE>(AB, rbase, cc, a0, a1, c >> 4, c & 15); }
    __builtin_amdgcn_s_waitcnt(0x0F70);
    for (;;) {
#pragma unroll
        for (int i = 0; i < 8; ++i) { const int c = tid + 512 * i; *(LAS u32x4*)(lds + (c >> 4) * FT_P + (c & 15) * 16) = stg[i]; }
        BLK_SYNC();
        const int nunit = unit + gridDim.x; const bool has_next = nunit < nunits;
        int nrbase = 0, ncc = 0, na0 = 0, na1 = 0, na2 = 0;
        if (has_next) { fft_rows<MODE>(nunit, nrbase, ncc, na0, na1, na2);
#pragma unroll
            for (int i = 0; i < 8; ++i) { const int c = tid + 512 * i; stg[i] = *(const u32x4*)fft_src<MODE>(AB, nrbase, ncc, na0, na1, c >> 4, c & 15); } }
        if (MODE == 0) {
            const int k1 = 32 * kb + r32, n2 = a0;
            const float ph = (float)((k1 * n2) & 16383) * (1.0f / 16384.0f); const float tc = __builtin_amdgcn_cosf(ph), ts = __builtin_amdgcn_sinf(ph);
#pragma unroll 1
            for (int cbi = 0; cbi < 2; ++cbi) { const int cb = 2 * cbh + cbi;
                LAS const unsigned char* ab = lds + (8 * hi + tq) * FT_P + (32 * cb + 16 * (g16 & 1) + 4 * tp) * 2;
                f32x16 yr, yi;
#pragma unroll
                for (int r = 0; r < 16; ++r) { yr[r] = 0.f; yi[r] = 0.f; }
#pragma unroll
                for (int s = 0; s < 8; ++s) {
                    const bf16x8 af = cat8(tr_read(ab + (16 * s) * FT_P), tr_read(ab + (16 * s + 4) * FT_P));
                    const bf16x8 bf = cat8(tr_read(ab + (128 + 16 * s) * FT_P), tr_read(ab + (128 + 16 * s + 4) * FT_P));
                    const bf16x8 naf = neg8(af), nbf = neg8(bf);
                    yr = MFMA32(af, Cf[s], yr); yr = MFMA32(nbf, Sf[s], yr);
                    yi = MFMA32(naf, Sf[s], yi); yi = MFMA32(nbf, Cf[s], yi);
                }
                bf16_t* orow = AB + (size_t)(k1 * 128 + n2) * 2048 + cc * 128 + cb * 32 + 4 * hi;
#pragma unroll
                for (int rg = 0; rg < 4; ++rg) { float a[4], b[4];
#pragma unroll
                    for (int e = 0; e < 4; ++e) { const float vr = yr[4 * rg + e], vi = yi[4 * rg + e]; a[e] = vr * tc + vi * ts; b[e] = vi * tc - vr * ts; }
                    u32x2 w0, w1; w0.x = pk2(a[0], a[1]); w0.y = pk2(a[2], a[3]); w1.x = pk2(b[0], b[1]); w1.y = pk2(b[2], b[3]);
                    *(u32x2*)(orow + 8 * rg) = w0; *(u32x2*)(orow + 1024 + 8 * rg) = w1; }
            }
        } else if (MODE == 1) {
            const int k1 = r32 & 15, po = r32 >> 4, n2 = a1 * 8 + wave;
            const float ph = (float)((k1 * n2) & 2047) * (1.0f / 2048.0f); const float tc = __builtin_amdgcn_cosf(ph); float ts = __builtin_amdgcn_sinf(ph); if (po) ts = -ts;
#pragma unroll 1
            for (int cb = 0; cb < 4; ++cb) {
                LAS const unsigned char* ab = lds + (wave * 32 + 8 * hi + tq) * FT_P + (32 * cb + 16 * (g16 & 1) + 4 * tp) * 2;
                f32x16 y;
#pragma unroll
                for (int r = 0; r < 16; ++r) y[r] = 0.f;
                const bf16x8 f0 = cat8(tr_read(ab), tr_read(ab + 4 * FT_P)), f1 = cat8(tr_read(ab + 16 * FT_P), tr_read(ab + 20 * FT_P));
                y = MFMA32(f0, Cf[0], y); y = MFMA32(f1, Cf[1], y);
                bf16_t* orow = AB + (size_t)(rbase + k1 * 128 + n2) * 2048 + po * 1024 + cc * 128 + cb * 32 + 4 * hi;
#pragma unroll
                for (int rg = 0; rg < 4; ++rg) { float a[4];
#pragma unroll
                    for (int e = 0; e < 4; ++e) { const float own = y[4 * rg + e], oth = __shfl_xor(own, 16); a[e] = own * tc + oth * ts; }
                    u32x2 w0; w0.x = pk2(a[0], a[1]); w0.y = pk2(a[2], a[3]); *(u32x2*)(orow + 8 * rg) = w0; }
            }
        } else {
            const int k2 = 32 * kb + r32, k1 = a0, N1 = a1; const float nrm = (N1 == 128) ? 6.905339660024879e-4f : 1.953125e-3f;
            const size_t orow_i = (size_t)(rbase + k1 + N1 * k2);
#pragma unroll 1
            for (int cbi = 0; cbi < 2; ++cbi) { const int cb = 2 * cbh + cbi;
                LAS const unsigned char* ab = lds + (8 * hi + tq) * FT_P + (32 * cb + 16 * (g16 & 1) + 4 * tp) * 2;
                f32x16 y;
#pragma unroll
                for (int r = 0; r < 16; ++r) y[r] = 0.f;
#pragma unroll
                for (int s = 0; s < 8; ++s) {
                    const bf16x8 af = cat8(tr_read(ab + (16 * s) * FT_P), tr_read(ab + (16 * s + 4) * FT_P));
                    const bf16x8 bf = cat8(tr_read(ab + (128 + 16 * s) * FT_P), tr_read(ab + (128 + 16 * s + 4) * FT_P));
                    y = MFMA32(af, Cf[s], y); y = MFMA32(bf, Sf[s], y);
                }
                const bf16_t* zrow = Z1 + orow_i * DM + cc * 128 + cb * 32 + 4 * hi; bf16_t* orow = FG + orow_i * DM + cc * 128 + cb * 32 + 4 * hi;
#pragma unroll
                for (int rg = 0; rg < 4; ++rg) { const u32x2 zz = *(const u32x2*)(zrow + 8 * rg);
                    const float v0 = y[4 * rg] * nrm * silu_f(bf_lo(zz.x)), v1 = y[4 * rg + 1] * nrm * silu_f(bf_hi(zz.x));
                    const float v2 = y[4 * rg + 2] * nrm * silu_f(bf_lo(zz.y)), v3 = y[4 * rg + 3] * nrm * silu_f(bf_hi(zz.y));
                    u32x2 w; w.x = pk2(v0, v1); w.y = pk2(v2, v3); *(u32x2*)(orow + 8 * rg) = w; }
            }
        }
        BLK_SYNC();
        if (!has_next) break;
        unit = nunit; rbase = nrbase; cc = ncc; a0 = na0; a1 = na1; a2 = na2;
    }
}

#ifndef PROBE
#define PROBE 0
#endif
#ifndef PHM
#define PHM 0xffff
#endif
__global__ void __launch_bounds__(NTHR, 2) fwd_kernel(Params p) {
    extern __shared__ __attribute__((aligned(16))) unsigned char lds_raw[];
    LAS unsigned char* lds = (LAS unsigned char*)lds_raw;
    cg::grid_group grid = cg::this_grid();
    const size_t REG = (size_t)MTOT * DM;
    bf16_t* R0 = (bf16_t*)p.ws; bf16_t* R1 = R0 + REG; bf16_t* R2 = R1 + REG; bf16_t* R3 = R2 + REG;
    bf16_t* XB = (bf16_t*)p.out;

    if (PHM & 1) phase0(p, lds, XB);
    grid.sync();
    if (PHM & 2) {
        pg8::Gemm gm{XB, g_w0t, MTOT, 4096, 1024, 1024, 1024}; pg8::StaticOrder S; S.init(MTOT, 4096, gridDim.x, blockIdx.x);
        EpiRowBf16 E{R0, R1, R2, R3, DM, DM, 1024, g_r0, 0, QSCALE, g_nrm};
        pg8::gemm_phase<EpiRowBf16, pg8::StaticOrder, true, true>(lds, gm, S, E);
#if PROBE & 1
        pg8::gemm_phase<EpiRowBf16, pg8::StaticOrder, true, true>(lds, gm, S, E);
#endif
    }
    grid.sync();
    if ((PHM & 512) && blockIdx.x < 32) {
        const int fu = blockIdx.x, g = fu >> 2; pg8::Gemm gm{g_tab128, g_ws1 + g * 128, 256, 1024, 128, 128, 1024}; OneUnit S{fu & 3}; EpiFold E{g_w1t, g};
        pg8::gemm_phase<EpiFold, OneUnit, false, true>(lds, gm, S, E);
    }
#if PROBE & 2
    attn_phase(p, lds, R0, R1, R2, R3, (bf16_t*)p.out + REG, &g_ctr[1]);
#endif
    if (PHM & 4) attn_phase(p, lds, R0, R1, R2, R3, R0, &g_ctr[0]);
    grid.sync();
    if (PHM & 8) {
        pg8::Gemm gm{R0, g_wo0t, MTOT, 1024, 1024, 1024, 1024}; pg8::StaticOrder S; S.init(MTOT, 1024, gridDim.x, blockIdx.x);
        EpiResid E{p.xp, p.xs, p.out, R3, g_ss1};
        pg8::gemm_phase<EpiResid, pg8::StaticOrder, true, true>(lds, gm, S, E);
#if PROBE & 1
        { EpiResid E2{p.xp, p.xs, p.out, R3, g_r0}; pg8::gemm_phase<EpiResid, pg8::StaticOrder, true, true>(lds, gm, S, E2); }
#endif
    }
    grid.sync();
    if (PHM & 16) {
        pg8::Gemm gm{R3, g_w1t, MTOT, 3072, 1024, 1024, 1024}; pg8::StaticOrder S; S.init(MTOT, 3072, gridDim.x, blockIdx.x);
        EpiRowBf16 E{R1, R0, R0, R0, 2048, DM, 2048, g_ss1, 1, 1.0f, nullptr};
        pg8::gemm_phase<EpiRowBf16, pg8::StaticOrder, true, true>(lds, gm, S, E);
#if PROBE & 1
        pg8::gemm_phase<EpiRowBf16, pg8::StaticOrder, true, true>(lds, gm, S, E);
#endif
    }
    grid.sync();
    if (PHM & 32) fft_pass<0>(lds, R1, nullptr, nullptr, 1024);
    if (PHM & 64) fft_pass<1>(lds, R1, nullptr, nullptr, 1024);
    grid.sync();
    if (PHM & 128) fft_pass<2>(lds, R1, R0, R3, 2048);
    grid.sync();
    if (PHM & 256) {
        pg8::Gemm gm{R3, g_wo1t, MTOT, 1024, 1024, 1024, 1024}; pg8::StaticOrder S; S.init(MTOT, 1024, gridDim.x, blockIdx.x);
        EpiResid E{p.out, p.out + (size_t)SEQP * DM, p.out, nullptr, g_ss2};
        pg8::gemm_phase<EpiResid, pg8::StaticOrder, true, true>(lds, gm, S, E);
    }
    grid.sync();
    const int lane = threadIdx.x & 63, wave = threadIdx.x >> 6;
    for (int row = blockIdx.x * 8 + wave; row < MTOT; row += gridDim.x * 8) {
        const float rs = rsqrtf(g_ss2[row] * (1.0f / 1024.0f) + EPS); float* orow = p.out + (size_t)row * DM;
#pragma unroll
        for (int i = 0; i < 4; ++i) { const int c = 4 * (lane + 64 * i); f32x4 v = *(const f32x4*)(orow + c); const f32x4 gg = *(const f32x4*)(p.final_norm + c);
            v[0] *= rs * gg[0]; v[1] *= rs * gg[1]; v[2] *= rs * gg[2]; v[3] *= rs * gg[3]; *(f32x4*)(orow + c) = v; }
    }
}

extern "C" void kernel_launch(void* const* d_in, const int* in_sizes, int n_in, void* d_out, int out_size, void* d_ws, size_t ws_size, hipStream_t stream) {
    static int grid = 0;
    if (grid == 0) {
        int dev = 0, cus = 0, per_cu = 0;
        if (n_in != 14 || ws_size < (size_t)4 * MTOT * DM * 2) { fprintf(stderr, "kernel_launch: unexpected problem shape (n_in %d, ws %zu)\n", n_in, ws_size); grid = -1; return; }
        hipGetDevice(&dev); hipDeviceGetAttribute(&cus, hipDeviceAttributeMultiprocessorCount, dev);
        if (hipFuncSetAttribute((const void*)fwd_kernel, hipFuncAttributeMaxDynamicSharedMemorySize, LDS_TOTAL) != hipSuccess) { fprintf(stderr, "kernel_launch: hipFuncSetAttribute failed\n"); grid = -1; return; }
        if (hipOccupancyMaxActiveBlocksPerMultiprocessor(&per_cu, (const void*)fwd_kernel, NTHR, LDS_TOTAL) != hipSuccess || per_cu < 1) { fprintf(stderr, "kernel_launch: occupancy query says %d blocks per CU\n", per_cu); per_cu = 1; }
        (void)hipGetLastError();
        grid = cus * 1;
    }
    if (grid < 0) return;
    Params p{};
    p.xp = (const float*)d_in[0]; p.xs = (const float*)d_in[1]; p.attn_norm = (const float*)d_in[2]; p.w_in0 = (const float*)d_in[3];
    p.lq1 = (const float*)d_in[4]; p.lk1 = (const float*)d_in[5]; p.lq2 = (const float*)d_in[6]; p.lk2 = (const float*)d_in[7];
    p.subln = (const float*)d_in[8]; p.w_out0 = (const float*)d_in[9]; p.fnet_norm = (const float*)d_in[10]; p.w_in1 = (const float*)d_in[11];
    p.w_out1 = (const float*)d_in[12]; p.final_norm = (const float*)d_in[13];
    p.out = (float*)d_out; p.ws = (unsigned char*)d_ws;
    void* args[] = {&p};
    const hipError_t e = hipLaunchCooperativeKernel((const void*)fwd_kernel, dim3(grid), dim3(NTHR), args, LDS_TOTAL, stream);
    if (e != hipSuccess) fprintf(stderr, "kernel_launch: cooperative launch failed: %s (grid %d)\n", hipGetErrorString(e), grid);
}
```

```cpp
#include <hip/hip_runtime.h>
#include <hip/hip_cooperative_groups.h>
#include <cstdio>
#include <cstdint>
namespace cg = cooperative_groups;
namespace pg8 {
#define PG8_LAS __attribute__((address_space(3)))
typedef unsigned short bf16_t;
typedef short bf16x8 __attribute__((ext_vector_type(8)));
typedef float f32x4 __attribute__((ext_vector_type(4)));
typedef unsigned u32x4 __attribute__((ext_vector_type(4)));
constexpr int BM = 256, BK = 64, HALF = 128, HTB = HALF * BK * 2  , STAGE_BYTES = 8 * HTB, NXCD = 8, WGM = 8;

__host__ __device__ __forceinline__ int lds_byte(int r, int c) { const int st = (r >> 4) * 2 + (c >> 5), rr = r & 15, cc = c & 31, ob = rr * 64 + cc * 2; return st * 1024 + (ob ^ (((ob >> 9) & 1) << 5)); }
__host__ __device__ __forceinline__ void stage_rc(int b, int& R, int& C) { const int st = b / 1024, sb = b % 1024, swz = sb ^ (((sb >> 9) & 1) << 5); R = (st >> 1) * 16 + swz / 64; C = (st & 1) * 32 + (swz % 64) / 2; }
__host__ __device__ __forceinline__ int perm32(int rho) { const int n = rho >> 4, i = rho & 15; return 8 * (i >> 2) + 4 * n + (i & 3); }

struct Unit { int pm, pn; };
struct Gemm { const bf16_t* A; const bf16_t* Bt; int M, N, K, lda, ldb; };

struct StaticOrder {
    int nM, nN, nwg, G, c;
    __host__ __device__ void init(int M, int N, int G_, int c_) { nM = M / BM; nN = N / BM; nwg = nM * nN; G = G_; c = c_; }
    __host__ __device__ bool next(int i, Unit& u) const {
        const long L = (long)i * G + c; if (L >= nwg) return false;
        int wgid = (int)L; { const int q = nwg / NXCD, r = nwg % NXCD, xcd = wgid % NXCD, off = wgid / NXCD; wgid = (xcd < r ? xcd * (q + 1) : r * (q + 1) + (xcd - r) * q) + off; }
        const int nig = WGM * nN, gid = wgid / nig, fm = gid * WGM, gsz = (nM - fm) < WGM ? (nM - fm) : WGM;
        u.pm = fm + ((wgid % nig) % gsz); u.pn = (wgid % nig) / gsz; return true;
    }
    __device__ __forceinline__ void a_ready(const Unit&) const {}
    __device__ __forceinline__ void done(const Unit&) const {}
};
template <class Epi, class Sched, bool ALIGN_EPI = false, bool SP2 = false>
__device__ __forceinline__ void gemm_phase(PG8_LAS unsigned char* lds, const Gemm g, const Sched& S, const Epi& E) {
    const int tid = threadIdx.x, wid = __builtin_amdgcn_readfirstlane(tid >> 6), lane = tid & 63, wr = wid >> 2, wc = wid & 3, fr = lane & 15, fq = lane >> 4;
    const int K = g.K, nt = K / BK;
    unsigned voffA[2], voffB[2];
#pragma unroll
    for (int i = 0; i < 2; ++i) { int R, C; stage_rc(tid * 16 + i * 8192, R, C); const int Rb = Epi::PERM ? ((R & ~31) + perm32(R & 31)) : R;
        voffA[i] = (unsigned)(R * g.lda + C) * 2u; voffB[i] = (unsigned)(Rb * g.ldb + C) * 2u; }
    const size_t kstep = (size_t)(BK * 2);
    const size_t hstepA = (size_t)HALF * g.lda * 2, hstepB = (size_t)HALF * g.ldb * 2;
    const size_t tstepA = 2 * hstepA, tstepB = 2 * hstepB;
    const unsigned ldsw = (unsigned)wid * 1024u;
    const int aoff = lds_byte(wr * 64 + fr, fq * 8), boff = lds_byte(wc * 32 + fr, fq * 8);
#define PG8_SA(b, h) (((b) * 2 + (h)) * HTB)
#define PG8_SB(b, h) ((4 + (b) * 2 + (h)) * HTB)
#define PG8_STAGE(bufoff, gbase, voff) do { _Pragma("unroll") for (int _i = 0; _i < 2; ++_i) \
        __builtin_amdgcn_global_load_lds((const unsigned*)((const char*)(gbase) + (voff)[_i]), (PG8_LAS unsigned*)(lds + (bufoff) + ldsw + _i * 8192), 16, 0, 0); } while (0)
#define PG8_LDA(dst, b, h) do { _Pragma("unroll") for (int m = 0; m < 4; ++m) _Pragma("unroll") for (int k = 0; k < 2; ++k) dst[m][k] = *(const PG8_LAS bf16x8*)(lds + PG8_SA(b, h) + aoff + m * 2048 + k * 1024); } while (0)
#define PG8_LDB(dst, b, h) do { _Pragma("unroll") for (int n = 0; n < 2; ++n) _Pragma("unroll") for (int k = 0; k < 2; ++k) dst[n][k] = *(const PG8_LAS bf16x8*)(lds + PG8_SB(b, h) + boff + n * 2048 + k * 1024); } while (0)
#define PG8_MMA(ai, bj, At, Bt) do { __builtin_amdgcn_s_setprio(1); _Pragma("unroll") for (int m = 0; m < 4; ++m) _Pragma("unroll") for (int n = 0; n < 2; ++n) _Pragma("unroll") for (int k = 0; k < 2; ++k) \
        acc[ai][bj][m][n] = __builtin_amdgcn_mfma_f32_16x16x32_bf16(Bt[n][k], At[m][k], acc[ai][bj][m][n], 0, 0, 0); __builtin_amdgcn_s_setprio(0); } while (0)
#define PG8_WAIT_V(n) asm volatile("s_waitcnt vmcnt(" #n ")" ::: "memory")
#define PG8_WAIT_L(n) asm volatile("s_waitcnt lgkmcnt(" #n ")" ::: "memory")
#define PG8_BAR __builtin_amdgcn_s_barrier()
#define PG8_SCHED __builtin_amdgcn_sched_barrier(0)
    Unit cur, nxt; int ui = 0;
    if (!S.next(0, cur)) return;
    f32x4 acc[2][2][4][2];
#pragma unroll
    for (int a = 0; a < 2; ++a)
#pragma unroll
        for (int b = 0; b < 2; ++b)
#pragma unroll
            for (int m = 0; m < 4; ++m)
#pragma unroll
                for (int n = 0; n < 2; ++n) acc[a][b][m][n] = (f32x4){0.f, 0.f, 0.f, 0.f};
    bf16x8 At[4][2], B0[2][2], B1[2][2];
    const char* cA = (const char*)g.A + (size_t)cur.pm * tstepA; const char* cB = (const char*)g.Bt + (size_t)cur.pn * tstepB;
    S.a_ready(cur);
    if constexpr (SP2) {
        PG8_STAGE(PG8_SB(0, 0), cB, voffB); PG8_STAGE(PG8_SB(0, 1), cB + hstepB, voffB); PG8_STAGE(PG8_SA(0, 0), cA, voffA); PG8_STAGE(PG8_SA(0, 1), cA + hstepA, voffA);
        if (wr == 1) PG8_BAR;
        PG8_WAIT_V(2); PG8_BAR;
        PG8_STAGE(PG8_SB(1, 0), cB + kstep, voffB); PG8_STAGE(PG8_SA(1, 0), cA + kstep, voffA); PG8_STAGE(PG8_SB(1, 1), cB + hstepB + kstep, voffB);
        PG8_WAIT_V(6); PG8_BAR;
    } else {
        PG8_STAGE(PG8_SB(0, 0), cB, voffB); PG8_STAGE(PG8_SA(0, 0), cA, voffA); PG8_STAGE(PG8_SB(0, 1), cB + hstepB, voffB); PG8_STAGE(PG8_SA(0, 1), cA + hstepA, voffA);
        if (wr == 1) PG8_BAR;
        PG8_WAIT_V(4); PG8_BAR;
        PG8_STAGE(PG8_SB(1, 0), cB + kstep, voffB); PG8_STAGE(PG8_SA(1, 0), cA + kstep, voffA); PG8_STAGE(PG8_SB(1, 1), cB + hstepB + kstep, voffB);
        PG8_WAIT_V(6); PG8_BAR;
    }
    for (;;) {
        const bool has_next = S.next(ui + 1, nxt);
        const char* nA = has_next ? (const char*)g.A + (size_t)nxt.pm * tstepA : cA; const char* nB = has_next ? (const char*)g.Bt + (size_t)nxt.pn * tstepB : cB;
        for (int t = 0; t < nt; t += 2) {
            const bool last = (t == nt - 2);
            const char* a1 = cA + (size_t)(t + 1) * kstep;
            const char* a2 = last ? nA : cA + (size_t)(t + 2) * kstep; const char* b2 = last ? nB : cB + (size_t)(t + 2) * kstep;
            const char* a3 = a2 + kstep; const char* b3 = b2 + kstep;
            if (last && has_next) S.a_ready(nxt);
            if constexpr (SP2) {
            PG8_LDB(B0, 0, 0); PG8_LDB(B1, 0, 1); PG8_SCHED; PG8_LDA(At, 0, 0); PG8_STAGE(PG8_SA(1, 1), a1 + hstepA, voffA);
            PG8_WAIT_V(8); PG8_WAIT_L(0); PG8_BAR; PG8_MMA(0, 0, At, B0); PG8_MMA(0, 1, At, B1); PG8_BAR; PG8_SCHED;
            PG8_LDA(At, 0, 1); PG8_STAGE(PG8_SB(0, 0), b2, voffB); PG8_STAGE(PG8_SB(0, 1), b2 + hstepB, voffB); PG8_STAGE(PG8_SA(0, 0), a2, voffA);
            PG8_WAIT_V(8); PG8_WAIT_L(0); PG8_BAR; PG8_MMA(1, 0, At, B0); PG8_MMA(1, 1, At, B1); PG8_BAR; PG8_SCHED;
            PG8_LDB(B0, 1, 0); PG8_LDB(B1, 1, 1); PG8_SCHED; PG8_LDA(At, 1, 0); PG8_STAGE(PG8_SA(0, 1), a2 + hstepA, voffA);
            PG8_WAIT_V(8); PG8_WAIT_L(0); PG8_BAR; PG8_MMA(0, 0, At, B0); PG8_MMA(0, 1, At, B1); PG8_BAR; PG8_SCHED;
            PG8_LDA(At, 1, 1); PG8_STAGE(PG8_SB(1, 0), b3, voffB); PG8_STAGE(PG8_SB(1, 1), b3 + hstepB, voffB); PG8_STAGE(PG8_SA(1, 0), a3, voffA);
            PG8_WAIT_V(8); PG8_WAIT_L(0); PG8_BAR; PG8_MMA(1, 0, At, B0); PG8_MMA(1, 1, At, B1); PG8_BAR; PG8_SCHED;
            } else {
            PG8_LDB(B0, 0, 0); PG8_SCHED; PG8_LDA(At, 0, 0); PG8_STAGE(PG8_SA(1, 1), a1 + hstepA, voffA);
            PG8_WAIT_L(8); PG8_BAR; PG8_WAIT_L(0); PG8_MMA(0, 0, At, B0); PG8_BAR; PG8_SCHED;
            PG8_LDB(B1, 0, 1); PG8_STAGE(PG8_SB(0, 0), b2, voffB);
            PG8_BAR; PG8_WAIT_L(0); PG8_MMA(0, 1, At, B1); PG8_BAR;
            PG8_LDA(At, 0, 1); PG8_STAGE(PG8_SA(0, 0), a2, voffA);
            PG8_BAR; PG8_WAIT_L(0); PG8_MMA(1, 0, At, B0); PG8_BAR; PG8_SCHED;
            PG8_STAGE(PG8_SB(0, 1), b2 + hstepB, voffB);
            PG8_WAIT_V(6); PG8_BAR; PG8_MMA(1, 1, At, B1); PG8_BAR;
            PG8_LDB(B0, 1, 0); PG8_SCHED; PG8_LDA(At, 1, 0); PG8_STAGE(PG8_SA(0, 1), a2 + hstepA, voffA);
            PG8_WAIT_L(8); PG8_BAR; PG8_WAIT_L(0); PG8_MMA(0, 0, At, B0); PG8_BAR; PG8_SCHED;
            PG8_LDB(B1, 1, 1); PG8_STAGE(PG8_SB(1, 0), b3, voffB);
            PG8_BAR; PG8_WAIT_L(0); PG8_MMA(0, 1, At, B1); PG8_BAR;
            PG8_LDA(At, 1, 1); PG8_STAGE(PG8_SA(1, 0), a3, voffA);
            PG8_BAR; PG8_WAIT_L(0); PG8_MMA(1, 0, At, B0); PG8_BAR; PG8_SCHED;
            PG8_STAGE(PG8_SB(1, 1), b3 + hstepB, voffB);
            PG8_WAIT_V(6); PG8_BAR; PG8_MMA(1, 1, At, B1); PG8_BAR;
            }
        }
        if constexpr (ALIGN_EPI) { if (wr == 0) PG8_BAR; }
        if constexpr (!Epi::AFTER_DRAIN) { E(acc, cur, wr, wc, fr, fq); S.done(cur); }
        if (!has_next) break;
#pragma unroll
        for (int a = 0; a < 2; ++a)
#pragma unroll
            for (int b = 0; b < 2; ++b)
#pragma unroll
                for (int m = 0; m < 4; ++m)
#pragma unroll
                    for (int n = 0; n < 2; ++n) acc[a][b][m][n] = (f32x4){0.f, 0.f, 0.f, 0.f};
        cur = nxt; cA = nA; cB = nB; ++ui;
        if constexpr (ALIGN_EPI) { if (wr == 1) PG8_BAR; }
    }
    PG8_WAIT_V(0);
    if constexpr (!ALIGN_EPI) { if (wr == 0) PG8_BAR; }
    PG8_BAR;
    if constexpr (Epi::AFTER_DRAIN) { E.fused(acc, cur, wr, wc, fr, fq, lds, wid, lane); S.done(cur); }
#undef PG8_SA
#undef PG8_SB
#undef PG8_STAGE
#undef PG8_LDA
#undef PG8_LDB
#undef PG8_MMA
#undef PG8_WAIT_V
#undef PG8_WAIT_L
#undef PG8_BAR
#undef PG8_SCHED
}
}
#ifndef LAS
#define LAS __attribute__((address_space(3)))
#endif

#define XB_TMO      128
#define XB_XCNT(j)  (256  + 64 * (j))
#define XB_XSUB(j)  (1280 + 64 * (j))
#define XB_XGEN(j)  (2304 + 64 * (j))
#define XB_TOP      3328
#define XB_TOPGEN   3392
#define XCD_BAR_WORDS 3456
#define XB_SPIN_CAP (1u << 18)

__device__ __forceinline__ unsigned xb_ld(unsigned* p)              { return __hip_atomic_load(p, __ATOMIC_RELAXED, __HIP_MEMORY_SCOPE_AGENT); }
__device__ __forceinline__ unsigned xb_add(unsigned* p, unsigned v) { return __hip_atomic_fetch_add(p, v, __ATOMIC_RELAXED, __HIP_MEMORY_SCOPE_AGENT); }
__device__ __forceinline__ unsigned xb_xcc_id() { return (unsigned)__builtin_amdgcn_s_getreg((3 << 11) | 20) & 0xFu; }
#define XB_SPIN(cond, bar) do { unsigned _sp = 0; while (cond) { __builtin_amdgcn_s_sleep(1); \
    if ((++_sp & 255u) == 0u) { if (xb_ld(&(bar)[XB_TMO])) break; if (_sp > XB_SPIN_CAP) { atomicAdd(&(bar)[XB_TMO], 1u); break; } } } } while (0)

struct XcdBarrier {
    unsigned* bar; unsigned x;
    volatile LAS unsigned* st;
};

__device__ __forceinline__ XcdBarrier xcd_barrier_post(unsigned* bar, volatile LAS unsigned* st) {
    XcdBarrier b; b.bar = bar; b.x = xb_xcc_id(); b.st = st;
    if (threadIdx.x == 0) (void)xb_add(&bar[XB_XCNT(b.x)], 1u);
    return b;
}
__device__ __forceinline__ void xcd_barrier_complete(unsigned* bar, unsigned x, unsigned& nloc, unsigned& nx) {
    const unsigned G = gridDim.x * gridDim.y * gridDim.z;
    unsigned sum, cnt, mine, sp = 0u;
    for (;;) {
        sum = 0u; cnt = 0u; mine = 0u;
#pragma unroll
        for (unsigned j = 0; j < 16; ++j) { const unsigned c = xb_ld(&bar[XB_XCNT(j)]); sum += c; cnt += (c > 0u) ? 1u : 0u; mine = (j == x) ? c : mine; }
        if (sum == G) break;
        __builtin_amdgcn_s_sleep(1);
        if ((++sp & 255u) == 0u) { if (xb_ld(&bar[XB_TMO])) break; if (sp > XB_SPIN_CAP) { atomicAdd(&bar[XB_TMO], 1u); break; } }
    }
    nloc = mine > 0u ? mine : 1u; nx = cnt > 0u ? cnt : 1u;
}

__device__ __forceinline__ void xcd_barrier(const XcdBarrier& b) {
    asm volatile("s_waitcnt vmcnt(0)" ::: "memory");
    __syncthreads();
    if (threadIdx.x == 0) {
        unsigned* bar = b.bar;
        __builtin_amdgcn_s_waitcnt(0);
        unsigned nloc = b.st[0], nx = b.st[1];
        if (nloc == 0u) { xcd_barrier_complete(bar, b.x, nloc, nx); b.st[0] = nloc; b.st[1] = nx; }
        const unsigned old = xb_add(&bar[XB_XSUB(b.x)], 1u);
        const unsigned gen = old / nloc;
        if (old + 1u == (gen + 1u) * nloc) {
            __builtin_amdgcn_fence(__ATOMIC_RELEASE, "agent");
            asm volatile("s_waitcnt vmcnt(0)" ::: "memory");
            const unsigned og = xb_add(&bar[XB_TOP], 1u);
            const unsigned tg = og / nx;
            if (og + 1u == (tg + 1u) * nx) xb_add(&bar[XB_TOPGEN], 1u);
            else XB_SPIN(xb_ld(&bar[XB_TOPGEN]) == tg, bar);
            __builtin_amdgcn_fence(__ATOMIC_ACQUIRE, "agent");
            xb_add(&bar[XB_XGEN(b.x)], 1u);
            asm volatile("s_waitcnt vmcnt(0)" ::: "memory");
        } else {
            XB_SPIN(xb_ld(&bar[XB_XGEN(b.x)]) == gen, bar);
            __builtin_amdgcn_fence(__ATOMIC_ACQUIRE, "agent");
            asm volatile("s_waitcnt vmcnt(0)" ::: "memory");
        }
    }
    __syncthreads();
}


__device__ __attribute__((aligned(256))) unsigned g_bar[XCD_BAR_WORDS];
#ifndef LAS
#define LAS __attribute__((address_space(3)))
#endif
typedef unsigned short bf16_t;
typedef short bf16x8 __attribute__((ext_vector_type(8)));
typedef short s16x4 __attribute__((ext_vector_type(4)));
typedef float f32x4 __attribute__((ext_vector_type(4)));
typedef float f32x16 __attribute__((ext_vector_type(16)));
typedef unsigned u32x4 __attribute__((ext_vector_type(4)));
typedef unsigned u32x2 __attribute__((ext_vector_type(2)));
typedef float f32x2_t __attribute__((ext_vector_type(2)));
typedef __bf16 bf16x2_t __attribute__((ext_vector_type(2)));

constexpr int DM = 1024, MTOT = 32768, SEQP = 16384, SEQS = 2048;
constexpr int NTHR = 512;
constexpr float EPS = 1e-6f, SUBLN_EPS = 1e-5f, LOG2E = 1.4426950408889634f;
constexpr float QSCALE = 0.125f * LOG2E;
constexpr int XB_LDS_OFF = 131072, LDS_TOTAL = 131072 + 256;

__device__ __attribute__((aligned(256))) bf16_t g_w0t[4096 * 1024];
__device__ __attribute__((aligned(256))) bf16_t g_wo0t[1024 * 1024];
__device__ __attribute__((aligned(256))) bf16_t g_ws1[1024 * 1024];
__device__ __attribute__((aligned(256))) bf16_t g_w1t[3072 * 1024];
__device__ __attribute__((aligned(256))) bf16_t g_wo1t[1024 * 1024];
__device__ __attribute__((aligned(256))) bf16_t g_tab128[256 * 128];
__device__ __attribute__((aligned(256))) bf16_t g_tab16[32 * 32];
__device__ __attribute__((aligned(256))) float g_r0[MTOT];
__device__ __attribute__((aligned(256))) float g_ss1[MTOT];
__device__ __attribute__((aligned(256))) float g_ss2[MTOT];
__device__ __attribute__((aligned(256))) unsigned g_nrm[64];
__device__ __attribute__((aligned(256))) unsigned g_ctr[4];

struct Params {
    const float* xp; const float* xs; const float* attn_norm; const float* w_in0; const float* lq1; const float* lk1; const float* lq2; const float* lk2;
    const float* subln; const float* w_out0; const float* fnet_norm; const float* w_in1; const float* w_out1; const float* final_norm;
    float* out; unsigned char* ws;
};

__device__ __forceinline__ unsigned pk2(float lo, float hi) { f32x2_t v = {lo, hi}; bf16x2_t b = __builtin_convertvector(v, bf16x2_t); return __builtin_bit_cast(unsigned, b); }
__device__ __forceinline__ float bf_lo(unsigned u) { return __uint_as_float(u << 16); }
__device__ __forceinline__ float bf_hi(unsigned u) { return __uint_as_float(u & 0xffff0000u); }
__device__ __forceinline__ float wave_sum(float v) { v += __shfl_xor(v, 32); v += __shfl_xor(v, 16); v += __shfl_xor(v, 8); v += __shfl_xor(v, 4); v += __shfl_xor(v, 2); v += __shfl_xor(v, 1); return v; }
__device__ __forceinline__ float silu_f(float z) { return z / (1.0f + __expf(-z)); }
__device__ __forceinline__ int crow(int r, int hi) { return (r & 3) + 8 * (r >> 2) + 4 * hi; }
#define BLK_SYNC() __syncthreads()

struct EpiRowBf16 {
    static constexpr bool PERM = true, AFTER_DRAIN = false;
    bf16_t* b0; bf16_t* b1; bf16_t* b2; bf16_t* b3; int ld0, ld1; int split_cols; const float* rstat; int stat_is_sumsq; float scale0; unsigned* nrm;
    __device__ __forceinline__ void operator()(const pg8::f32x4 (&acc)[2][2][4][2], const pg8::Unit& u, int wr, int wc, int fr, int fq) const {
        const int row0 = u.pm * 256 + wr * 64 + fr; int colt = u.pn * 256; const int t = colt / split_cols; colt -= t * split_cols;
        bf16_t* b = (t == 0) ? b0 : (t == 1) ? b1 : (t == 2) ? b2 : b3; const int ld = (t == 0) ? ld0 : ld1; const float sc = (t == 0) ? scale0 : 1.0f;
        const int col0 = colt + wc * 32 + 8 * fq; const bool donrm = (nrm != nullptr) && (t < 2); float mx[2] = {0.f, 0.f};
#pragma unroll
        for (int ai = 0; ai < 2; ++ai)
#pragma unroll
            for (int m = 0; m < 4; ++m) {
                const int row = row0 + ai * 128 + m * 16; float rs = rstat[row];
                if (stat_is_sumsq) rs = rsqrtf(rs * (1.0f / 1024.0f) + EPS);
                rs *= sc; bf16_t* rowp = b + (size_t)row * ld + col0;
#pragma unroll
                for (int bj = 0; bj < 2; ++bj) { const pg8::f32x4 v0 = acc[ai][bj][m][0] * rs, v1 = acc[ai][bj][m][1] * rs;
                    u32x4 w; w.x = pk2(v0[0], v0[1]); w.y = pk2(v0[2], v0[3]); w.z = pk2(v1[0], v1[1]); w.w = pk2(v1[2], v1[3]);
                    *(u32x4*)(rowp + bj * 128) = w;
                    if (donrm) { float ps = (v0[0] * v0[0] + v0[1] * v0[1]) + (v0[2] * v0[2] + v0[3] * v0[3]) + (v1[0] * v1[0] + v1[1] * v1[1]) + (v1[2] * v1[2] + v1[3] * v1[3]);
                        ps += __shfl_xor(ps, 16); ps += __shfl_xor(ps, 32); mx[bj] = fmaxf(mx[bj], ps); } }
            }
        if (donrm) {
#pragma unroll
            for (int bj = 0; bj < 2; ++bj) { float v = mx[bj]; v = fmaxf(v, __shfl_xor(v, 1)); v = fmaxf(v, __shfl_xor(v, 2)); v = fmaxf(v, __shfl_xor(v, 4)); v = fmaxf(v, __shfl_xor(v, 8));
                if ((threadIdx.x & 63) == 0) atomicMax(nrm + t * 32 + ((colt + bj * 128 + wc * 32) >> 6) * 2 + (wc & 1), __float_as_uint(v)); }
        }
    }
};
struct EpiFold {
    static constexpr bool PERM = true, AFTER_DRAIN = false;
    bf16_t* O; int g;
    __device__ __forceinline__ void operator()(const pg8::f32x4 (&acc)[2][2][4][2], const pg8::Unit& u, int wr, int wc, int fr, int fq) const {
        const int col0 = u.pn * 256 + wc * 32 + 8 * fq;
#pragma unroll
        for (int ai = 0; ai < 2; ++ai)
#pragma unroll
            for (int m = 0; m < 4; ++m) {
                const int j = wr * 64 + m * 16 + fr; bf16_t* rowp = O + (size_t)(ai * 1024 + g * 128 + j) * 1024 + col0;
#pragma unroll
                for (int bj = 0; bj < 2; ++bj) { const pg8::f32x4 v0 = acc[ai][bj][m][0], v1 = acc[ai][bj][m][1];
                    u32x4 w; w.x = pk2(v0[0], v0[1]); w.y = pk2(v0[2], v0[3]); w.z = pk2(v1[0], v1[1]); w.w = pk2(v1[2], v1[3]);
                    *(u32x4*)(rowp + bj * 128) = w; }
            }
    }
};
struct EpiResid {
    static constexpr bool PERM = false, AFTER_DRAIN = false;
    const float* resA; const float* resB; float* out; bf16_t* outb; float* ss;
    __device__ __forceinline__ void operator()(const pg8::f32x4 (&acc)[2][2][4][2], const pg8::Unit& u, int wr, int wc, int fr, int fq) const {
        const int row0 = u.pm * 256 + wr * 64 + fr; const int col0 = u.pn * 256 + wc * 32 + 4 * fq;
#pragma unroll
        for (int ai = 0; ai < 2; ++ai)
#pragma unroll
            for (int m = 0; m < 4; ++m) {
                const int row = row0 + ai * 128 + m * 16;
                const float* rp = (row < SEQP) ? (resA + (size_t)row * DM) : (resB + (size_t)(row - SEQP) * DM);
                float s = 0.f;
#pragma unroll
                for (int bj = 0; bj < 2; ++bj)
#pragma unroll
                    for (int n = 0; n < 2; ++n) { const int col = col0 + bj * 128 + n * 16;
                        const pg8::f32x4 r = *(const pg8::f32x4*)(rp + col); const pg8::f32x4 v = r + acc[ai][bj][m][n];
                        *(pg8::f32x4*)(out + (size_t)row * DM + col) = v;
                        if (outb) { u32x2 w; w.x = pk2(v[0], v[1]); w.y = pk2(v[2], v[3]); *(u32x2*)(outb + (size_t)row * DM + col) = w; }
                        s += (v[0] * v[0] + v[1] * v[1]) + (v[2] * v[2] + v[3] * v[3]); }
                s += __shfl_xor(s, 16); s += __shfl_xor(s, 32);
                if (fq == 0) atomicAdd(ss + row, s);
            }
    }
};
struct OneUnit { int pn; __device__ bool next(int i, pg8::Unit& u) const { if (i > 0) return false; u.pm = 0; u.pn = pn; return true; }
    __device__ __forceinline__ void a_ready(const pg8::Unit&) const {} __device__ __forceinline__ void done(const pg8::Unit&) const {} };

__device__ __forceinline__ void transpose_item(const float* W, int ldw, const float* gain, bf16_t* WT, LAS float* scr, int item, int nblk, int lane) {
    const int kb = item / nblk, nb = item % nblk, k0 = 64 * kb, n0 = 32 * nb;
#pragma unroll 8
    for (int i = 0; i < 32; ++i) { const int kk = 2 * i + (lane >> 5); const float gk = gain ? gain[k0 + kk] : 1.0f; scr[kk * 33 + (lane & 31)] = W[(size_t)(k0 + kk) * ldw + n0 + (lane & 31)] * gk; }
    asm volatile("s_waitcnt lgkmcnt(0)" ::: "memory");
    const int c = lane & 7;
#pragma unroll
    for (int j = 0; j < 4; ++j) { const int n = (lane >> 3) + 8 * j; const LAS float* s = scr + (8 * c) * 33 + n;
        u32x4 o; o.x = pk2(s[0 * 33], s[1 * 33]); o.y = pk2(s[2 * 33], s[3 * 33]); o.z = pk2(s[4 * 33], s[5 * 33]); o.w = pk2(s[6 * 33], s[7 * 33]);
        *(u32x4*)(WT + (size_t)(n0 + n) * 1024 + k0 + 8 * c) = o; }
    asm volatile("s_waitcnt lgkmcnt(0)" ::: "memory");
}

__device__ __forceinline__ void phase0(const Params& p, LAS unsigned char* lds, bf16_t* XB) {
    const int tid = threadIdx.x, lane = tid & 63, wave = tid >> 6;
    const int gw = blockIdx.x * 8 + wave, NGW = gridDim.x * 8;
    for (int row = gw; row < MTOT; row += NGW) {
        const float* xr = (row < SEQP) ? (p.xp + (size_t)row * DM) : (p.xs + (size_t)(row - SEQP) * DM);
        f32x4 v[4]; float ss = 0.f;
#pragma unroll
        for (int i = 0; i < 4; ++i) { v[i] = *(const f32x4*)(xr + 4 * (lane + 64 * i)); ss += (v[i][0] * v[i][0] + v[i][1] * v[i][1]) + (v[i][2] * v[i][2] + v[i][3] * v[i][3]); }
        ss = wave_sum(ss);
        if (lane == 0) g_r0[row] = rsqrtf(ss * (1.0f / 1024.0f) + EPS);
#pragma unroll
        for (int i = 0; i < 4; ++i) { u32x2 w; w.x = pk2(v[i][0], v[i][1]); w.y = pk2(v[i][2], v[i][3]); *(u32x2*)(XB + (size_t)row * DM + 4 * (lane + 64 * i)) = w; }
    }
    for (int i = blockIdx.x * NTHR + tid; i < MTOT; i += gridDim.x * NTHR) { g_ss1[i] = 0.f; g_ss2[i] = 0.f; }
    if (blockIdx.x == 0 && tid < 64) { g_nrm[tid] = 0u; if (tid < 4) g_ctr[tid] = 0u; }
    if (blockIdx.x == 0) for (int i = tid; i < XCD_BAR_WORDS; i += NTHR) g_bar[i] = 0u;
    LAS float* scr = (LAS float*)(lds + wave * 8704);
    constexpr int I0 = 16 * 128, I1 = 16 * 32, NIT = I0 + 3 * I1;
    for (int it = gw; it < NIT; it += NGW) {
        int r = it;
        if (r < I0) { transpose_item(p.w_in0, 4096, p.attn_norm, g_w0t, scr, r, 128, lane); continue; } r -= I0;
        if (r < I1) { transpose_item(p.w_out0, 1024, nullptr, g_wo0t, scr, r, 32, lane); continue; } r -= I1;
        if (r < I1) { transpose_item(p.w_in1 + 1024, 2048, p.fnet_norm, g_w1t + (size_t)2048 * 1024, scr, r, 32, lane); continue; } r -= I1;
        transpose_item(p.w_out1, 1024, nullptr, g_wo1t, scr, r, 32, lane);
    }
    for (int i = blockIdx.x * NTHR + tid; i < 1024 * 256; i += gridDim.x * NTHR) {
        const int k = i >> 8, c4 = (i & 255) * 4; const f32x4 w = *(const f32x4*)(p.w_in1 + (size_t)k * 2048 + c4); const float gk = p.fnet_norm[k];
        u32x2 o; o.x = pk2(w[0] * gk, w[1] * gk); o.y = pk2(w[2] * gk, w[3] * gk); *(u32x2*)(g_ws1 + (size_t)k * 1024 + c4) = o;
    }
    for (int i = blockIdx.x * NTHR + tid; i < 256 * 128; i += gridDim.x * NTHR) {
        const int rr = i >> 7, n = i & 127, k = rr & 127, part = rr >> 7; const float th = (float)((k * n) & 127) * (6.283185307179586f / 128.0f);
        const float v = part ? sinf(th) : cosf(th); g_tab128[i] = (bf16_t)(pk2(v, 0.f) & 0xffffu);
    }
    for (int i = blockIdx.x * NTHR + tid; i < 32 * 32; i += gridDim.x * NTHR) {
        const int kk = i >> 5, j = i & 31, k1 = kk & 15, po = kk >> 4, n1 = j & 15, pi = j >> 4; const float th = (float)((k1 * n1) & 15) * (6.283185307179586f / 16.0f);
        float v; if (po == 0) v = pi ? -sinf(th) : cosf(th); else v = pi ? -cosf(th) : -sinf(th);
        g_tab16[i] = (bf16_t)(pk2(v, 0.f) & 0xffffu);
    }
}

constexpr int AT_KP = 144, AT_VP = 320, AT_K2 = 64 * AT_KP, AT_V = 2 * 64 * AT_KP, AT_STAGE = AT_V + 64 * AT_VP, AT_XP = 528;
typedef short v4i16_t __attribute__((ext_vector_type(4)));
__device__ __forceinline__ s16x4 tr_read(LAS const unsigned char* p) { return __builtin_bit_cast(s16x4, __builtin_amdgcn_ds_read_tr16_b64_v4i16((LAS v4i16_t*)p)); }
__device__ __forceinline__ bf16x8 cat8(s16x4 a, s16x4 b) { return (bf16x8){a[0], a[1], a[2], a[3], b[0], b[1], b[2], b[3]}; }
__device__ __forceinline__ bf16x8 neg8(bf16x8 a) { typedef int i32x4 __attribute__((ext_vector_type(4))); i32x4 v = __builtin_bit_cast(i32x4, a); v = v ^ (int)0x80008000; return __builtin_bit_cast(bf16x8, v); }
#define MFMA32(a, b, c) __builtin_amdgcn_mfma_f32_32x32x16_bf16((a), (b), (c), 0, 0, 0)

__device__ __forceinline__ void attn_phase(const Params& p, LAS unsigned char* lds, const bf16_t* Qb, const bf16_t* Kb, const bf16_t* Vb, const bf16_t* Zb, bf16_t* Ob, unsigned* ctr) {
    const int tid = threadIdx.x, lane = tid & 63, wave = __builtin_amdgcn_readfirstlane(tid >> 6), r32 = lane & 31, hi = lane >> 5;
    const int map = wave >> 2, qs = wave & 3;
    float lam;
    { const float a = wave_sum(p.lq1[lane] * p.lk1[lane]), b = wave_sum(p.lq2[lane] * p.lk2[lane]); lam = expf(a) - expf(b) + 0.2f; }
    const int g16 = lane >> 4, i16 = lane & 15, tq = i16 >> 2, tp = i16 & 3;
    LAS unsigned* qword = (LAS unsigned*)(lds + 2 * AT_STAGE);
    for (;;) {
        if (tid == 0) *qword = atomicAdd(ctr, 1u);
        BLK_SYNC();
        const int unit = (int)*qword;
        if (unit >= 2048) break;
        int R0s, S, h, q0;
        if (unit < 1024) { R0s = 0; S = SEQP; h = 7 - (unit >> 7); q0 = (unit & 127) * 128; }
        else { const int v = unit - 1024; h = 7 - (v >> 7); R0s = SEQP + ((v >> 4) & 7) * SEQS; S = SEQS; q0 = (v & 15) * 128; }
        const float slope2 = exp2f(-(float)(h + 1)) * LOG2E;
        int t_lo, t_hi;
        { float B2 = 0.f;
#pragma unroll
          for (int mm = 0; mm < 2; ++mm) { const int e = (2 * h + mm) * 2;
              const float qn2 = __uint_as_float(g_nrm[e]) + __uint_as_float(g_nrm[e + 1]), kn2 = __uint_as_float(g_nrm[32 + e]) + __uint_as_float(g_nrm[32 + e + 1]);
              B2 = fmaxf(B2, sqrtf(qn2 * kn2) * 1.02f); }
          const float thr = 2.0f * B2 + 25.0f - log2f(1.0f - exp2f(-slope2));
          const float dminf = fminf(ceilf(thr / slope2), 1.0e6f); const int dmin = (int)dminf;
          const int NTL = S / 64; int lo = q0 - dmin + 1; lo = lo < 0 ? 0 : lo; int hiK = q0 + 127 + dmin - 1; hiK = hiK > S - 1 ? S - 1 : hiK;
          t_lo = lo >> 6; t_hi = hiK >> 6; if (t_hi > NTL - 1) t_hi = NTL - 1; }
        const int qrow = R0s + q0 + qs * 32 + r32;
        bf16x8 qf[4];
        { const bf16_t* qp = Qb + (size_t)qrow * DM + h * 128 + map * 64 + hi * 8;
#pragma unroll
          for (int st = 0; st < 4; ++st) qf[st] = *(const bf16x8*)(qp + st * 16); }
        const float nslope2 = -slope2;
        const float qposf = (float)(q0 + qs * 32 + r32 - 4 * hi);
        float l = 0.f;
        f32x16 o[4];
#pragma unroll
        for (int db = 0; db < 4; ++db)
#pragma unroll
            for (int r = 0; r < 16; ++r) o[db][r] = 0.f;
        const bf16_t* gsrc[4]; int ldst[4];
#pragma unroll
        for (int i = 0; i < 4; ++i) { const int c = tid + 512 * i;
            if (i < 2) { const int row = c >> 4, ch = c & 15; gsrc[i] = Kb + (size_t)(R0s + t_lo * 64 + row) * DM + h * 128 + ch * 8; ldst[i] = (ch >> 3) * AT_K2 + row * AT_KP + (ch & 7) * 16; }
            else { const int c2 = c - 1024, row = c2 >> 4, ch = c2 & 15; gsrc[i] = Vb + (size_t)(R0s + t_lo * 64 + row) * DM + h * 128 + ch * 8; ldst[i] = AT_V + row * AT_VP + ch * 16; } }
        u32x4 stg[4];
#pragma unroll
        for (int i = 0; i < 4; ++i) stg[i] = *(const u32x4*)(gsrc[i]);
#pragma unroll
        for (int i = 0; i < 4; ++i) *(LAS u32x4*)(lds + ldst[i]) = stg[i];
        __builtin_amdgcn_s_waitcnt(0x0F70);
        BLK_SYNC();
        const int ntl = t_hi - t_lo + 1;
        for (int tt = 0; tt < ntl; ++tt) {
            const int stage = tt & 1;
            if (tt + 1 < ntl) {
#pragma unroll
                for (int i = 0; i < 4; ++i) stg[i] = *(const u32x4*)(gsrc[i] + (size_t)(tt + 1) * 64 * DM);
            }
            LAS const unsigned char* Kt = lds + stage * AT_STAGE + map * AT_K2 + r32 * AT_KP + hi * 16;
            LAS const unsigned char* vbase = lds + stage * AT_STAGE + AT_V + (4 * hi + tq) * AT_VP + (16 * (g16 & 1) + 4 * tp) * 2;
            bf16x8 kf0[4], kf1[4];
#pragma unroll
            for (int st = 0; st < 4; ++st) { kf0[st] = *(LAS const bf16x8*)(Kt + st * 32); kf1[st] = *(LAS const bf16x8*)(Kt + 32 * AT_KP + st * 32); }
            __builtin_amdgcn_sched_barrier(0);
            f32x16 s0, s1;
#pragma unroll
            for (int r = 0; r < 16; ++r) { s0[r] = 0.f; s1[r] = 0.f; }
#pragma unroll
            for (int st = 0; st < 4; ++st) { s0 = MFMA32(kf0[st], qf[st], s0); s1 = MFMA32(kf1[st], qf[st], s1); }
            bf16x8 vf[2][4];
#pragma unroll
            for (int ks = 0; ks < 4; ++ks) { LAS const unsigned char* a = vbase + (16 * ks) * AT_VP; vf[0][ks] = cat8(tr_read(a), tr_read(a + 8 * AT_VP)); }
            __builtin_amdgcn_sched_barrier(0);
            const float d0 = qposf - (float)((t_lo + tt) * 64);
            float rs = 0.f;
#pragma unroll
            for (int r = 0; r < 16; ++r) { const float c = (float)((r & 3) + 8 * (r >> 2));
                s0[r] = __builtin_amdgcn_exp2f(__builtin_fmaf(nslope2, fabsf(d0 - c), s0[r]));
                s1[r] = __builtin_amdgcn_exp2f(__builtin_fmaf(nslope2, fabsf(d0 - (32.0f + c)), s1[r]));
                rs += s0[r] + s1[r]; }
            l += rs;
            bf16x8 pf[4];
#pragma unroll
            for (int s = 0; s < 2; ++s) {
                u32x4 w0, w1;
                w0.x = pk2(s0[8 * s + 0], s0[8 * s + 1]); w0.y = pk2(s0[8 * s + 2], s0[8 * s + 3]); w0.z = pk2(s0[8 * s + 4], s0[8 * s + 5]); w0.w = pk2(s0[8 * s + 6], s0[8 * s + 7]);
                w1.x = pk2(s1[8 * s + 0], s1[8 * s + 1]); w1.y = pk2(s1[8 * s + 2], s1[8 * s + 3]); w1.z = pk2(s1[8 * s + 4], s1[8 * s + 5]); w1.w = pk2(s1[8 * s + 6], s1[8 * s + 7]);
                pf[s] = __builtin_bit_cast(bf16x8, w0); pf[2 + s] = __builtin_bit_cast(bf16x8, w1);
            }
            __builtin_amdgcn_sched_barrier(0);
#pragma unroll
            for (int db = 0; db < 4; ++db) {
                if (db < 3) {
#pragma unroll
                    for (int ks = 0; ks < 4; ++ks) { LAS const unsigned char* a = vbase + (16 * ks) * AT_VP + (db + 1) * 64; vf[(db + 1) & 1][ks] = cat8(tr_read(a), tr_read(a + 8 * AT_VP)); }
                }
#pragma unroll
                for (int ks = 0; ks < 4; ++ks) o[db] = MFMA32(vf[db & 1][ks], pf[ks], o[db]);
                __builtin_amdgcn_sched_barrier(0);
            }
            if (tt + 1 < ntl) {
#pragma unroll
                for (int i = 0; i < 4; ++i) *(LAS u32x4*)(lds + (stage ^ 1) * AT_STAGE + ldst[i]) = stg[i];
            }
            BLK_SYNC();
        }
        l += __shfl_xor(l, 32);
        const float inv = 1.0f / l;
#pragma unroll
        for (int db = 0; db < 4; ++db)
#pragma unroll
            for (int r = 0; r < 16; ++r) o[db][r] *= inv;
        LAS unsigned char* xq = lds + (qs * 32 + r32) * AT_XP;
        if (map == 1) {
#pragma unroll
            for (int db = 0; db < 4; ++db)
#pragma unroll
                for (int rg = 0; rg < 4; ++rg) { const int d = 32 * db + 8 * rg + 4 * hi;
                    *(LAS f32x4*)(xq + d * 4) = (f32x4){o[db][4 * rg], o[db][4 * rg + 1], o[db][4 * rg + 2], o[db][4 * rg + 3]}; }
        }
        BLK_SYNC();
        if (map == 0) {
            float ss = 0.f;
#pragma unroll
            for (int db = 0; db < 4; ++db)
#pragma unroll
                for (int rg = 0; rg < 4; ++rg) { const int d = 32 * db + 8 * rg + 4 * hi; const f32x4 o2 = *(LAS const f32x4*)(xq + d * 4);
#pragma unroll
                    for (int e = 0; e < 4; ++e) { const float v = o[db][4 * rg + e] - lam * o2[e]; o[db][4 * rg + e] = v; ss += v * v; } }
            ss += __shfl_xor(ss, 32);
            const float rn = rsqrtf(ss * (1.0f / 128.0f) + SUBLN_EPS) * 0.8f;
            const bf16_t* zp = Zb + (size_t)qrow * DM + h * 128; bf16_t* op = Ob + (size_t)qrow * DM + h * 128;
#pragma unroll
            for (int db = 0; db < 4; ++db)
#pragma unroll
                for (int rg = 0; rg < 4; ++rg) { const int d = 32 * db + 8 * rg + 4 * hi;
                    const f32x4 gg = *(const f32x4*)(p.subln + d); const u32x2 zz = *(const u32x2*)(zp + d);
                    const float v0 = o[db][4 * rg] * rn * gg[0] * silu_f(bf_lo(zz.x)), v1 = o[db][4 * rg + 1] * rn * gg[1] * silu_f(bf_hi(zz.x));
                    const float v2 = o[db][4 * rg + 2] * rn * gg[2] * silu_f(bf_lo(zz.y)), v3 = o[db][4 * rg + 3] * rn * gg[3] * silu_f(bf_hi(zz.y));
                    u32x2 w; w.x = pk2(v0, v1); w.y = pk2(v2, v3); *(u32x2*)(op + d) = w; }
        }
        BLK_SYNC();
    }
}

constexpr int FT_P = 320;
template <int MODE> __device__ __forceinline__ void fft_rows(int unit, int& rbase, int& cc, int& a0, int& a1, int& a2) {
    cc = unit & 7;
    if (MODE == 0) { a0 = unit >> 3; rbase = 0; a1 = 0; a2 = 0; }
    else if (MODE == 1) { a0 = unit >> 7; a1 = (unit >> 3) & 15; rbase = SEQP + a0 * SEQS; a2 = 0; }
    else { if (unit < 1024) { rbase = 0; a0 = unit >> 3; a1 = 128; } else { const int v = unit - 1024; rbase = SEQP + (v >> 7) * SEQS; a0 = (v >> 3) & 15; a1 = 16; } a2 = 0; }
}
template <int MODE> __device__ __forceinline__ const bf16_t* fft_src(const bf16_t* AB, int rbase, int cc, int a0, int a1, int rho, int ch16) {
    int grow, part;
    if (MODE == 0) { part = rho >> 7; grow = (rho & 127) * 128 + a0; }
    else if (MODE == 1) { part = (rho >> 4) & 1; grow = rbase + (rho & 15) * 128 + a1 * 8 + (rho >> 5); }
    else { part = rho >> 7; grow = rbase + a0 * 128 + (rho & 127); }
    return AB + (size_t)grow * 2048 + part * 1024 + cc * 128 + ch16 * 8;
}

template <int MODE> __device__ __forceinline__ void fft_pass(LAS unsigned char* lds, bf16_t* AB, const bf16_t* Z1, bf16_t* FG, int nunits) {
    const int tid = threadIdx.x, lane = tid & 63, wave = __builtin_amdgcn_readfirstlane(tid >> 6), r32 = lane & 31, hi = lane >> 5;
    const int g16 = lane >> 4, i16 = lane & 15, tq = i16 >> 2, tp = i16 & 3;
    const int kb = wave & 3, cbh = wave >> 2;
    bf16x8 Cf[8], Sf[8];
    if (MODE != 1) {
        const int k = 32 * kb + r32;
#pragma unroll
        for (int s = 0; s < 8; ++s) { Cf[s] = *(const bf16x8*)(g_tab128 + k * 128 + 16 * s + 8 * hi); Sf[s] = *(const bf16x8*)(g_tab128 + (128 + k) * 128 + 16 * s + 8 * hi); }
    } else {
#pragma unroll
        for (int s = 0; s < 2; ++s) Cf[s] = *(const bf16x8*)(g_tab16 + r32 * 32 + 16 * s + 8 * hi);
    }
    int unit = blockIdx.x;
    if (unit >= nunits) return;
    int rbase, cc, a0, a1, a2;
    fft_rows<MODE>(unit, rbase, cc, a0, a1, a2);
    u32x4 stg[8];
#pragma unroll
    for (int i = 0; i < 8; ++i) { const int c = tid + 512 * i; stg[i] = *(const u32x4*)fft_src<MODE>(AB, rbase, cc, a0, a1, c >> 4, c & 15); }
    __builtin_amdgcn_s_waitcnt(0x0F70);
    for (;;) {
#pragma unroll
        for (int i = 0; i < 8; ++i) { const int c = tid + 512 * i; *(LAS u32x4*)(lds + (c >> 4) * FT_P + (c & 15) * 16) = stg[i]; }
        BLK_SYNC();
        const int nunit = unit + gridDim.x; const bool has_next = nunit < nunits;
        int nrbase = 0, ncc = 0, na0 = 0, na1 = 0, na2 = 0;
        if (has_next) { fft_rows<MODE>(nunit, nrbase, ncc, na0, na1, na2);
#pragma unroll
            for (int i = 0; i < 8; ++i) { const int c = tid + 512 * i; stg[i] = *(const u32x4*)fft_src<MODE>(AB, nrbase, ncc, na0, na1, c >> 4, c & 15); } }
        if (MODE == 0) {
            const int k1 = 32 * kb + r32, n2 = a0;
            const float ph = (float)((k1 * n2) & 16383) * (1.0f / 16384.0f); const float tc = __builtin_amdgcn_cosf(ph), ts = __builtin_amdgcn_sinf(ph);
#pragma unroll 1
            for (int cbi = 0; cbi < 2; ++cbi) { const int cb = 2 * cbh + cbi;
                LAS const unsigned char* ab = lds + (8 * hi + tq) * FT_P + (32 * cb + 16 * (g16 & 1) + 4 * tp) * 2;
                f32x16 yr, yi;
#pragma unroll
                for (int r = 0; r < 16; ++r) { yr[r] = 0.f; yi[r] = 0.f; }
#pragma unroll
                for (int s = 0; s < 8; ++s) {
                    const bf16x8 af = cat8(tr_read(ab + (16 * s) * FT_P), tr_read(ab + (16 * s + 4) * FT_P));
                    const bf16x8 bf = cat8(tr_read(ab + (128 + 16 * s) * FT_P), tr_read(ab + (128 + 16 * s + 4) * FT_P));
                    const bf16x8 naf = neg8(af), nbf = neg8(bf);
                    yr = MFMA32(af, Cf[s], yr); yr = MFMA32(nbf, Sf[s], yr);
                    yi = MFMA32(naf, Sf[s], yi); yi = MFMA32(nbf, Cf[s], yi);
                }
                bf16_t* orow = AB + (size_t)(k1 * 128 + n2) * 2048 + cc * 128 + cb * 32 + 4 * hi;
#pragma unroll
                for (int rg = 0; rg < 4; ++rg) { float a[4], b[4];
#pragma unroll
                    for (int e = 0; e < 4; ++e) { const float vr = yr[4 * rg + e], vi = yi[4 * rg + e]; a[e] = vr * tc + vi * ts; b[e] = vi * tc - vr * ts; }
                    u32x2 w0, w1; w0.x = pk2(a[0], a[1]); w0.y = pk2(a[2], a[3]); w1.x = pk2(b[0], b[1]); w1.y = pk2(b[2], b[3]);
                    *(u32x2*)(orow + 8 * rg) = w0; *(u32x2*)(orow + 1024 + 8 * rg) = w1; }
            }
        } else if (MODE == 1) {
            const int k1 = r32 & 15, po = r32 >> 4, n2 = a1 * 8 + wave;
            const float ph = (float)((k1 * n2) & 2047) * (1.0f / 2048.0f); const float tc = __builtin_amdgcn_cosf(ph); float ts = __builtin_amdgcn_sinf(ph); if (po) ts = -ts;
#pragma unroll 1
            for (int cb = 0; cb < 4; ++cb) {
                LAS const unsigned char* ab = lds + (wave * 32 + 8 * hi + tq) * FT_P + (32 * cb + 16 * (g16 & 1) + 4 * tp) * 2;
                f32x16 y;
#pragma unroll
                for (int r = 0; r < 16; ++r) y[r] = 0.f;
                const bf16x8 f0 = cat8(tr_read(ab), tr_read(ab + 4 * FT_P)), f1 = cat8(tr_read(ab + 16 * FT_P), tr_read(ab + 20 * FT_P));
                y = MFMA32(f0, Cf[0], y); y = MFMA32(f1, Cf[1], y);
                bf16_t* orow = AB + (size_t)(rbase + k1 * 128 + n2) * 2048 + po * 1024 + cc * 128 + cb * 32 + 4 * hi;
#pragma unroll
                for (int rg = 0; rg < 4; ++rg) { float a[4];
#pragma unroll
                    for (int e = 0; e < 4; ++e) { const float own = y[4 * rg + e], oth = __shfl_xor(own, 16); a[e] = own * tc + oth * ts; }
                    u32x2 w0; w0.x = pk2(a[0], a[1]); w0.y = pk2(a[2], a[3]); *(u32x2*)(orow + 8 * rg) = w0; }
            }
        } else {
            const int k2 = 32 * kb + r32, k1 = a0, N1 = a1; const float nrm = (N1 == 128) ? 6.905339660024879e-4f : 1.953125e-3f;
            const size_t orow_i = (size_t)(rbase + k1 + N1 * k2);
#pragma unroll 1
            for (int cbi = 0; cbi < 2; ++cbi) { const int cb = 2 * cbh + cbi;
                LAS const unsigned char* ab = lds + (8 * hi + tq) * FT_P + (32 * cb + 16 * (g16 & 1) + 4 * tp) * 2;
                f32x16 y;
#pragma unroll
                for (int r = 0; r < 16; ++r) y[r] = 0.f;
#pragma unroll
                for (int s = 0; s < 8; ++s) {
                    const bf16x8 af = cat8(tr_read(ab + (16 * s) * FT_P), tr_read(ab + (16 * s + 4) * FT_P));
                    const bf16x8 bf = cat8(tr_read(ab + (128 + 16 * s) * FT_P), tr_read(ab + (128 + 16 * s + 4) * FT_P));
                    y = MFMA32(af, Cf[s], y); y = MFMA32(bf, Sf[s], y);
                }
                const bf16_t* zrow = Z1 + orow_i * DM + cc * 128 + cb * 32 + 4 * hi; bf16_t* orow = FG + orow_i * DM + cc * 128 + cb * 32 + 4 * hi;
#pragma unroll
                for (int rg = 0; rg < 4; ++rg) { const u32x2 zz = *(const u32x2*)(zrow + 8 * rg);
                    const float v0 = y[4 * rg] * nrm * silu_f(bf_lo(zz.x)), v1 = y[4 * rg + 1] * nrm * silu_f(bf_hi(zz.x));
                    const float v2 = y[4 * rg + 2] * nrm * silu_f(bf_lo(zz.y)), v3 = y[4 * rg + 3] * nrm * silu_f(bf_hi(zz.y));
                    u32x2 w; w.x = pk2(v0, v1); w.y = pk2(v2, v3); *(u32x2*)(orow + 8 * rg) = w; }
            }
        }
        BLK_SYNC();
        if (!has_next) break;
        unit = nunit; rbase = nrbase; cc = ncc; a0 = na0; a1 = na1; a2 = na2;
    }
}

#ifndef PROBE
#define PROBE 0
#endif
#ifndef PHM
#define PHM 0xffff
#endif
__global__ void __launch_bounds__(NTHR, 2) fwd_kernel(Params p) {
    extern __shared__ __attribute__((aligned(16))) unsigned char lds_raw[];
    LAS unsigned char* lds = (LAS unsigned char*)lds_raw;
    cg::grid_group grid = cg::this_grid();
    if (threadIdx.x < 4) ((LAS unsigned*)(lds + XB_LDS_OFF))[threadIdx.x] = 0u;
    __syncthreads();
    const size_t REG = (size_t)MTOT * DM;
    bf16_t* R0 = (bf16_t*)p.ws; bf16_t* R1 = R0 + REG; bf16_t* R2 = R1 + REG; bf16_t* R3 = R2 + REG;
    bf16_t* XB = (bf16_t*)p.out;

    if (PHM & 1) phase0(p, lds, XB);
#if PROBE & 4
    phase0(p, lds, XB);
#endif

    grid.sync();
    const XcdBarrier xbar = xcd_barrier_post(g_bar, (volatile LAS unsigned*)(lds + XB_LDS_OFF));
#if PROBE & 16
    xcd_barrier(xbar); xcd_barrier(xbar); xcd_barrier(xbar); xcd_barrier(xbar); xcd_barrier(xbar); xcd_barrier(xbar); xcd_barrier(xbar); xcd_barrier(xbar);
#endif
    if (PHM & 2) {
        pg8::Gemm gm{XB, g_w0t, MTOT, 4096, 1024, 1024, 1024}; pg8::StaticOrder S; S.init(MTOT, 4096, gridDim.x, blockIdx.x);
        EpiRowBf16 E{R0, R1, R2, R3, DM, DM, 1024, g_r0, 0, QSCALE, g_nrm};
        pg8::gemm_phase<EpiRowBf16, pg8::StaticOrder, true, true>(lds, gm, S, E);
#if PROBE & 1
        pg8::gemm_phase<EpiRowBf16, pg8::StaticOrder, true, true>(lds, gm, S, E);
#endif
    }
    xcd_barrier(xbar);
    if ((PHM & 512) && blockIdx.x < 32) {
        const int fu = blockIdx.x, g = fu >> 2; pg8::Gemm gm{g_tab128, g_ws1 + g * 128, 256, 1024, 128, 128, 1024}; OneUnit S{fu & 3}; EpiFold E{g_w1t, g};
        pg8::gemm_phase<EpiFold, OneUnit, false, true>(lds, gm, S, E);
    }
#if PROBE & 2
    attn_phase(p, lds, R0, R1, R2, R3, (bf16_t*)p.out + REG, &g_ctr[1]);
#endif
    if (PHM & 4) attn_phase(p, lds, R0, R1, R2, R3, R0, &g_ctr[0]);
    xcd_barrier(xbar);
    if (PHM & 8) {
        pg8::Gemm gm{R0, g_wo0t, MTOT, 1024, 1024, 1024, 1024}; pg8::StaticOrder S; S.init(MTOT, 1024, gridDim.x, blockIdx.x);
        EpiResid E{p.xp, p.xs, p.out, R3, g_ss1};
        pg8::gemm_phase<EpiResid, pg8::StaticOrder, true, true>(lds, gm, S, E);
#if PROBE & 1
        { EpiResid E2{p.xp, p.xs, p.out, R3, g_r0}; pg8::gemm_phase<EpiResid, pg8::StaticOrder, true, true>(lds, gm, S, E2); }
#endif
    }
    xcd_barrier(xbar);
    if (PHM & 16) {
        pg8::Gemm gm{R3, g_w1t, MTOT, 3072, 1024, 1024, 1024}; pg8::StaticOrder S; S.init(MTOT, 3072, gridDim.x, blockIdx.x);
        EpiRowBf16 E{R1, R0, R0, R0, 2048, DM, 2048, g_ss1, 1, 1.0f, nullptr};
        pg8::gemm_phase<EpiRowBf16, pg8::StaticOrder, true, true>(lds, gm, S, E);
#if PROBE & 1
        pg8::gemm_phase<EpiRowBf16, pg8::StaticOrder, true, true>(lds, gm, S, E);
#endif
    }
    xcd_barrier(xbar);
    if (PHM & 32) fft_pass<0>(lds, R1, nullptr, nullptr, 1024);
    if (PHM & 64) fft_pass<1>(lds, R1, nullptr, nullptr, 1024);
    xcd_barrier(xbar);
    if (PHM & 128) fft_pass<2>(lds, R1, R0, R3, 2048);
#if PROBE & 8
    fft_pass<2>(lds, R1, R0, R3, 2048);
#endif
    xcd_barrier(xbar);
    if (PHM & 256) {
        pg8::Gemm gm{R3, g_wo1t, MTOT, 1024, 1024, 1024, 1024}; pg8::StaticOrder S; S.init(MTOT, 1024, gridDim.x, blockIdx.x);
        EpiResid E{p.out, p.out + (size_t)SEQP * DM, p.out, nullptr, g_ss2};
        pg8::gemm_phase<EpiResid, pg8::StaticOrder, true, true>(lds, gm, S, E);
    }
    xcd_barrier(xbar);
    const int lane = threadIdx.x & 63, wave = threadIdx.x >> 6;
    for (int row = blockIdx.x * 8 + wave; row < MTOT; row += gridDim.x * 8) {
        const float rs = rsqrtf(g_ss2[row] * (1.0f / 1024.0f) + EPS); float* orow = p.out + (size_t)row * DM;
#pragma unroll
        for (int i = 0; i < 4; ++i) { const int c = 4 * (lane + 64 * i); f32x4 v = *(const f32x4*)(orow + c); const f32x4 gg = *(const f32x4*)(p.final_norm + c);
            v[0] *= rs * gg[0]; v[1] *= rs * gg[1]; v[2] *= rs * gg[2]; v[3] *= rs * gg[3]; *(f32x4*)(orow + c) = v; }
    }
}

extern "C" void kernel_launch(void* const* d_in, const int* in_sizes, int n_in, void* d_out, int out_size, void* d_ws, size_t ws_size, hipStream_t stream) {
    static int grid = 0;
    if (grid == 0) {
        int dev = 0, cus = 0, per_cu = 0;
        if (n_in != 14 || ws_size < (size_t)4 * MTOT * DM * 2) { fprintf(stderr, "kernel_launch: unexpected problem shape (n_in %d, ws %zu)\n", n_in, ws_size); grid = -1; return; }
        hipGetDevice(&dev); hipDeviceGetAttribute(&cus, hipDeviceAttributeMultiprocessorCount, dev);
        if (hipFuncSetAttribute((const void*)fwd_kernel, hipFuncAttributeMaxDynamicSharedMemorySize, LDS_TOTAL) != hipSuccess) { fprintf(stderr, "kernel_launch: hipFuncSetAttribute failed\n"); grid = -1; return; }
        if (hipOccupancyMaxActiveBlocksPerMultiprocessor(&per_cu, (const void*)fwd_kernel, NTHR, LDS_TOTAL) != hipSuccess || per_cu < 1) { fprintf(stderr, "kernel_launch: occupancy query says %d blocks per CU\n", per_cu); per_cu = 1; }
        (void)hipGetLastError();
        grid = cus * 1;
    }
    if (grid < 0) return;
    Params p{};
    p.xp = (const float*)d_in[0]; p.xs = (const float*)d_in[1]; p.attn_norm = (const float*)d_in[2]; p.w_in0 = (const float*)d_in[3];
    p.lq1 = (const float*)d_in[4]; p.lk1 = (const float*)d_in[5]; p.lq2 = (const float*)d_in[6]; p.lk2 = (const float*)d_in[7];
    p.subln = (const float*)d_in[8]; p.w_out0 = (const float*)d_in[9]; p.fnet_norm = (const float*)d_in[10]; p.w_in1 = (const float*)d_in[11];
    p.w_out1 = (const float*)d_in[12]; p.final_norm = (const float*)d_in[13];
    p.out = (float*)d_out; p.ws = (unsigned char*)d_ws;
    void* args[] = {&p};
    const hipError_t e = hipLaunchCooperativeKernel((const void*)fwd_kernel, dim3(grid), dim3(NTHR), args, LDS_TOTAL, stream);
    if (e != hipSuccess) fprintf(stderr, "kernel_launch: cooperative launch failed: %s (grid %d)\n", hipGetErrorString(e), grid);
}
```

```cpp
#include <hip/hip_runtime.h>
#include <hip/hip_cooperative_groups.h>
#include <cstdio>
#include <cstdint>
namespace cg = cooperative_groups;
namespace pg8 {
#define PG8_LAS __attribute__((address_space(3)))
typedef unsigned short bf16_t;
typedef short bf16x8 __attribute__((ext_vector_type(8)));
typedef float f32x4 __attribute__((ext_vector_type(4)));
typedef unsigned u32x4 __attribute__((ext_vector_type(4)));
constexpr int BM = 256, BK = 64, HALF = 128, HTB = HALF * BK * 2  , STAGE_BYTES = 8 * HTB, NXCD = 8, WGM = 8;

__host__ __device__ __forceinline__ int lds_byte(int r, int c) { const int st = (r >> 4) * 2 + (c >> 5), rr = r & 15, cc = c & 31, ob = rr * 64 + cc * 2; return st * 1024 + (ob ^ (((ob >> 9) & 1) << 5)); }
__host__ __device__ __forceinline__ void stage_rc(int b, int& R, int& C) { const int st = b / 1024, sb = b % 1024, swz = sb ^ (((sb >> 9) & 1) << 5); R = (st >> 1) * 16 + swz / 64; C = (st & 1) * 32 + (swz % 64) / 2; }
__host__ __device__ __forceinline__ int perm32(int rho) { const int n = rho >> 4, i = rho & 15; return 8 * (i >> 2) + 4 * n + (i & 3); }

struct Unit { int pm, pn; };
struct Gemm { const bf16_t* A; const bf16_t* Bt; int M, N, K, lda, ldb; };

struct StaticOrder {
    int nM, nN, nwg, G, c;
    __host__ __device__ void init(int M, int N, int G_, int c_) { nM = M / BM; nN = N / BM; nwg = nM * nN; G = G_; c = c_; }
    __host__ __device__ bool next(int i, Unit& u) const {
        const long L = (long)i * G + c; if (L >= nwg) return false;
        int wgid = (int)L; { const int q = nwg / NXCD, r = nwg % NXCD, xcd = wgid % NXCD, off = wgid / NXCD; wgid = (xcd < r ? xcd * (q + 1) : r * (q + 1) + (xcd - r) * q) + off; }
        const int nig = WGM * nN, gid = wgid / nig, fm = gid * WGM, gsz = (nM - fm) < WGM ? (nM - fm) : WGM;
        u.pm = fm + ((wgid % nig) % gsz); u.pn = (wgid % nig) / gsz; return true;
    }
    __device__ __forceinline__ void a_ready(const Unit&) const {}
    __device__ __forceinline__ void done(const Unit&) const {}
};
template <class Epi, class Sched, bool ALIGN_EPI = false, bool SP2 = false>
__device__ __forceinline__ void gemm_phase(PG8_LAS unsigned char* lds, const Gemm g, const Sched& S, const Epi& E) {
    const int tid = threadIdx.x, wid = __builtin_amdgcn_readfirstlane(tid >> 6), lane = tid & 63, wr = wid >> 2, wc = wid & 3, fr = lane & 15, fq = lane >> 4;
    const int K = g.K, nt = K / BK;
    unsigned voffA[2], voffB[2];
#pragma unroll
    for (int i = 0; i < 2; ++i) { int R, C; stage_rc(tid * 16 + i * 8192, R, C); const int Rb = Epi::PERM ? ((R & ~31) + perm32(R & 31)) : R;
        voffA[i] = (unsigned)(R * g.lda + C) * 2u; voffB[i] = (unsigned)(Rb * g.ldb + C) * 2u; }
    const size_t kstep = (size_t)(BK * 2);
    const size_t hstepA = (size_t)HALF * g.lda * 2, hstepB = (size_t)HALF * g.ldb * 2;
    const size_t tstepA = 2 * hstepA, tstepB = 2 * hstepB;
    const unsigned ldsw = (unsigned)wid * 1024u;
    const int aoff = lds_byte(wr * 64 + fr, fq * 8), boff = lds_byte(wc * 32 + fr, fq * 8);
#define PG8_SA(b, h) (((b) * 2 + (h)) * HTB)
#define PG8_SB(b, h) ((4 + (b) * 2 + (h)) * HTB)
#define PG8_STAGE(bufoff, gbase, voff) do { _Pragma("unroll") for (int _i = 0; _i < 2; ++_i) \
        __builtin_amdgcn_global_load_lds((const unsigned*)((const char*)(gbase) + (voff)[_i]), (PG8_LAS unsigned*)(lds + (bufoff) + ldsw + _i * 8192), 16, 0, 0); } while (0)
#define PG8_LDA(dst, b, h) do { _Pragma("unroll") for (int m = 0; m < 4; ++m) _Pragma("unroll") for (int k = 0; k < 2; ++k) dst[m][k] = *(const PG8_LAS bf16x8*)(lds + PG8_SA(b, h) + aoff + m * 2048 + k * 1024); } while (0)
#define PG8_LDB(dst, b, h) do { _Pragma("unroll") for (int n = 0; n < 2; ++n) _Pragma("unroll") for (int k = 0; k < 2; ++k) dst[n][k] = *(const PG8_LAS bf16x8*)(lds + PG8_SB(b, h) + boff + n * 2048 + k * 1024); } while (0)
#define PG8_MMA(ai, bj, At, Bt) do { __builtin_amdgcn_s_setprio(1); _Pragma("unroll") for (int m = 0; m < 4; ++m) _Pragma("unroll") for (int n = 0; n < 2; ++n) _Pragma("unroll") for (int k = 0; k < 2; ++k) \
        acc[ai][bj][m][n] = __builtin_amdgcn_mfma_f32_16x16x32_bf16(Bt[n][k], At[m][k], acc[ai][bj][m][n], 0, 0, 0); __builtin_amdgcn_s_setprio(0); } while (0)
#define PG8_WAIT_V(n) asm volatile("s_waitcnt vmcnt(" #n ")" ::: "memory")
#define PG8_WAIT_L(n) asm volatile("s_waitcnt lgkmcnt(" #n ")" ::: "memory")
#define PG8_BAR __builtin_amdgcn_s_barrier()
#define PG8_SCHED __builtin_amdgcn_sched_barrier(0)
    Unit cur, nxt; int ui = 0;
    if (!S.next(0, cur)) return;
    f32x4 acc[2][2][4][2];
#pragma unroll
    for (int a = 0; a < 2; ++a)
#pragma unroll
        for (int b = 0; b < 2; ++b)
#pragma unroll
            for (int m = 0; m < 4; ++m)
#pragma unroll
                for (int n = 0; n < 2; ++n) acc[a][b][m][n] = (f32x4){0.f, 0.f, 0.f, 0.f};
    bf16x8 At[4][2], B0[2][2], B1[2][2];
    const char* cA = (const char*)g.A + (size_t)cur.pm * tstepA; const char* cB = (const char*)g.Bt + (size_t)cur.pn * tstepB;
    S.a_ready(cur);
    if constexpr (SP2) {
        PG8_STAGE(PG8_SB(0, 0), cB, voffB); PG8_STAGE(PG8_SB(0, 1), cB + hstepB, voffB); PG8_STAGE(PG8_SA(0, 0), cA, voffA); PG8_STAGE(PG8_SA(0, 1), cA + hstepA, voffA);
        if (wr == 1) PG8_BAR;
        PG8_WAIT_V(2); PG8_BAR;
        PG8_STAGE(PG8_SB(1, 0), cB + kstep, voffB); PG8_STAGE(PG8_SA(1, 0), cA + kstep, voffA); PG8_STAGE(PG8_SB(1, 1), cB + hstepB + kstep, voffB);
        PG8_WAIT_V(6); PG8_BAR;
    } else {
        PG8_STAGE(PG8_SB(0, 0), cB, voffB); PG8_STAGE(PG8_SA(0, 0), cA, voffA); PG8_STAGE(PG8_SB(0, 1), cB + hstepB, voffB); PG8_STAGE(PG8_SA(0, 1), cA + hstepA, voffA);
        if (wr == 1) PG8_BAR;
        PG8_WAIT_V(4); PG8_BAR;
        PG8_STAGE(PG8_SB(1, 0), cB + kstep, voffB); PG8_STAGE(PG8_SA(1, 0), cA + kstep, voffA); PG8_STAGE(PG8_SB(1, 1), cB + hstepB + kstep, voffB);
        PG8_WAIT_V(6); PG8_BAR;
    }
    for (;;) {
        const bool has_next = S.next(ui + 1, nxt);
        const char* nA = has_next ? (const char*)g.A + (size_t)nxt.pm * tstepA : cA; const char* nB = has_next ? (const char*)g.Bt + (size_t)nxt.pn * tstepB : cB;
        for (int t = 0; t < nt; t += 2) {
            const bool last = (t == nt - 2);
            const char* a1 = cA + (size_t)(t + 1) * kstep;
            const char* a2 = last ? nA : cA + (size_t)(t + 2) * kstep; const char* b2 = last ? nB : cB + (size_t)(t + 2) * kstep;
            const char* a3 = a2 + kstep; const char* b3 = b2 + kstep;
            if (last && has_next) S.a_ready(nxt);
            if constexpr (SP2) {
            PG8_LDB(B0, 0, 0); PG8_LDB(B1, 0, 1); PG8_SCHED; PG8_LDA(At, 0, 0); PG8_STAGE(PG8_SA(1, 1), a1 + hstepA, voffA);
            PG8_WAIT_V(8); PG8_WAIT_L(0); PG8_BAR; PG8_MMA(0, 0, At, B0); PG8_MMA(0, 1, At, B1); PG8_BAR; PG8_SCHED;
            PG8_LDA(At, 0, 1); PG8_STAGE(PG8_SB(0, 0), b2, voffB); PG8_STAGE(PG8_SB(0, 1), b2 + hstepB, voffB); PG8_STAGE(PG8_SA(0, 0), a2, voffA);
            PG8_WAIT_V(8); PG8_WAIT_L(0); PG8_BAR; PG8_MMA(1, 0, At, B0); PG8_MMA(1, 1, At, B1); PG8_BAR; PG8_SCHED;
            PG8_LDB(B0, 1, 0); PG8_LDB(B1, 1, 1); PG8_SCHED; PG8_LDA(At, 1, 0); PG8_STAGE(PG8_SA(0, 1), a2 + hstepA, voffA);
            PG8_WAIT_V(8); PG8_WAIT_L(0); PG8_BAR; PG8_MMA(0, 0, At, B0); PG8_MMA(0, 1, At, B1); PG8_BAR; PG8_SCHED;
            PG8_LDA(At, 1, 1); PG8_STAGE(PG8_SB(1, 0), b3, voffB); PG8_STAGE(PG8_SB(1, 1), b3 + hstepB, voffB); PG8_STAGE(PG8_SA(1, 0), a3, voffA);
            PG8_WAIT_V(8); PG8_WAIT_L(0); PG8_BAR; PG8_MMA(1, 0, At, B0); PG8_MMA(1, 1, At, B1); PG8_BAR; PG8_SCHED;
            } else {
            PG8_LDB(B0, 0, 0); PG8_SCHED; PG8_LDA(At, 0, 0); PG8_STAGE(PG8_SA(1, 1), a1 + hstepA, voffA);
            PG8_WAIT_L(8); PG8_BAR; PG8_WAIT_L(0); PG8_MMA(0, 0, At, B0); PG8_BAR; PG8_SCHED;
            PG8_LDB(B1, 0, 1); PG8_STAGE(PG8_SB(0, 0), b2, voffB);
            PG8_BAR; PG8_WAIT_L(0); PG8_MMA(0, 1, At, B1); PG8_BAR;
            PG8_LDA(At, 0, 1); PG8_STAGE(PG8_SA(0, 0), a2, voffA);
            PG8_BAR; PG8_WAIT_L(0); PG8_MMA(1, 0, At, B0); PG8_BAR; PG8_SCHED;
            PG8_STAGE(PG8_SB(0, 1), b2 + hstepB, voffB);
            PG8_WAIT_V(6); PG8_BAR; PG8_MMA(1, 1, At, B1); PG8_BAR;
            PG8_LDB(B0, 1, 0); PG8_SCHED; PG8_LDA(At, 1, 0); PG8_STAGE(PG8_SA(0, 1), a2 + hstepA, voffA);
            PG8_WAIT_L(8); PG8_BAR; PG8_WAIT_L(0); PG8_MMA(0, 0, At, B0); PG8_BAR; PG8_SCHED;
            PG8_LDB(B1, 1, 1); PG8_STAGE(PG8_SB(1, 0), b3, voffB);
            PG8_BAR; PG8_WAIT_L(0); PG8_MMA(0, 1, At, B1); PG8_BAR;
            PG8_LDA(At, 1, 1); PG8_STAGE(PG8_SA(1, 0), a3, voffA);
            PG8_BAR; PG8_WAIT_L(0); PG8_MMA(1, 0, At, B0); PG8_BAR; PG8_SCHED;
            PG8_STAGE(PG8_SB(1, 1), b3 + hstepB, voffB);
            PG8_WAIT_V(6); PG8_BAR; PG8_MMA(1, 1, At, B1); PG8_BAR;
            }
        }
        if constexpr (ALIGN_EPI) { if (wr == 0) PG8_BAR; }
        if constexpr (!Epi::AFTER_DRAIN) { E(acc, cur, wr, wc, fr, fq); S.done(cur); }
        if (!has_next) break;
#pragma unroll
        for (int a = 0; a < 2; ++a)
#pragma unroll
            for (int b = 0; b < 2; ++b)
#pragma unroll
                for (int m = 0; m < 4; ++m)
#pragma unroll
                    for (int n = 0; n < 2; ++n) acc[a][b][m][n] = (f32x4){0.f, 0.f, 0.f, 0.f};
        cur = nxt; cA = nA; cB = nB; ++ui;
        if constexpr (ALIGN_EPI) { if (wr == 1) PG8_BAR; }
    }
    PG8_WAIT_V(0);
    if constexpr (!ALIGN_EPI) { if (wr == 0) PG8_BAR; }
    PG8_BAR;
    if constexpr (Epi::AFTER_DRAIN) { E.fused(acc, cur, wr, wc, fr, fq, lds, wid, lane); S.done(cur); }
#undef PG8_SA
#undef PG8_SB
#undef PG8_STAGE
#undef PG8_LDA
#undef PG8_LDB
#undef PG8_MMA
#undef PG8_WAIT_V
#undef PG8_WAIT_L
#undef PG8_BAR
#undef PG8_SCHED
}
}
#ifndef LAS
#define LAS __attribute__((address_space(3)))
#endif

#define XB_TMO      128
#define XB_XCNT(j)  (256  + 64 * (j))
#define XB_XSUB(j)  (1280 + 64 * (j))
#define XB_XGEN(j)  (2304 + 64 * (j))
#define XB_TOP      3328
#define XB_TOPGEN   3392
#define XCD_BAR_WORDS 3456
#define XB_SPIN_CAP (1u << 18)

__device__ __forceinline__ unsigned xb_ld(unsigned* p)              { return __hip_atomic_load(p, __ATOMIC_RELAXED, __HIP_MEMORY_SCOPE_AGENT); }
__device__ __forceinline__ unsigned xb_add(unsigned* p, unsigned v) { return __hip_atomic_fetch_add(p, v, __ATOMIC_RELAXED, __HIP_MEMORY_SCOPE_AGENT); }
__device__ __forceinline__ unsigned xb_xcc_id() { return (unsigned)__builtin_amdgcn_s_getreg((3 << 11) | 20) & 0xFu; }
#define XB_SPIN(cond, bar) do { unsigned _sp = 0; while (cond) { __builtin_amdgcn_s_sleep(1); \
    if ((++_sp & 255u) == 0u) { if (xb_ld(&(bar)[XB_TMO])) break; if (_sp > XB_SPIN_CAP) { atomicAdd(&(bar)[XB_TMO], 1u); break; } } } } while (0)

struct XcdBarrier {
    unsigned* bar; unsigned x;
    volatile LAS unsigned* st;
};

__device__ __forceinline__ XcdBarrier xcd_barrier_post(unsigned* bar, volatile LAS unsigned* st) {
    XcdBarrier b; b.bar = bar; b.x = xb_xcc_id(); b.st = st;
    if (threadIdx.x == 0) (void)xb_add(&bar[XB_XCNT(b.x)], 1u);
    return b;
}
__device__ __forceinline__ void xcd_barrier_complete(unsigned* bar, unsigned x, unsigned& nloc, unsigned& nx) {
    const unsigned G = gridDim.x * gridDim.y * gridDim.z;
    unsigned sum, cnt, mine, sp = 0u;
    for (;;) {
        sum = 0u; cnt = 0u; mine = 0u;
#pragma unroll
        for (unsigned j = 0; j < 16; ++j) { const unsigned c = xb_ld(&bar[XB_XCNT(j)]); sum += c; cnt += (c > 0u) ? 1u : 0u; mine = (j == x) ? c : mine; }
        if (sum == G) break;
        __builtin_amdgcn_s_sleep(1);
        if ((++sp & 255u) == 0u) { if (xb_ld(&bar[XB_TMO])) break; if (sp > XB_SPIN_CAP) { atomicAdd(&bar[XB_TMO], 1u); break; } }
    }
    nloc = mine > 0u ? mine : 1u; nx = cnt > 0u ? cnt : 1u;
}

__device__ __forceinline__ void xcd_barrier(const XcdBarrier& b) {
    asm volatile("s_waitcnt vmcnt(0)" ::: "memory");
    __syncthreads();
    if (threadIdx.x == 0) {
        unsigned* bar = b.bar;
        __builtin_amdgcn_s_waitcnt(0);
        unsigned nloc = b.st[0], nx = b.st[1];
        if (nloc == 0u) { xcd_barrier_complete(bar, b.x, nloc, nx); b.st[0] = nloc; b.st[1] = nx; }
        const unsigned old = xb_add(&bar[XB_XSUB(b.x)], 1u);
        const unsigned gen = old / nloc;
        if (old + 1u == (gen + 1u) * nloc) {
            __builtin_amdgcn_fence(__ATOMIC_RELEASE, "agent");
            asm volatile("s_waitcnt vmcnt(0)" ::: "memory");
            const unsigned og = xb_add(&bar[XB_TOP], 1u);
            const unsigned tg = og / nx;
            if (og + 1u == (tg + 1u) * nx) xb_add(&bar[XB_TOPGEN], 1u);
            else XB_SPIN(xb_ld(&bar[XB_TOPGEN]) == tg, bar);
            __builtin_amdgcn_fence(__ATOMIC_ACQUIRE, "agent");
            xb_add(&bar[XB_XGEN(b.x)], 1u);
            asm volatile("s_waitcnt vmcnt(0)" ::: "memory");
        } else {
            XB_SPIN(xb_ld(&bar[XB_XGEN(b.x)]) == gen, bar);
            __builtin_amdgcn_fence(__ATOMIC_ACQUIRE, "agent");
            asm volatile("s_waitcnt vmcnt(0)" ::: "memory");
        }
    }
    __syncthreads();
}


__device__ __attribute__((aligned(256))) unsigned g_bar[XCD_BAR_WORDS];
#ifndef LAS
#define LAS __attribute__((address_space(3)))
#endif
typedef unsigned short bf16_t;
typedef short bf16x8 __attribute__((ext_vector_type(8)));
typedef short s16x4 __attribute__((ext_vector_type(4)));
typedef float f32x4 __attribute__((ext_vector_type(4)));
typedef float f32x16 __attribute__((ext_vector_type(16)));
typedef unsigned u32x4 __attribute__((ext_vector_type(4)));
typedef unsigned u32x2 __attribute__((ext_vector_type(2)));
typedef float f32x2_t __attribute__((ext_vector_type(2)));
typedef __bf16 bf16x2_t __attribute__((ext_vector_type(2)));

constexpr int DM = 1024, MTOT = 32768, SEQP = 16384, SEQS = 2048;
constexpr int NTHR = 512;
constexpr float EPS = 1e-6f, SUBLN_EPS = 1e-5f, LOG2E = 1.4426950408889634f;
constexpr float QSCALE = 0.125f * LOG2E;
constexpr int XB_LDS_OFF = 131072, LDS_TOTAL = 131072 + 256;

__device__ __attribute__((aligned(256))) bf16_t g_w0t[4096 * 1024];
__device__ __attribute__((aligned(256))) bf16_t g_wo0t[1024 * 1024];
__device__ __attribute__((aligned(256))) bf16_t g_ws1[1024 * 1024];
__device__ __attribute__((aligned(256))) bf16_t g_w1t[3072 * 1024];
__device__ __attribute__((aligned(256))) bf16_t g_wo1t[1024 * 1024];
__device__ __attribute__((aligned(256))) bf16_t g_tab128[256 * 128];
__device__ __attribute__((aligned(256))) bf16_t g_tab16[32 * 32];
__device__ __attribute__((aligned(256))) float g_r0[MTOT];
__device__ __attribute__((aligned(256))) float g_ss1[MTOT];
__device__ __attribute__((aligned(256))) float g_ss2[MTOT];
__device__ __attribute__((aligned(256))) unsigned g_nrm[64];
__device__ __attribute__((aligned(256))) unsigned g_ctr[4];

struct Params {
    const float* xp; const float* xs; const float* attn_norm; const float* w_in0; const float* lq1; const float* lk1; const float* lq2; const float* lk2;
    const float* subln; const float* w_out0; const float* fnet_norm; const float* w_in1; const float* w_out1; const float* final_norm;
    float* out; unsigned char* ws;
};

__device__ __forceinline__ unsigned pk2(float lo, float hi) { f32x2_t v = {lo, hi}; bf16x2_t b = __builtin_convertvector(v, bf16x2_t); return __builtin_bit_cast(unsigned, b); }
__device__ __forceinline__ float bf_lo(unsigned u) { return __uint_as_float(u << 16); }
__device__ __forceinline__ float bf_hi(unsigned u) { return __uint_as_float(u & 0xffff0000u); }
__device__ __forceinline__ float wave_sum(float v) { v += __shfl_xor(v, 32); v += __shfl_xor(v, 16); v += __shfl_xor(v, 8); v += __shfl_xor(v, 4); v += __shfl_xor(v, 2); v += __shfl_xor(v, 1); return v; }
__device__ __forceinline__ float silu_f(float z) { return z / (1.0f + __expf(-z)); }
__device__ __forceinline__ int crow(int r, int hi) { return (r & 3) + 8 * (r >> 2) + 4 * hi; }
#define BLK_SYNC() __syncthreads()

struct EpiRowBf16 {
    static constexpr bool PERM = true, AFTER_DRAIN = false;
    bf16_t* b0; bf16_t* b1; bf16_t* b2; bf16_t* b3; int ld0, ld1; int split_cols; const float* rstat; int stat_is_sumsq; float scale0; unsigned* nrm;
    __device__ __forceinline__ void operator()(const pg8::f32x4 (&acc)[2][2][4][2], const pg8::Unit& u, int wr, int wc, int fr, int fq) const {
        const int row0 = u.pm * 256 + wr * 64 + fr; int colt = u.pn * 256; const int t = colt / split_cols; colt -= t * split_cols;
        bf16_t* b = (t == 0) ? b0 : (t == 1) ? b1 : (t == 2) ? b2 : b3; const int ld = (t == 0) ? ld0 : ld1; const float sc = (t == 0) ? scale0 : 1.0f;
        const int col0 = colt + wc * 32 + 8 * fq; const bool donrm = (nrm != nullptr) && (t < 2); float mx[2] = {0.f, 0.f};
#pragma unroll
        for (int ai = 0; ai < 2; ++ai)
#pragma unroll
            for (int m = 0; m < 4; ++m) {
                const int row = row0 + ai * 128 + m * 16; float rs = rstat[row];
                if (stat_is_sumsq) rs = rsqrtf(rs * (1.0f / 1024.0f) + EPS);
                rs *= sc; bf16_t* rowp = b + (size_t)row * ld + col0;
#pragma unroll
                for (int bj = 0; bj < 2; ++bj) { const pg8::f32x4 v0 = acc[ai][bj][m][0] * rs, v1 = acc[ai][bj][m][1] * rs;
                    u32x4 w; w.x = pk2(v0[0], v0[1]); w.y = pk2(v0[2], v0[3]); w.z = pk2(v1[0], v1[1]); w.w = pk2(v1[2], v1[3]);
                    *(u32x4*)(rowp + bj * 128) = w;
                    if (donrm) { float ps = (v0[0] * v0[0] + v0[1] * v0[1]) + (v0[2] * v0[2] + v0[3] * v0[3]) + (v1[0] * v1[0] + v1[1] * v1[1]) + (v1[2] * v1[2] + v1[3] * v1[3]);
                        ps += __shfl_xor(ps, 16); ps += __shfl_xor(ps, 32); mx[bj] = fmaxf(mx[bj], ps); } }
            }
        if (donrm) {
#pragma unroll
            for (int bj = 0; bj < 2; ++bj) { float v = mx[bj]; v = fmaxf(v, __shfl_xor(v, 1)); v = fmaxf(v, __shfl_xor(v, 2)); v = fmaxf(v, __shfl_xor(v, 4)); v = fmaxf(v, __shfl_xor(v, 8));
                if ((threadIdx.x & 63) == 0) atomicMax(nrm + t * 32 + ((colt + bj * 128 + wc * 32) >> 6) * 2 + (wc & 1), __float_as_uint(v)); }
        }
    }
};
struct EpiFold {
    static constexpr bool PERM = true, AFTER_DRAIN = false;
    bf16_t* O; int g;
    __device__ __forceinline__ void operator()(const pg8::f32x4 (&acc)[2][2][4][2], const pg8::Unit& u, int wr, int wc, int fr, int fq) const {
        const int col0 = u.pn * 256 + wc * 32 + 8 * fq;
#pragma unroll
        for (int ai = 0; ai < 2; ++ai)
#pragma unroll
            for (int m = 0; m < 4; ++m) {
                const int j = wr * 64 + m * 16 + fr; bf16_t* rowp = O + (size_t)(ai * 1024 + g * 128 + j) * 1024 + col0;
#pragma unroll
                for (int bj = 0; bj < 2; ++bj) { const pg8::f32x4 v0 = acc[ai][bj][m][0], v1 = acc[ai][bj][m][1];
                    u32x4 w; w.x = pk2(v0[0], v0[1]); w.y = pk2(v0[2], v0[3]); w.z = pk2(v1[0], v1[1]); w.w = pk2(v1[2], v1[3]);
                    *(u32x4*)(rowp + bj * 128) = w; }
            }
    }
};
struct EpiResid {
    static constexpr bool PERM = false, AFTER_DRAIN = false;
    const float* resA; const float* resB; float* out; bf16_t* outb; float* ss;
    __device__ __forceinline__ void operator()(const pg8::f32x4 (&acc)[2][2][4][2], const pg8::Unit& u, int wr, int wc, int fr, int fq) const {
        const int row0 = u.pm * 256 + wr * 64 + fr; const int col0 = u.pn * 256 + wc * 32 + 4 * fq;
#pragma unroll
        for (int ai = 0; ai < 2; ++ai)
#pragma unroll
            for (int m = 0; m < 4; ++m) {
                const int row = row0 + ai * 128 + m * 16;
                const float* rp = (row < SEQP) ? (resA + (size_t)row * DM) : (resB + (size_t)(row - SEQP) * DM);
                float s = 0.f;
#pragma unroll
                for (int bj = 0; bj < 2; ++bj)
#pragma unroll
                    for (int n = 0; n < 2; ++n) { const int col = col0 + bj * 128 + n * 16;
                        const pg8::f32x4 r = *(const pg8::f32x4*)(rp + col); const pg8::f32x4 v = r + acc[ai][bj][m][n];
                        *(pg8::f32x4*)(out + (size_t)row * DM + col) = v;
                        if (outb) { u32x2 w; w.x = pk2(v[0], v[1]); w.y = pk2(v[2], v[3]); *(u32x2*)(outb + (size_t)row * DM + col) = w; }
                        s += (v[0] * v[0] + v[1] * v[1]) + (v[2] * v[2] + v[3] * v[3]); }
                s += __shfl_xor(s, 16); s += __shfl_xor(s, 32);
                if (fq == 0) atomicAdd(ss + row, s);
            }
    }
};
struct OneUnit { int pn; __device__ bool next(int i, pg8::Unit& u) const { if (i > 0) return false; u.pm = 0; u.pn = pn; return true; }
    __device__ __forceinline__ void a_ready(const pg8::Unit&) const {} __device__ __forceinline__ void done(const pg8::Unit&) const {} };

__device__ __forceinline__ void transpose_item(const float* W, int ldw, const float* gain, bf16_t* WT, LAS float* scr, int item, int nblk, int lane) {
    const int kb = item / nblk, nb = item % nblk, k0 = 64 * kb, n0 = 32 * nb;
#pragma unroll 8
    for (int i = 0; i < 32; ++i) { const int kk = 2 * i + (lane >> 5); const float gk = gain ? gain[k0 + kk] : 1.0f; scr[kk * 33 + (lane & 31)] = W[(size_t)(k0 + kk) * ldw + n0 + (lane & 31)] * gk; }
    asm volatile("s_waitcnt lgkmcnt(0)" ::: "memory");
    const int c = lane & 7;
#pragma unroll
    for (int j = 0; j < 4; ++j) { const int n = (lane >> 3) + 8 * j; const LAS float* s = scr + (8 * c) * 33 + n;
        u32x4 o; o.x = pk2(s[0 * 33], s[1 * 33]); o.y = pk2(s[2 * 33], s[3 * 33]); o.z = pk2(s[4 * 33], s[5 * 33]); o.w = pk2(s[6 * 33], s[7 * 33]);
        *(u32x4*)(WT + (size_t)(n0 + n) * 1024 + k0 + 8 * c) = o; }
    asm volatile("s_waitcnt lgkmcnt(0)" ::: "memory");
}

__device__ __forceinline__ void phase0(const Params& p, LAS unsigned char* lds, bf16_t* XB) {
    const int tid = threadIdx.x, lane = tid & 63, wave = tid >> 6;
    const int gw = blockIdx.x * 8 + wave, NGW = gridDim.x * 8;
    for (int row = gw; row < MTOT; row += NGW) {
        const float* xr = (row < SEQP) ? (p.xp + (size_t)row * DM) : (p.xs + (size_t)(row - SEQP) * DM);
        f32x4 v[4]; float ss = 0.f;
#pragma unroll
        for (int i = 0; i < 4; ++i) { v[i] = *(const f32x4*)(xr + 4 * (lane + 64 * i)); ss += (v[i][0] * v[i][0] + v[i][1] * v[i][1]) + (v[i][2] * v[i][2] + v[i][3] * v[i][3]); }
        ss = wave_sum(ss);
        if (lane == 0) g_r0[row] = rsqrtf(ss * (1.0f / 1024.0f) + EPS);
#pragma unroll
        for (int i = 0; i < 4; ++i) { u32x2 w; w.x = pk2(v[i][0], v[i][1]); w.y = pk2(v[i][2], v[i][3]); *(u32x2*)(XB + (size_t)row * DM + 4 * (lane + 64 * i)) = w; }
    }
    for (int i = blockIdx.x * NTHR + tid; i < MTOT; i += gridDim.x * NTHR) { g_ss1[i] = 0.f; g_ss2[i] = 0.f; }
    if (blockIdx.x == 0 && tid < 64) { g_nrm[tid] = 0u; if (tid < 4) g_ctr[tid] = 0u; }
    if (blockIdx.x == 0) for (int i = tid; i < XCD_BAR_WORDS; i += NTHR) g_bar[i] = 0u;
    LAS float* scr = (LAS float*)(lds + wave * 8704);
    constexpr int I0 = 16 * 128, I1 = 16 * 32, NIT = I0 + 3 * I1;
    for (int it = gw; it < NIT; it += NGW) {
        int r = it;
        if (r < I0) { transpose_item(p.w_in0, 4096, p.attn_norm, g_w0t, scr, r, 128, lane); continue; } r -= I0;
        if (r < I1) { transpose_item(p.w_out0, 1024, nullptr, g_wo0t, scr, r, 32, lane); continue; } r -= I1;
        if (r < I1) { transpose_item(p.w_in1 + 1024, 2048, p.fnet_norm, g_w1t + (size_t)2048 * 1024, scr, r, 32, lane); continue; } r -= I1;
        transpose_item(p.w_out1, 1024, nullptr, g_wo1t, scr, r, 32, lane);
    }
    for (int i = blockIdx.x * NTHR + tid; i < 1024 * 256; i += gridDim.x * NTHR) {
        const int k = i >> 8, c4 = (i & 255) * 4; const f32x4 w = *(const f32x4*)(p.w_in1 + (size_t)k * 2048 + c4); const float gk = p.fnet_norm[k];
        u32x2 o; o.x = pk2(w[0] * gk, w[1] * gk); o.y = pk2(w[2] * gk, w[3] * gk); *(u32x2*)(g_ws1 + (size_t)k * 1024 + c4) = o;
    }
    for (int i = blockIdx.x * NTHR + tid; i < 256 * 128; i += gridDim.x * NTHR) {
        const int rr = i >> 7, n = i & 127, k = rr & 127, part = rr >> 7; const float th = (float)((k * n) & 127) * (6.283185307179586f / 128.0f);
        const float v = part ? sinf(th) : cosf(th); g_tab128[i] = (bf16_t)(pk2(v, 0.f) & 0xffffu);
    }
    for (int i = blockIdx.x * NTHR + tid; i < 32 * 32; i += gridDim.x * NTHR) {
        const int kk = i >> 5, j = i & 31, k1 = kk & 15, po = kk >> 4, n1 = j & 15, pi = j >> 4; const float th = (float)((k1 * n1) & 15) * (6.283185307179586f / 16.0f);
        float v; if (po == 0) v = pi ? -sinf(th) : cosf(th); else v = pi ? -cosf(th) : -sinf(th);
        g_tab16[i] = (bf16_t)(pk2(v, 0.f) & 0xffffu);
    }
}

constexpr int AT_KP = 144, AT_VP = 320, AT_K2 = 64 * AT_KP, AT_V = 2 * 64 * AT_KP, AT_STAGE = AT_V + 64 * AT_VP, AT_XP = 528;
typedef short v4i16_t __attribute__((ext_vector_type(4)));
__device__ __forceinline__ s16x4 tr_read(LAS const unsigned char* p) { return __builtin_bit_cast(s16x4, __builtin_amdgcn_ds_read_tr16_b64_v4i16((LAS v4i16_t*)p)); }
__device__ __forceinline__ bf16x8 cat8(s16x4 a, s16x4 b) { return (bf16x8){a[0], a[1], a[2], a[3], b[0], b[1], b[2], b[3]}; }
__device__ __forceinline__ bf16x8 neg8(bf16x8 a) { typedef int i32x4 __attribute__((ext_vector_type(4))); i32x4 v = __builtin_bit_cast(i32x4, a); v = v ^ (int)0x80008000; return __builtin_bit_cast(bf16x8, v); }
#define MFMA32(a, b, c) __builtin_amdgcn_mfma_f32_32x32x16_bf16((a), (b), (c), 0, 0, 0)

__device__ __forceinline__ void attn_phase(const Params& p, LAS unsigned char* lds, const bf16_t* Qb, const bf16_t* Kb, const bf16_t* Vb, const bf16_t* Zb, bf16_t* Ob, unsigned* ctr) {
    const int tid = threadIdx.x, lane = tid & 63, wave = __builtin_amdgcn_readfirstlane(tid >> 6), r32 = lane & 31, hi = lane >> 5;
    const int map = wave >> 2, qs = wave & 3;
    float lam;
    { const float a = wave_sum(p.lq1[lane] * p.lk1[lane]), b = wave_sum(p.lq2[lane] * p.lk2[lane]); lam = expf(a) - expf(b) + 0.2f; }
    const int g16 = lane >> 4, i16 = lane & 15, tq = i16 >> 2, tp = i16 & 3;
    LAS unsigned* qword = (LAS unsigned*)(lds + 2 * AT_STAGE);
    for (;;) {
        if (tid == 0) *qword = atomicAdd(ctr, 1u);
        BLK_SYNC();
        const int unit = (int)*qword;
        if (unit >= 2048) break;
        int R0s, S, h, q0;
        if (unit < 1024) { R0s = 0; S = SEQP; h = 7 - (unit >> 7); q0 = (unit & 127) * 128; }
        else { const int v = unit - 1024; h = 7 - (v >> 7); R0s = SEQP + ((v >> 4) & 7) * SEQS; S = SEQS; q0 = (v & 15) * 128; }
        const float slope2 = exp2f(-(float)(h + 1)) * LOG2E;
        const int qrow = R0s + q0 + qs * 32 + r32;
        bf16x8 qf[4];
        { const bf16_t* qp = Qb + (size_t)qrow * DM + h * 128 + map * 64 + hi * 8; const bf16_t* kp = Kb + (size_t)qrow * DM + h * 128 + map * 64 + hi * 8;
          float qq = 0.f, qk = 0.f;
#pragma unroll
          for (int st = 0; st < 4; ++st) { qf[st] = *(const bf16x8*)(qp + st * 16); const bf16x8 ks = *(const bf16x8*)(kp + st * 16);
#pragma unroll
              for (int e = 0; e < 8; ++e) { const float qv = __uint_as_float(((unsigned)(unsigned short)qf[st][e]) << 16), kv = __uint_as_float(((unsigned)(unsigned short)ks[e]) << 16); qq = __builtin_fmaf(qv, qv, qq); qk = __builtin_fmaf(qv, kv, qk); } }
          qq += __shfl_xor(qq, 32); qk += __shfl_xor(qk, 32);
#pragma unroll
          for (int sh = 1; sh < 32; sh <<= 1) { qq = fmaxf(qq, __shfl_xor(qq, sh)); qk = fminf(qk, __shfl_xor(qk, sh)); }
          LAS float* wst = (LAS float*)(lds + 2 * AT_STAGE + 64);
          if (lane == 0) { wst[wave * 2] = qq; wst[wave * 2 + 1] = qk; }
        }
        BLK_SYNC();
        int t_lo, t_hi;
        { LAS const float* wst = (LAS const float*)(lds + 2 * AT_STAGE + 64);
          float thr = -1.0e30f;
#pragma unroll
          for (int mm = 0; mm < 2; ++mm) { const int e = (2 * h + mm) * 2;
              const float kn2 = __uint_as_float(g_nrm[32 + e]) + __uint_as_float(g_nrm[32 + e + 1]);
              float qmx = 0.f, smn = 1.0e30f;
#pragma unroll
              for (int w = 0; w < 4; ++w) { qmx = fmaxf(qmx, wst[(mm * 4 + w) * 2]); smn = fminf(smn, wst[(mm * 4 + w) * 2 + 1]); }
              thr = fmaxf(thr, sqrtf(qmx * kn2) * 1.02f - smn + 0.05f); }
          thr += 25.0f - log2f(1.0f - exp2f(-slope2));
          const float dminf = fminf(fmaxf(ceilf(thr / slope2), 1.0f), 1.0e6f); const int dmin = (int)dminf;
          const int NTL = S / 64; int lo = q0 - dmin + 1; lo = lo < 0 ? 0 : lo; int hiK = q0 + 127 + dmin - 1; hiK = hiK > S - 1 ? S - 1 : hiK;
          t_lo = lo >> 6; t_hi = hiK >> 6; if (t_hi > NTL - 1) t_hi = NTL - 1; }
        const float nslope2 = -slope2;
        const float qposf = (float)(q0 + qs * 32 + r32 - 4 * hi);
        float l = 0.f;
        f32x16 o[4];
#pragma unroll
        for (int db = 0; db < 4; ++db)
#pragma unroll
            for (int r = 0; r < 16; ++r) o[db][r] = 0.f;
        const bf16_t* gsrc[4]; int ldst[4];
#pragma unroll
        for (int i = 0; i < 4; ++i) { const int c = tid + 512 * i;
            if (i < 2) { const int row = c >> 4, ch = c & 15; gsrc[i] = Kb + (size_t)(R0s + t_lo * 64 + row) * DM + h * 128 + ch * 8; ldst[i] = (ch >> 3) * AT_K2 + row * AT_KP + (ch & 7) * 16; }
            else { const int c2 = c - 1024, row = c2 >> 4, ch = c2 & 15; gsrc[i] = Vb + (size_t)(R0s + t_lo * 64 + row) * DM + h * 128 + ch * 8; ldst[i] = AT_V + row * AT_VP + ch * 16; } }
        u32x4 stg[2][4];
#pragma unroll
        for (int i = 0; i < 4; ++i) stg[0][i] = *(const u32x4*)(gsrc[i]);
        const int ntl = t_hi - t_lo + 1;
        if (ntl > 1) {
#pragma unroll
            for (int i = 0; i < 4; ++i) stg[1][i] = *(const u32x4*)(gsrc[i] + (size_t)64 * DM);
        }
#pragma unroll
        for (int i = 0; i < 4; ++i) *(LAS u32x4*)(lds + ldst[i]) = stg[0][i];
        __builtin_amdgcn_s_waitcnt(0x0F70);
        BLK_SYNC();
        for (int tt2 = 0; tt2 < ntl; tt2 += 2) {
#pragma unroll
          for (int par = 0; par < 2; ++par) {
            const int tt = tt2 + par;
            if (tt < ntl) {
            const int stage = par;
            if (tt + 2 < ntl) {
#pragma unroll
                for (int i = 0; i < 4; ++i) stg[par][i] = *(const u32x4*)(gsrc[i] + (size_t)(tt + 2) * 64 * DM);
            }
            LAS const unsigned char* Kt = lds + stage * AT_STAGE + map * AT_K2 + r32 * AT_KP + hi * 16;
            LAS const unsigned char* vbase = lds + stage * AT_STAGE + AT_V + (4 * hi + tq) * AT_VP + (16 * (g16 & 1) + 4 * tp) * 2;
            bf16x8 kf0[4], kf1[4];
#pragma unroll
            for (int st = 0; st < 4; ++st) { kf0[st] = *(LAS const bf16x8*)(Kt + st * 32); kf1[st] = *(LAS const bf16x8*)(Kt + 32 * AT_KP + st * 32); }
            __builtin_amdgcn_sched_barrier(0);
            f32x16 s0, s1;
#pragma unroll
            for (int r = 0; r < 16; ++r) { s0[r] = 0.f; s1[r] = 0.f; }
#pragma unroll
            for (int st = 0; st < 4; ++st) { s0 = MFMA32(kf0[st], qf[st], s0); s1 = MFMA32(kf1[st], qf[st], s1); }
            bf16x8 vf[2][4];
#pragma unroll
            for (int ks = 0; ks < 4; ++ks) { LAS const unsigned char* a = vbase + (16 * ks) * AT_VP; vf[0][ks] = cat8(tr_read(a), tr_read(a + 8 * AT_VP)); }
            __builtin_amdgcn_sched_barrier(0);
            const float d0 = qposf - (float)((t_lo + tt) * 64);
            float rs = 0.f;
#pragma unroll
            for (int r = 0; r < 16; ++r) { const float c = (float)((r & 3) + 8 * (r >> 2));
                s0[r] = __builtin_amdgcn_exp2f(__builtin_fmaf(nslope2, fabsf(d0 - c), s0[r]));
                s1[r] = __builtin_amdgcn_exp2f(__builtin_fmaf(nslope2, fabsf(d0 - (32.0f + c)), s1[r]));
                rs += s0[r] + s1[r]; }
            l += rs;
            bf16x8 pf[4];
#pragma unroll
            for (int s = 0; s < 2; ++s) {
                u32x4 w0, w1;
                w0.x = pk2(s0[8 * s + 0], s0[8 * s + 1]); w0.y = pk2(s0[8 * s + 2], s0[8 * s + 3]); w0.z = pk2(s0[8 * s + 4], s0[8 * s + 5]); w0.w = pk2(s0[8 * s + 6], s0[8 * s + 7]);
                w1.x = pk2(s1[8 * s + 0], s1[8 * s + 1]); w1.y = pk2(s1[8 * s + 2], s1[8 * s + 3]); w1.z = pk2(s1[8 * s + 4], s1[8 * s + 5]); w1.w = pk2(s1[8 * s + 6], s1[8 * s + 7]);
                pf[s] = __builtin_bit_cast(bf16x8, w0); pf[2 + s] = __builtin_bit_cast(bf16x8, w1);
            }
            __builtin_amdgcn_sched_barrier(0);
#pragma unroll
            for (int db = 0; db < 4; ++db) {
                if (db < 3) {
#pragma unroll
                    for (int ks = 0; ks < 4; ++ks) { LAS const unsigned char* a = vbase + (16 * ks) * AT_VP + (db + 1) * 64; vf[(db + 1) & 1][ks] = cat8(tr_read(a), tr_read(a + 8 * AT_VP)); }
                }
#pragma unroll
                for (int ks = 0; ks < 4; ++ks) o[db] = MFMA32(vf[db & 1][ks], pf[ks], o[db]);
                __builtin_amdgcn_sched_barrier(0);
            }
            if (tt + 1 < ntl) {
#pragma unroll
                for (int i = 0; i < 4; ++i) *(LAS u32x4*)(lds + (stage ^ 1) * AT_STAGE + ldst[i]) = stg[par ^ 1][i];
            }
            BLK_SYNC();
            }
          }
        }
        l += __shfl_xor(l, 32);
        const float inv = 1.0f / l;
#pragma unroll
        for (int db = 0; db < 4; ++db)
#pragma unroll
            for (int r = 0; r < 16; ++r) o[db][r] *= inv;
        LAS unsigned char* xq = lds + (qs * 32 + r32) * AT_XP;
        if (map == 1) {
#pragma unroll
            for (int db = 0; db < 4; ++db)
#pragma unroll
                for (int rg = 0; rg < 4; ++rg) { const int d = 32 * db + 8 * rg + 4 * hi;
                    *(LAS f32x4*)(xq + d * 4) = (f32x4){o[db][4 * rg], o[db][4 * rg + 1], o[db][4 * rg + 2], o[db][4 * rg + 3]}; }
        }
        BLK_SYNC();
        if (map == 0) {
            float ss = 0.f;
#pragma unroll
            for (int db = 0; db < 4; ++db)
#pragma unroll
                for (int rg = 0; rg < 4; ++rg) { const int d = 32 * db + 8 * rg + 4 * hi; const f32x4 o2 = *(LAS const f32x4*)(xq + d * 4);
#pragma unroll
                    for (int e = 0; e < 4; ++e) { const float v = o[db][4 * rg + e] - lam * o2[e]; o[db][4 * rg + e] = v; ss += v * v; } }
            ss += __shfl_xor(ss, 32);
            const float rn = rsqrtf(ss * (1.0f / 128.0f) + SUBLN_EPS) * 0.8f;
            const bf16_t* zp = Zb + (size_t)qrow * DM + h * 128; bf16_t* op = Ob + (size_t)qrow * DM + h * 128;
#pragma unroll
            for (int db = 0; db < 4; ++db)
#pragma unroll
                for (int rg = 0; rg < 4; ++rg) { const int d = 32 * db + 8 * rg + 4 * hi;
                    const f32x4 gg = *(const f32x4*)(p.subln + d); const u32x2 zz = *(const u32x2*)(zp + d);
                    const float v0 = o[db][4 * rg] * rn * gg[0] * silu_f(bf_lo(zz.x)), v1 = o[db][4 * rg + 1] * rn * gg[1] * silu_f(bf_hi(zz.x));
                    const float v2 = o[db][4 * rg + 2] * rn * gg[2] * silu_f(bf_lo(zz.y)), v3 = o[db][4 * rg + 3] * rn * gg[3] * silu_f(bf_hi(zz.y));
                    u32x2 w; w.x = pk2(v0, v1); w.y = pk2(v2, v3); *(u32x2*)(op + d) = w; }
        }
        BLK_SYNC();
    }
}

constexpr int FT_P = 320;
template <int MODE> __device__ __forceinline__ void fft_rows(int unit, int& rbase, int& cc, int& a0, int& a1, int& a2) {
    cc = unit & 7;
    if (MODE == 0) { a0 = unit >> 3; rbase = 0; a1 = 0; a2 = 0; }
    else if (MODE == 1) { a0 = unit >> 7; a1 = (unit >> 3) & 15; rbase = SEQP + a0 * SEQS; a2 = 0; }
    else { if (unit < 1024) { rbase = 0; a0 = unit >> 3; a1 = 128; } else { const int v = unit - 1024; rbase = SEQP + (v >> 7) * SEQS; a0 = (v >> 3) & 15; a1 = 16; } a2 = 0; }
}
template <int MODE> __device__ __forceinline__ const bf16_t* fft_src(const bf16_t* AB, int rbase, int cc, int a0, int a1, int rho, int ch16) {
    int grow, part;
    if (MODE == 0) { part = rho >> 7; grow = (rho & 127) * 128 + a0; }
    else if (MODE == 1) { part = (rho >> 4) & 1; grow = rbase + (rho & 15) * 128 + a1 * 8 + (rho >> 5); }
    else { part = rho >> 7; grow = rbase + a0 * 128 + (rho & 127); }
    return AB + (size_t)grow * 2048 + part * 1024 + cc * 128 + ch16 * 8;
}

template <int MODE> __device__ __forceinline__ void fft_pass(LAS unsigned char* lds, bf16_t* AB, const bf16_t* Z1, bf16_t* FG, int nunits) {
    const int tid = threadIdx.x, lane = tid & 63, wave = __builtin_amdgcn_readfirstlane(tid >> 6), r32 = lane & 31, hi = lane >> 5;
    const int g16 = lane >> 4, i16 = lane & 15, tq = i16 >> 2, tp = i16 & 3;
    const int kb = wave & 3, cbh = wave >> 2;
    bf16x8 Cf[8], Sf[8];
    if (MODE != 1) {
        const int k = 32 * kb + r32;
#pragma unroll
        for (int s = 0; s < 8; ++s) { Cf[s] = *(const bf16x8*)(g_tab128 + k * 128 + 16 * s + 8 * hi); Sf[s] = *(const bf16x8*)(g_tab128 + (128 + k) * 128 + 16 * s + 8 * hi); }
    } else {
#pragma unroll
        for (int s = 0; s < 2; ++s) Cf[s] = *(const bf16x8*)(g_tab16 + r32 * 32 + 16 * s + 8 * hi);
    }
    int unit = blockIdx.x;
    if (unit >= nunits) return;
    int rbase, cc, a0, a1, a2;
    fft_rows<MODE>(unit, rbase, cc, a0, a1, a2);
    u32x4 stg[8];
#pragma unroll
    for (int i = 0; i < 8; ++i) { const int c = tid + 512 * i; stg[i] = *(const u32x4*)fft_src<MODE>(AB, rbase, cc, a0, a1, c >> 4, c & 15); }
    __builtin_amdgcn_s_waitcnt(0x0F70);
    for (;;) {
#pragma unroll
        for (int i = 0; i < 8; ++i) { const int c = tid + 512 * i; *(LAS u32x4*)(lds + (c >> 4) * FT_P + (c & 15) * 16) = stg[i]; }
        BLK_SYNC();
        const int nunit = unit + gridDim.x; const bool has_next = nunit < nunits;
        int nrbase = 0, ncc = 0, na0 = 0, na1 = 0, na2 = 0;
        if (has_next) { fft_rows<MODE>(nunit, nrbase, ncc, na0, na1, na2);
#pragma unroll
            for (int i = 0; i < 8; ++i) { const int c = tid + 512 * i; stg[i] = *(const u32x4*)fft_src<MODE>(AB, nrbase, ncc, na0, na1, c >> 4, c & 15); } }
        if (MODE == 0) {
            const int k1 = 32 * kb + r32, n2 = a0;
            const float ph = (float)((k1 * n2) & 16383) * (1.0f / 16384.0f); const float tc = __builtin_amdgcn_cosf(ph), ts = __builtin_amdgcn_sinf(ph);
#pragma unroll 1
            for (int cbi = 0; cbi < 2; ++cbi) { const int cb = 2 * cbh + cbi;
                LAS const unsigned char* ab = lds + (8 * hi + tq) * FT_P + (32 * cb + 16 * (g16 & 1) + 4 * tp) * 2;
                f32x16 yr, yi;
#pragma unroll
                for (int r = 0; r < 16; ++r) { yr[r] = 0.f; yi[r] = 0.f; }
#pragma unroll
                for (int s = 0; s < 8; ++s) {
                    const bf16x8 af = cat8(tr_read(ab + (16 * s) * FT_P), tr_read(ab + (16 * s + 4) * FT_P));
                    const bf16x8 bf = cat8(tr_read(ab + (128 + 16 * s) * FT_P), tr_read(ab + (128 + 16 * s + 4) * FT_P));
                    const bf16x8 naf = neg8(af), nbf = neg8(bf);
                    yr = MFMA32(af, Cf[s], yr); yr = MFMA32(nbf, Sf[s], yr);
                    yi = MFMA32(naf, Sf[s], yi); yi = MFMA32(nbf, Cf[s], yi);
                }
                bf16_t* orow = AB + (size_t)(k1 * 128 + n2) * 2048 + cc * 128 + cb * 32 + 4 * hi;
#pragma unroll
                for (int rg = 0; rg < 4; ++rg) { float a[4], b[4];
#pragma unroll
                    for (int e = 0; e < 4; ++e) { const float vr = yr[4 * rg + e], vi = yi[4 * rg + e]; a[e] = vr * tc + vi * ts; b[e] = vi * tc - vr * ts; }
                    u32x2 w0, w1; w0.x = pk2(a[0], a[1]); w0.y = pk2(a[2], a[3]); w1.x = pk2(b[0], b[1]); w1.y = pk2(b[2], b[3]);
                    *(u32x2*)(orow + 8 * rg) = w0; *(u32x2*)(orow + 1024 + 8 * rg) = w1; }
            }
        } else if (MODE == 1) {
            const int k1 = r32 & 15, po = r32 >> 4, n2 = a1 * 8 + wave;
            const float ph = (float)((k1 * n2) & 2047) * (1.0f / 2048.0f); const float tc = __builtin_amdgcn_cosf(ph); float ts = __builtin_amdgcn_sinf(ph); if (po) ts = -ts;
#pragma unroll 1
            for (int cb = 0; cb < 4; ++cb) {
                LAS const unsigned char* ab = lds + (wave * 32 + 8 * hi + tq) * FT_P + (32 * cb + 16 * (g16 & 1) + 4 * tp) * 2;
                f32x16 y;
#pragma unroll
                for (int r = 0; r < 16; ++r) y[r] = 0.f;
                const bf16x8 f0 = cat8(tr_read(ab), tr_read(ab + 4 * FT_P)), f1 = cat8(tr_read(ab + 16 * FT_P), tr_read(ab + 20 * FT_P));
                y = MFMA32(f0, Cf[0], y); y = MFMA32(f1, Cf[1], y);
                bf16_t* orow = AB + (size_t)(rbase + k1 * 128 + n2) * 2048 + po * 1024 + cc * 128 + cb * 32 + 4 * hi;
#pragma unroll
                for (int rg = 0; rg < 4; ++rg) { float a[4];
#pragma unroll
                    for (int e = 0; e < 4; ++e) { const float own = y[4 * rg + e], oth = __shfl_xor(own, 16); a[e] = own * tc + oth * ts; }
                    u32x2 w0; w0.x = pk2(a[0], a[1]); w0.y = pk2(a[2], a[3]); *(u32x2*)(orow + 8 * rg) = w0; }
            }
        } else {
            const int k2 = 32 * kb + r32, k1 = a0, N1 = a1; const float nrm = (N1 == 128) ? 6.905339660024879e-4f : 1.953125e-3f;
            const size_t orow_i = (size_t)(rbase + k1 + N1 * k2);
#pragma unroll 1
            for (int cbi = 0; cbi < 2; ++cbi) { const int cb = 2 * cbh + cbi;
                LAS const unsigned char* ab = lds + (8 * hi + tq) * FT_P + (32 * cb + 16 * (g16 & 1) + 4 * tp) * 2;
                f32x16 y;
#pragma unroll
                for (int r = 0; r < 16; ++r) y[r] = 0.f;
#pragma unroll
                for (int s = 0; s < 8; ++s) {
                    const bf16x8 af = cat8(tr_read(ab + (16 * s) * FT_P), tr_read(ab + (16 * s + 4) * FT_P));
                    const bf16x8 bf = cat8(tr_read(ab + (128 + 16 * s) * FT_P), tr_read(ab + (128 + 16 * s + 4) * FT_P));
                    y = MFMA32(af, Cf[s], y); y = MFMA32(bf, Sf[s], y);
                }
                const bf16_t* zrow = Z1 + orow_i * DM + cc * 128 + cb * 32 + 4 * hi; bf16_t* orow = FG + orow_i * DM + cc * 128 + cb * 32 + 4 * hi;
#pragma unroll
                for (int rg = 0; rg < 4; ++rg) { const u32x2 zz = *(const u32x2*)(zrow + 8 * rg);
                    const float v0 = y[4 * rg] * nrm * silu_f(bf_lo(zz.x)), v1 = y[4 * rg + 1] * nrm * silu_f(bf_hi(zz.x));
                    const float v2 = y[4 * rg + 2] * nrm * silu_f(bf_lo(zz.y)), v3 = y[4 * rg + 3] * nrm * silu_f(bf_hi(zz.y));
                    u32x2 w; w.x = pk2(v0, v1); w.y = pk2(v2, v3); *(u32x2*)(orow + 8 * rg) = w; }
            }
        }
        BLK_SYNC();
        if (!has_next) break;
        unit = nunit; rbase = nrbase; cc = ncc; a0 = na0; a1 = na1; a2 = na2;
    }
}

#ifndef PROBE
#define PROBE 0
#endif
#ifndef PHM
#define PHM 0xffff
#endif
__global__ void __launch_bounds__(NTHR, 2) fwd_kernel(Params p) {
    extern __shared__ __attribute__((aligned(16))) unsigned char lds_raw[];
    LAS unsigned char* lds = (LAS unsigned char*)lds_raw;
    cg::grid_group grid = cg::this_grid();
    if (threadIdx.x < 4) ((LAS unsigned*)(lds + XB_LDS_OFF))[threadIdx.x] = 0u;
    __syncthreads();
    const size_t REG = (size_t)MTOT * DM;
    bf16_t* R0 = (bf16_t*)p.ws; bf16_t* R1 = R0 + REG; bf16_t* R2 = R1 + REG; bf16_t* R3 = R2 + REG;
    bf16_t* XB = (bf16_t*)p.out;

    if (PHM & 1) phase0(p, lds, XB);
#if PROBE & 4
    phase0(p, lds, XB);
#endif

    grid.sync();
    const XcdBarrier xbar = xcd_barrier_post(g_bar, (volatile LAS unsigned*)(lds + XB_LDS_OFF));
#if PROBE & 16
    xcd_barrier(xbar); xcd_barrier(xbar); xcd_barrier(xbar); xcd_barrier(xbar); xcd_barrier(xbar); xcd_barrier(xbar); xcd_barrier(xbar); xcd_barrier(xbar);
#endif
    if (PHM & 2) {
        pg8::Gemm gm{XB, g_w0t, MTOT, 4096, 1024, 1024, 1024}; pg8::StaticOrder S; S.init(MTOT, 4096, gridDim.x, blockIdx.x);
        EpiRowBf16 E{R0, R1, R2, R3, DM, DM, 1024, g_r0, 0, QSCALE, g_nrm};
        pg8::gemm_phase<EpiRowBf16, pg8::StaticOrder, true, true>(lds, gm, S, E);
#if PROBE & 1
        pg8::gemm_phase<EpiRowBf16, pg8::StaticOrder, true, true>(lds, gm, S, E);
#endif
    }
    xcd_barrier(xbar);
    if ((PHM & 512) && blockIdx.x < 32) {
        const int fu = blockIdx.x, g = fu >> 2; pg8::Gemm gm{g_tab128, g_ws1 + g * 128, 256, 1024, 128, 128, 1024}; OneUnit S{fu & 3}; EpiFold E{g_w1t, g};
        pg8::gemm_phase<EpiFold, OneUnit, false, true>(lds, gm, S, E);
    }
#if PROBE & 2
    attn_phase(p, lds, R0, R1, R2, R3, (bf16_t*)p.out + REG, &g_ctr[1]);
#endif
    if (PHM & 4) attn_phase(p, lds, R0, R1, R2, R3, R0, &g_ctr[0]);
    xcd_barrier(xbar);
    if (PHM & 8) {
        pg8::Gemm gm{R0, g_wo0t, MTOT, 1024, 1024, 1024, 1024}; pg8::StaticOrder S; S.init(MTOT, 1024, gridDim.x, blockIdx.x);
        EpiResid E{p.xp, p.xs, p.out, R3, g_ss1};
        pg8::gemm_phase<EpiResid, pg8::StaticOrder, true, true>(lds, gm, S, E);
#if PROBE & 1
        { EpiResid E2{p.xp, p.xs, p.out, R3, g_r0}; pg8::gemm_phase<EpiResid, pg8::StaticOrder, true, true>(lds, gm, S, E2); }
#endif
    }
    xcd_barrier(xbar);
    if (PHM & 16) {
        pg8::Gemm gm{R3, g_w1t, MTOT, 3072, 1024, 1024, 1024}; pg8::StaticOrder S; S.init(MTOT, 3072, gridDim.x, blockIdx.x);
        EpiRowBf16 E{R1, R0, R0, R0, 2048, DM, 2048, g_ss1, 1, 1.0f, nullptr};
        pg8::gemm_phase<EpiRowBf16, pg8::StaticOrder, true, true>(lds, gm, S, E);
#if PROBE & 1
        pg8::gemm_phase<EpiRowBf16, pg8::StaticOrder, true, true>(lds, gm, S, E);
#endif
    }
    xcd_barrier(xbar);
    if (PHM & 32) fft_pass<0>(lds, R1, nullptr, nullptr, 1024);
    if (PHM & 64) fft_pass<1>(lds, R1, nullptr, nullptr, 1024);
    xcd_barrier(xbar);
    if (PHM & 128) fft_pass<2>(lds, R1, R0, R3, 2048);
#if PROBE & 8
    fft_pass<2>(lds, R1, R0, R3, 2048);
#endif
    xcd_barrier(xbar);
    if (PHM & 256) {
        pg8::Gemm gm{R3, g_wo1t, MTOT, 1024, 1024, 1024, 1024}; pg8::StaticOrder S; S.init(MTOT, 1024, gridDim.x, blockIdx.x);
        EpiResid E{p.out, p.out + (size_t)SEQP * DM, p.out, nullptr, g_ss2};
        pg8::gemm_phase<EpiResid, pg8::StaticOrder, true, true>(lds, gm, S, E);
    }
    xcd_barrier(xbar);
    const int lane = threadIdx.x & 63, wave = threadIdx.x >> 6;
    for (int row = blockIdx.x * 8 + wave; row < MTOT; row += gridDim.x * 8) {
        const float rs = rsqrtf(g_ss2[row] * (1.0f / 1024.0f) + EPS); float* orow = p.out + (size_t)row * DM;
#pragma unroll
        for (int i = 0; i < 4; ++i) { const int c = 4 * (lane + 64 * i); f32x4 v = *(const f32x4*)(orow + c); const f32x4 gg = *(const f32x4*)(p.final_norm + c);
            v[0] *= rs * gg[0]; v[1] *= rs * gg[1]; v[2] *= rs * gg[2]; v[3] *= rs * gg[3]; *(f32x4*)(orow + c) = v; }
    }
}

extern "C" void kernel_launch(void* const* d_in, const int* in_sizes, int n_in, void* d_out, int out_size, void* d_ws, size_t ws_size, hipStream_t stream) {
    static int grid = 0;
    if (grid == 0) {
        int dev = 0, cus = 0, per_cu = 0;
        if (n_in != 14 || ws_size < (size_t)4 * MTOT * DM * 2) { fprintf(stderr, "kernel_launch: unexpected problem shape (n_in %d, ws %zu)\n", n_in, ws_size); grid = -1; return; }
        hipGetDevice(&dev); hipDeviceGetAttribute(&cus, hipDeviceAttributeMultiprocessorCount, dev);
        if (hipFuncSetAttribute((const void*)fwd_kernel, hipFuncAttributeMaxDynamicSharedMemorySize, LDS_TOTAL) != hipSuccess) { fprintf(stderr, "kernel_launch: hipFuncSetAttribute failed\n"); grid = -1; return; }
        if (hipOccupancyMaxActiveBlocksPerMultiprocessor(&per_cu, (const void*)fwd_kernel, NTHR, LDS_TOTAL) != hipSuccess || per_cu < 1) { fprintf(stderr, "kernel_launch: occupancy query says %d blocks per CU\n", per_cu); per_cu = 1; }
        (void)hipGetLastError();
        grid = cus * 1;
    }
    if (grid < 0) return;
    Params p{};
    p.xp = (const float*)d_in[0]; p.xs = (const float*)d_in[1]; p.attn_norm = (const float*)d_in[2]; p.w_in0 = (const float*)d_in[3];
    p.lq1 = (const float*)d_in[4]; p.lk1 = (const float*)d_in[5]; p.lq2 = (const float*)d_in[6]; p.lk2 = (const float*)d_in[7];
    p.subln = (const float*)d_in[8]; p.w_out0 = (const float*)d_in[9]; p.fnet_norm = (const float*)d_in[10]; p.w_in1 = (const float*)d_in[11];
    p.w_out1 = (const float*)d_in[12]; p.final_norm = (const float*)d_in[13];
    p.out = (float*)d_out; p.ws = (unsigned char*)d_ws;
    void* args[] = {&p};
    const hipError_t e = hipLaunchCooperativeKernel((const void*)fwd_kernel, dim3(grid), dim3(NTHR), args, LDS_TOTAL, stream);
    if (e != hipSuccess) fprintf(stderr, "kernel_launch: cooperative launch failed: %s (grid %d)\n", hipGetErrorString(e), grid);
}
```

```cpp
#include <hip/hip_runtime.h>
#include <hip/hip_cooperative_groups.h>
#include <cstdio>
#include <cstdint>
namespace cg = cooperative_groups;
namespace pg8 {
#define PG8_LAS __attribute__((address_space(3)))
typedef unsigned short bf16_t;
typedef short bf16x8 __attribute__((ext_vector_type(8)));
typedef float f32x4 __attribute__((ext_vector_type(4)));
typedef unsigned u32x4 __attribute__((ext_vector_type(4)));
constexpr int BM = 256, BK = 64, HALF = 128, HTB = HALF * BK * 2  , STAGE_BYTES = 8 * HTB, NXCD = 8, WGM = 8;

__host__ __device__ __forceinline__ int lds_byte(int r, int c) { const int st = (r >> 4) * 2 + (c >> 5), rr = r & 15, cc = c & 31, ob = rr * 64 + cc * 2; return st * 1024 + (ob ^ (((ob >> 9) & 1) << 5)); }
__host__ __device__ __forceinline__ void stage_rc(int b, int& R, int& C) { const int st = b / 1024, sb = b % 1024, swz = sb ^ (((sb >> 9) & 1) << 5); R = (st >> 1) * 16 + swz / 64; C = (st & 1) * 32 + (swz % 64) / 2; }
__host__ __device__ __forceinline__ int perm32(int rho) { const int n = rho >> 4, i = rho & 15; return 8 * (i >> 2) + 4 * n + (i & 3); }

struct Unit { int pm, pn; };
struct Gemm { const bf16_t* A; const bf16_t* Bt; int M, N, K, lda, ldb; };

struct StaticOrder {
    int nM, nN, nwg, G, c;
    __host__ __device__ void init(int M, int N, int G_, int c_) { nM = M / BM; nN = N / BM; nwg = nM * nN; G = G_; c = c_; }
    __host__ __device__ bool next(int i, Unit& u) const {
        const long L = (long)i * G + c; if (L >= nwg) return false;
        int wgid = (int)L; { const int q = nwg / NXCD, r = nwg % NXCD, xcd = wgid % NXCD, off = wgid / NXCD; wgid = (xcd < r ? xcd * (q + 1) : r * (q + 1) + (xcd - r) * q) + off; }
        const int nig = WGM * nN, gid = wgid / nig, fm = gid * WGM, gsz = (nM - fm) < WGM ? (nM - fm) : WGM;
        u.pm = fm + ((wgid % nig) % gsz); u.pn = (wgid % nig) / gsz; return true;
    }
    __device__ __forceinline__ void a_ready(const Unit&) const {}
    __device__ __forceinline__ void done(const Unit&) const {}
};
template <class Epi, class Sched, bool ALIGN_EPI = false, bool SP2 = false>
__device__ __forceinline__ void gemm_phase(PG8_LAS unsigned char* lds, const Gemm g, const Sched& S, const Epi& E) {
    const int tid = threadIdx.x, wid = __builtin_amdgcn_readfirstlane(tid >> 6), lane = tid & 63, wr = wid >> 2, wc = wid & 3, fr = lane & 15, fq = lane >> 4;
    const int K = g.K, nt = K / BK;
    unsigned voffA[2], voffB[2];
#pragma unroll
    for (int i = 0; i < 2; ++i) { int R, C; stage_rc(tid * 16 + i * 8192, R, C); const int Rb = Epi::PERM ? ((R & ~31) + perm32(R & 31)) : R;
        voffA[i] = (unsigned)(R * g.lda + C) * 2u; voffB[i] = (unsigned)(Rb * g.ldb + C) * 2u; }
    const size_t kstep = (size_t)(BK * 2);
    const size_t hstepA = (size_t)HALF * g.lda * 2, hstepB = (size_t)HALF * g.ldb * 2;
    const size_t tstepA = 2 * hstepA, tstepB = 2 * hstepB;
    const unsigned ldsw = (unsigned)wid * 1024u;
    const int aoff = lds_byte(wr * 64 + fr, fq * 8), boff = lds_byte(wc * 32 + fr, fq * 8);
#define PG8_SA(b, h) (((b) * 2 + (h)) * HTB)
#define PG8_SB(b, h) ((4 + (b) * 2 + (h)) * HTB)
#define PG8_STAGE(bufoff, gbase, voff) do { _Pragma("unroll") for (int _i = 0; _i < 2; ++_i) \
        __builtin_amdgcn_global_load_lds((const unsigned*)((const char*)(gbase) + (voff)[_i]), (PG8_LAS unsigned*)(lds + (bufoff) + ldsw + _i * 8192), 16, 0, 0); } while (0)
#define PG8_LDA(dst, b, h) do { _Pragma("unroll") for (int m = 0; m < 4; ++m) _Pragma("unroll") for (int k = 0; k < 2; ++k) dst[m][k] = *(const PG8_LAS bf16x8*)(lds + PG8_SA(b, h) + aoff + m * 2048 + k * 1024); } while (0)
#define PG8_LDB(dst, b, h) do { _Pragma("unroll") for (int n = 0; n < 2; ++n) _Pragma("unroll") for (int k = 0; k < 2; ++k) dst[n][k] = *(const PG8_LAS bf16x8*)(lds + PG8_SB(b, h) + boff + n * 2048 + k * 1024); } while (0)
#define PG8_MMA(ai, bj, At, Bt) do { __builtin_amdgcn_s_setprio(1); _Pragma("unroll") for (int m = 0; m < 4; ++m) _Pragma("unroll") for (int n = 0; n < 2; ++n) _Pragma("unroll") for (int k = 0; k < 2; ++k) \
        acc[ai][bj][m][n] = __builtin_amdgcn_mfma_f32_16x16x32_bf16(Bt[n][k], At[m][k], acc[ai][bj][m][n], 0, 0, 0); __builtin_amdgcn_s_setprio(0); } while (0)
#define PG8_WAIT_V(n) asm volatile("s_waitcnt vmcnt(" #n ")" ::: "memory")
#define PG8_WAIT_L(n) asm volatile("s_waitcnt lgkmcnt(" #n ")" ::: "memory")
#define PG8_BAR __builtin_amdgcn_s_barrier()
#define PG8_SCHED __builtin_amdgcn_sched_barrier(0)
    Unit cur, nxt; int ui = 0;
    if (!S.next(0, cur)) return;
    f32x4 acc[2][2][4][2];
#pragma unroll
    for (int a = 0; a < 2; ++a)
#pragma unroll
        for (int b = 0; b < 2; ++b)
#pragma unroll
            for (int m = 0; m < 4; ++m)
#pragma unroll
                for (int n = 0; n < 2; ++n) acc[a][b][m][n] = (f32x4){0.f, 0.f, 0.f, 0.f};
    bf16x8 At[4][2], B0[2][2], B1[2][2];
    const char* cA = (const char*)g.A + (size_t)cur.pm * tstepA; const char* cB = (const char*)g.Bt + (size_t)cur.pn * tstepB;
    S.a_ready(cur);
    if constexpr (SP2) {
        PG8_STAGE(PG8_SB(0, 0), cB, voffB); PG8_STAGE(PG8_SB(0, 1), cB + hstepB, voffB); PG8_STAGE(PG8_SA(0, 0), cA, voffA); PG8_STAGE(PG8_SA(0, 1), cA + hstepA, voffA);
        if (wr == 1) PG8_BAR;
        PG8_WAIT_V(2); PG8_BAR;
        PG8_STAGE(PG8_SB(1, 0), cB + kstep, voffB); PG8_STAGE(PG8_SA(1, 0), cA + kstep, voffA); PG8_STAGE(PG8_SB(1, 1), cB + hstepB + kstep, voffB);
        PG8_WAIT_V(6); PG8_BAR;
    } else {
        PG8_STAGE(PG8_SB(0, 0), cB, voffB); PG8_STAGE(PG8_SA(0, 0), cA, voffA); PG8_STAGE(PG8_SB(0, 1), cB + hstepB, voffB); PG8_STAGE(PG8_SA(0, 1), cA + hstepA, voffA);
        if (wr == 1) PG8_BAR;
        PG8_WAIT_V(4); PG8_BAR;
        PG8_STAGE(PG8_SB(1, 0), cB + kstep, voffB); PG8_STAGE(PG8_SA(1, 0), cA + kstep, voffA); PG8_STAGE(PG8_SB(1, 1), cB + hstepB + kstep, voffB);
        PG8_WAIT_V(6); PG8_BAR;
    }
    for (;;) {
        const bool has_next = S.next(ui + 1, nxt);
        const char* nA = has_next ? (const char*)g.A + (size_t)nxt.pm * tstepA : cA; const char* nB = has_next ? (const char*)g.Bt + (size_t)nxt.pn * tstepB : cB;
        for (int t = 0; t < nt; t += 2) {
            const bool last = (t == nt - 2);
            const char* a1 = cA + (size_t)(t + 1) * kstep;
            const char* a2 = last ? nA : cA + (size_t)(t + 2) * kstep; const char* b2 = last ? nB : cB + (size_t)(t + 2) * kstep;
            const char* a3 = a2 + kstep; const char* b3 = b2 + kstep;
            if (last && has_next) S.a_ready(nxt);
            if constexpr (SP2) {
            PG8_LDB(B0, 0, 0); PG8_LDB(B1, 0, 1); PG8_SCHED; PG8_LDA(At, 0, 0); PG8_STAGE(PG8_SA(1, 1), a1 + hstepA, voffA);
            PG8_WAIT_V(8); PG8_WAIT_L(0); PG8_BAR; PG8_MMA(0, 0, At, B0); PG8_MMA(0, 1, At, B1); PG8_BAR; PG8_SCHED;
            PG8_LDA(At, 0, 1); PG8_STAGE(PG8_SB(0, 0), b2, voffB); PG8_STAGE(PG8_SB(0, 1), b2 + hstepB, voffB); PG8_STAGE(PG8_SA(0, 0), a2, voffA);
            PG8_WAIT_V(8); PG8_WAIT_L(0); PG8_BAR; PG8_MMA(1, 0, At, B0); PG8_MMA(1, 1, At, B1); PG8_BAR; PG8_SCHED;
            PG8_LDB(B0, 1, 0); PG8_LDB(B1, 1, 1); PG8_SCHED; PG8_LDA(At, 1, 0); PG8_STAGE(PG8_SA(0, 1), a2 + hstepA, voffA);
            PG8_WAIT_V(8); PG8_WAIT_L(0); PG8_BAR; PG8_MMA(0, 0, At, B0); PG8_MMA(0, 1, At, B1); PG8_BAR; PG8_SCHED;
            PG8_LDA(At, 1, 1); PG8_STAGE(PG8_SB(1, 0), b3, voffB); PG8_STAGE(PG8_SB(1, 1), b3 + hstepB, voffB); PG8_STAGE(PG8_SA(1, 0), a3, voffA);
            PG8_WAIT_V(8); PG8_WAIT_L(0); PG8_BAR; PG8_MMA(1, 0, At, B0); PG8_MMA(1, 1, At, B1); PG8_BAR; PG8_SCHED;
            } else {
            PG8_LDB(B0, 0, 0); PG8_SCHED; PG8_LDA(At, 0, 0); PG8_STAGE(PG8_SA(1, 1), a1 + hstepA, voffA);
            PG8_WAIT_L(8); PG8_BAR; PG8_WAIT_L(0); PG8_MMA(0, 0, At, B0); PG8_BAR; PG8_SCHED;
            PG8_LDB(B1, 0, 1); PG8_STAGE(PG8_SB(0, 0), b2, voffB);
            PG8_BAR; PG8_WAIT_L(0); PG8_MMA(0, 1, At, B1); PG8_BAR;
            PG8_LDA(At, 0, 1); PG8_STAGE(PG8_SA(0, 0), a2, voffA);
            PG8_BAR; PG8_WAIT_L(0); PG8_MMA(1, 0, At, B0); PG8_BAR; PG8_SCHED;
            PG8_STAGE(PG8_SB(0, 1), b2 + hstepB, voffB);
            PG8_WAIT_V(6); PG8_BAR; PG8_MMA(1, 1, At, B1); PG8_BAR;
            PG8_LDB(B0, 1, 0); PG8_SCHED; PG8_LDA(At, 1, 0); PG8_STAGE(PG8_SA(0, 1), a2 + hstepA, voffA);
            PG8_WAIT_L(8); PG8_BAR; PG8_WAIT_L(0); PG8_MMA(0, 0, At, B0); PG8_BAR; PG8_SCHED;
            PG8_LDB(B1, 1, 1); PG8_STAGE(PG8_SB(1, 0), b3, voffB);
            PG8_BAR; PG8_WAIT_L(0); PG8_MMA(0, 1, At, B1); PG8_BAR;
            PG8_LDA(At, 1, 1); PG8_STAGE(PG8_SA(1, 0), a3, voffA);
            PG8_BAR; PG8_WAIT_L(0); PG8_MMA(1, 0, At, B0); PG8_BAR; PG8_SCHED;
            PG8_STAGE(PG8_SB(1, 1), b3 + hstepB, voffB);
            PG8_WAIT_V(6); PG8_BAR; PG8_MMA(1, 1, At, B1); PG8_BAR;
            }
        }
        if constexpr (ALIGN_EPI) { if (wr == 0) PG8_BAR; }
        if constexpr (!Epi::AFTER_DRAIN) { E(acc, cur, wr, wc, fr, fq); S.done(cur); }
        if (!has_next) break;
#pragma unroll
        for (int a = 0; a < 2; ++a)
#pragma unroll
            for (int b = 0; b < 2; ++b)
#pragma unroll
                for (int m = 0; m < 4; ++m)
#pragma unroll
                    for (int n = 0; n < 2; ++n) acc[a][b][m][n] = (f32x4){0.f, 0.f, 0.f, 0.f};
        cur = nxt; cA = nA; cB = nB; ++ui;
        if constexpr (ALIGN_EPI) { if (wr == 1) PG8_BAR; }
    }
    PG8_WAIT_V(0);
    if constexpr (!ALIGN_EPI) { if (wr == 0) PG8_BAR; }
    PG8_BAR;
    if constexpr (Epi::AFTER_DRAIN) { E.fused(acc, cur, wr, wc, fr, fq, lds, wid, lane); S.done(cur); }
#undef PG8_SA
#undef PG8_SB
#undef PG8_STAGE
#undef PG8_LDA
#undef PG8_LDB
#undef PG8_MMA
#undef PG8_WAIT_V
#undef PG8_WAIT_L
#undef PG8_BAR
#undef PG8_SCHED
}
}
#ifndef LAS
#define LAS __attribute__((address_space(3)))
#endif

#define XB_TMO      128
#define XB_XCNT(j)  (256  + 64 * (j))
#define XB_XSUB(j)  (1280 + 64 * (j))
#define XB_XGEN(j)  (2304 + 64 * (j))
#define XB_TOP      3328
#define XB_TOPGEN   3392
#define XCD_BAR_WORDS 3456
#define XB_SPIN_CAP (1u << 18)

__device__ __forceinline__ unsigned xb_ld(unsigned* p)              { return __hip_atomic_load(p, __ATOMIC_RELAXED, __HIP_MEMORY_SCOPE_AGENT); }
__device__ __forceinline__ unsigned xb_add(unsigned* p, unsigned v) { return __hip_atomic_fetch_add(p, v, __ATOMIC_RELAXED, __HIP_MEMORY_SCOPE_AGENT); }
__device__ __forceinline__ unsigned xb_xcc_id() { return (unsigned)__builtin_amdgcn_s_getreg((3 << 11) | 20) & 0xFu; }
#define XB_SPIN(cond, bar) do { unsigned _sp = 0; while (cond) { __builtin_amdgcn_s_sleep(1); \
    if ((++_sp & 255u) == 0u) { if (xb_ld(&(bar)[XB_TMO])) break; if (_sp > XB_SPIN_CAP) { atomicAdd(&(bar)[XB_TMO], 1u); break; } } } } while (0)

struct XcdBarrier {
    unsigned* bar; unsigned x;
    volatile LAS unsigned* st;
};

__device__ __forceinline__ XcdBarrier xcd_barrier_post(unsigned* bar, volatile LAS unsigned* st) {
    XcdBarrier b; b.bar = bar; b.x = xb_xcc_id(); b.st = st;
    if (threadIdx.x == 0) (void)xb_add(&bar[XB_XCNT(b.x)], 1u);
    return b;
}
__device__ __forceinline__ void xcd_barrier_complete(unsigned* bar, unsigned x, unsigned& nloc, unsigned& nx) {
    const unsigned G = gridDim.x * gridDim.y * gridDim.z;
    unsigned sum, cnt, mine, sp = 0u;
    for (;;) {
        sum = 0u; cnt = 0u; mine = 0u;
#pragma unroll
        for (unsigned j = 0; j < 16; ++j) { const unsigned c = xb_ld(&bar[XB_XCNT(j)]); sum += c; cnt += (c > 0u) ? 1u : 0u; mine = (j == x) ? c : mine; }
        if (sum == G) break;
        __builtin_amdgcn_s_sleep(1);
        if ((++sp & 255u) == 0u) { if (xb_ld(&bar[XB_TMO])) break; if (sp > XB_SPIN_CAP) { atomicAdd(&bar[XB_TMO], 1u); break; } }
    }
    nloc = mine > 0u ? mine : 1u; nx = cnt > 0u ? cnt : 1u;
}

__device__ __forceinline__ void xcd_barrier(const XcdBarrier& b) {
    asm volatile("s_waitcnt vmcnt(0)" ::: "memory");
    __syncthreads();
    if (threadIdx.x == 0) {
        unsigned* bar = b.bar;
        __builtin_amdgcn_s_waitcnt(0);
        unsigned nloc = b.st[0], nx = b.st[1];
        if (nloc == 0u) { xcd_barrier_complete(bar, b.x, nloc, nx); b.st[0] = nloc; b.st[1] = nx; }
        const unsigned old = xb_add(&bar[XB_XSUB(b.x)], 1u);
        const unsigned gen = old / nloc;
        if (old + 1u == (gen + 1u) * nloc) {
            __builtin_amdgcn_fence(__ATOMIC_RELEASE, "agent");
            asm volatile("s_waitcnt vmcnt(0)" ::: "memory");
            const unsigned og = xb_add(&bar[XB_TOP], 1u);
            const unsigned tg = og / nx;
            if (og + 1u == (tg + 1u) * nx) xb_add(&bar[XB_TOPGEN], 1u);
            else XB_SPIN(xb_ld(&bar[XB_TOPGEN]) == tg, bar);
            __builtin_amdgcn_fence(__ATOMIC_ACQUIRE, "agent");
            xb_add(&bar[XB_XGEN(b.x)], 1u);
            asm volatile("s_waitcnt vmcnt(0)" ::: "memory");
        } else {
            XB_SPIN(xb_ld(&bar[XB_XGEN(b.x)]) == gen, bar);
            __builtin_amdgcn_fence(__ATOMIC_ACQUIRE, "agent");
            asm volatile("s_waitcnt vmcnt(0)" ::: "memory");
        }
    }
    __syncthreads();
}


__device__ __attribute__((aligned(256))) unsigned g_bar[XCD_BAR_WORDS];
#ifndef LAS
#define LAS __attribute__((address_space(3)))
#endif
typedef unsigned short bf16_t;
typedef short bf16x8 __attribute__((ext_vector_type(8)));
typedef short s16x4 __attribute__((ext_vector_type(4)));
typedef float f32x4 __attribute__((ext_vector_type(4)));
typedef float f32x16 __attribute__((ext_vector_type(16)));
typedef unsigned u32x4 __attribute__((ext_vector_type(4)));
typedef unsigned u32x2 __attribute__((ext_vector_type(2)));
typedef float f32x2_t __attribute__((ext_vector_type(2)));
typedef __bf16 bf16x2_t __attribute__((ext_vector_type(2)));

constexpr int DM = 1024, MTOT = 32768, SEQP = 16384, SEQS = 2048;
constexpr int NTHR = 512;
constexpr float EPS = 1e-6f, SUBLN_EPS = 1e-5f, LOG2E = 1.4426950408889634f;
constexpr float QSCALE = 0.125f * LOG2E;
constexpr int XB_LDS_OFF = 131072, LDS_TOTAL = 131072 + 256;

__device__ __attribute__((aligned(256))) bf16_t g_w0t[4096 * 1024];
__device__ __attribute__((aligned(256))) bf16_t g_wo0t[1024 * 1024];
__device__ __attribute__((aligned(256))) bf16_t g_ws1[1024 * 1024];
__device__ __attribute__((aligned(256))) bf16_t g_w1t[3072 * 1024];
__device__ __attribute__((aligned(256))) bf16_t g_wo1t[1024 * 1024];
__device__ __attribute__((aligned(256))) bf16_t g_tab128[256 * 128];
__device__ __attribute__((aligned(256))) bf16_t g_tab16[32 * 32];
__device__ __attribute__((aligned(256))) float g_r0[MTOT];
__device__ __attribute__((aligned(256))) float g_ss1[MTOT];
__device__ __attribute__((aligned(256))) float g_ss2[MTOT];
__device__ __attribute__((aligned(256))) unsigned g_nrm[64];
__device__ __attribute__((aligned(256))) unsigned g_ctr[4];

struct Params {
    const float* xp; const float* xs; const float* attn_norm; const float* w_in0; const float* lq1; const float* lk1; const float* lq2; const float* lk2;
    const float* subln; const float* w_out0; const float* fnet_norm; const float* w_in1; const float* w_out1; const float* final_norm;
    float* out; unsigned char* ws;
};

__device__ __forceinline__ unsigned pk2(float lo, float hi) { f32x2_t v = {lo, hi}; bf16x2_t b = __builtin_convertvector(v, bf16x2_t); return __builtin_bit_cast(unsigned, b); }
__device__ __forceinline__ float bf_lo(unsigned u) { return __uint_as_float(u << 16); }
__device__ __forceinline__ float bf_hi(unsigned u) { return __uint_as_float(u & 0xffff0000u); }
__device__ __forceinline__ float wave_sum(float v) { v += __shfl_xor(v, 32); v += __shfl_xor(v, 16); v += __shfl_xor(v, 8); v += __shfl_xor(v, 4); v += __shfl_xor(v, 2); v += __shfl_xor(v, 1); return v; }
__device__ __forceinline__ float silu_f(float z) { return z / (1.0f + __expf(-z)); }
__device__ __forceinline__ int crow(int r, int hi) { return (r & 3) + 8 * (r >> 2) + 4 * hi; }
#define BLK_SYNC() __syncthreads()

struct EpiRowBf16 {
    static constexpr bool PERM = true, AFTER_DRAIN = false;
    bf16_t* b0; bf16_t* b1; bf16_t* b2; bf16_t* b3; int ld0, ld1; int split_cols; const float* rstat; int stat_is_sumsq; float scale0; unsigned* nrm;
    __device__ __forceinline__ void operator()(const pg8::f32x4 (&acc)[2][2][4][2], const pg8::Unit& u, int wr, int wc, int fr, int fq) const {
        const int row0 = u.pm * 256 + wr * 64 + fr; int colt = u.pn * 256; const int t = colt / split_cols; colt -= t * split_cols;
        bf16_t* b = (t == 0) ? b0 : (t == 1) ? b1 : (t == 2) ? b2 : b3; const int ld = (t == 0) ? ld0 : ld1; const float sc = (t == 0) ? scale0 : 1.0f;
        const int col0 = colt + wc * 32 + 8 * fq; const bool donrm = (nrm != nullptr) && (t < 2); float mx[2] = {0.f, 0.f};
#pragma unroll
        for (int ai = 0; ai < 2; ++ai)
#pragma unroll
            for (int m = 0; m < 4; ++m) {
                const int row = row0 + ai * 128 + m * 16; float rs = rstat[row];
                if (stat_is_sumsq) rs = rsqrtf(rs * (1.0f / 1024.0f) + EPS);
                rs *= sc; bf16_t* rowp = b + (size_t)row * ld + col0;
#pragma unroll
                for (int bj = 0; bj < 2; ++bj) { const pg8::f32x4 v0 = acc[ai][bj][m][0] * rs, v1 = acc[ai][bj][m][1] * rs;
                    u32x4 w; w.x = pk2(v0[0], v0[1]); w.y = pk2(v0[2], v0[3]); w.z = pk2(v1[0], v1[1]); w.w = pk2(v1[2], v1[3]);
                    *(u32x4*)(rowp + bj * 128) = w;
                    if (donrm) { float ps = (v0[0] * v0[0] + v0[1] * v0[1]) + (v0[2] * v0[2] + v0[3] * v0[3]) + (v1[0] * v1[0] + v1[1] * v1[1]) + (v1[2] * v1[2] + v1[3] * v1[3]);
                        ps += __shfl_xor(ps, 16); ps += __shfl_xor(ps, 32); mx[bj] = fmaxf(mx[bj], ps); } }
            }
        if (donrm) {
#pragma unroll
            for (int bj = 0; bj < 2; ++bj) { float v = mx[bj]; v = fmaxf(v, __shfl_xor(v, 1)); v = fmaxf(v, __shfl_xor(v, 2)); v = fmaxf(v, __shfl_xor(v, 4)); v = fmaxf(v, __shfl_xor(v, 8));
                if ((threadIdx.x & 63) == 0) atomicMax(nrm + t * 32 + ((colt + bj * 128 + wc * 32) >> 6) * 2 + (wc & 1), __float_as_uint(v)); }
        }
    }
};
struct EpiFold {
    static constexpr bool PERM = true, AFTER_DRAIN = false;
    bf16_t* O; int g;
    __device__ __forceinline__ void operator()(const pg8::f32x4 (&acc)[2][2][4][2], const pg8::Unit& u, int wr, int wc, int fr, int fq) const {
        const int col0 = u.pn * 256 + wc * 32 + 8 * fq;
#pragma unroll
        for (int ai = 0; ai < 2; ++ai)
#pragma unroll
            for (int m = 0; m < 4; ++m) {
                const int j = wr * 64 + m * 16 + fr; bf16_t* rowp = O + (size_t)(ai * 1024 + g * 128 + j) * 1024 + col0;
#pragma unroll
                for (int bj = 0; bj < 2; ++bj) { const pg8::f32x4 v0 = acc[ai][bj][m][0], v1 = acc[ai][bj][m][1];
                    u32x4 w; w.x = pk2(v0[0], v0[1]); w.y = pk2(v0[2], v0[3]); w.z = pk2(v1[0], v1[1]); w.w = pk2(v1[2], v1[3]);
                    *(u32x4*)(rowp + bj * 128) = w; }
            }
    }
};
struct EpiResid {
    static constexpr bool PERM = false, AFTER_DRAIN = false;
    const float* resA; const float* resB; float* out; bf16_t* outb; float* ss;
    __device__ __forceinline__ void operator()(const pg8::f32x4 (&acc)[2][2][4][2], const pg8::Unit& u, int wr, int wc, int fr, int fq) const {
        const int row0 = u.pm * 256 + wr * 64 + fr; const int col0 = u.pn * 256 + wc * 32 + 4 * fq;
#pragma unroll
        for (int ai = 0; ai < 2; ++ai)
#pragma unroll
            for (int m = 0; m < 4; ++m) {
                const int row = row0 + ai * 128 + m * 16;
                const float* rp = (row < SEQP) ? (resA + (size_t)row * DM) : (resB + (size_t)(row - SEQP) * DM);
                float s = 0.f;
#pragma unroll
                for (int bj = 0; bj < 2; ++bj)
#pragma unroll
                    for (int n = 0; n < 2; ++n) { const int col = col0 + bj * 128 + n * 16;
                        const pg8::f32x4 r = *(const pg8::f32x4*)(rp + col); const pg8::f32x4 v = r + acc[ai][bj][m][n];
                        *(pg8::f32x4*)(out + (size_t)row * DM + col) = v;
                        if (outb) { u32x2 w; w.x = pk2(v[0], v[1]); w.y = pk2(v[2], v[3]); *(u32x2*)(outb + (size_t)row * DM + col) = w; }
                        s += (v[0] * v[0] + v[1] * v[1]) + (v[2] * v[2] + v[3] * v[3]); }
                s += __shfl_xor(s, 16); s += __shfl_xor(s, 32);
                if (fq == 0) atomicAdd(ss + row, s);
            }
    }
};
struct OneUnit { int pn; __device__ bool next(int i, pg8::Unit& u) const { if (i > 0) return false; u.pm = 0; u.pn = pn; return true; }
    __device__ __forceinline__ void a_ready(const pg8::Unit&) const {} __device__ __forceinline__ void done(const pg8::Unit&) const {} };

__device__ __forceinline__ void transpose_item(const float* W, int ldw, const float* gain, bf16_t* WT, LAS float* scr, int item, int nblk, int lane) {
    const int kb = item / nblk, nb = item % nblk, k0 = 64 * kb, n0 = 32 * nb;
#pragma unroll 8
    for (int i = 0; i < 32; ++i) { const int kk = 2 * i + (lane >> 5); const float gk = gain ? gain[k0 + kk] : 1.0f; scr[kk * 33 + (lane & 31)] = W[(size_t)(k0 + kk) * ldw + n0 + (lane & 31)] * gk; }
    asm volatile("s_waitcnt lgkmcnt(0)" ::: "memory");
    const int c = lane & 7;
#pragma unroll
    for (int j = 0; j < 4; ++j) { const int n = (lane >> 3) + 8 * j; const LAS float* s = scr + (8 * c) * 33 + n;
        u32x4 o; o.x = pk2(s[0 * 33], s[1 * 33]); o.y = pk2(s[2 * 33], s[3 * 33]); o.z = pk2(s[4 * 33], s[5 * 33]); o.w = pk2(s[6 * 33], s[7 * 33]);
        *(u32x4*)(WT + (size_t)(n0 + n) * 1024 + k0 + 8 * c) = o; }
    asm volatile("s_waitcnt lgkmcnt(0)" ::: "memory");
}

__device__ __forceinline__ void phase0(const Params& p, LAS unsigned char* lds, bf16_t* XB) {
    const int tid = threadIdx.x, lane = tid & 63, wave = tid >> 6;
    const int gw = blockIdx.x * 8 + wave, NGW = gridDim.x * 8;
    for (int row = gw; row < MTOT; row += NGW) {
        const float* xr = (row < SEQP) ? (p.xp + (size_t)row * DM) : (p.xs + (size_t)(row - SEQP) * DM);
        f32x4 v[4]; float ss = 0.f;
#pragma unroll
        for (int i = 0; i < 4; ++i) { v[i] = *(const f32x4*)(xr + 4 * (lane + 64 * i)); ss += (v[i][0] * v[i][0] + v[i][1] * v[i][1]) + (v[i][2] * v[i][2] + v[i][3] * v[i][3]); }
        ss = wave_sum(ss);
        if (lane == 0) g_r0[row] = rsqrtf(ss * (1.0f / 1024.0f) + EPS);
#pragma unroll
        for (int i = 0; i < 4; ++i) { u32x2 w; w.x = pk2(v[i][0], v[i][1]); w.y = pk2(v[i][2], v[i][3]); *(u32x2*)(XB + (size_t)row * DM + 4 * (lane + 64 * i)) = w; }
    }
    for (int i = blockIdx.x * NTHR + tid; i < MTOT; i += gridDim.x * NTHR) { g_ss1[i] = 0.f; g_ss2[i] = 0.f; }
    if (blockIdx.x == 0 && tid < 64) { g_nrm[tid] = 0u; if (tid < 4) g_ctr[tid] = 0u; }
    if (blockIdx.x == 0) for (int i = tid; i < XCD_BAR_WORDS; i += NTHR) g_bar[i] = 0u;
    LAS float* scr = (LAS float*)(lds + wave * 8704);
    constexpr int I0 = 16 * 128, I1 = 16 * 32, NIT = I0 + 3 * I1;
    for (int it = gw; it < NIT; it += NGW) {
        int r = it;
        if (r < I0) { transpose_item(p.w_in0, 4096, p.attn_norm, g_w0t, scr, r, 128, lane); continue; } r -= I0;
        if (r < I1) { transpose_item(p.w_out0, 1024, nullptr, g_wo0t, scr, r, 32, lane); continue; } r -= I1;
        if (r < I1) { transpose_item(p.w_in1 + 1024, 2048, p.fnet_norm, g_w1t + (size_t)2048 * 1024, scr, r, 32, lane); continue; } r -= I1;
        transpose_item(p.w_out1, 1024, nullptr, g_wo1t, scr, r, 32, lane);
    }
    for (int i = blockIdx.x * NTHR + tid; i < 1024 * 256; i += gridDim.x * NTHR) {
        const int k = i >> 8, c4 = (i & 255) * 4; const f32x4 w = *(const f32x4*)(p.w_in1 + (size_t)k * 2048 + c4); const float gk = p.fnet_norm[k];
        u32x2 o; o.x = pk2(w[0] * gk, w[1] * gk); o.y = pk2(w[2] * gk, w[3] * gk); *(u32x2*)(g_ws1 + (size_t)k * 1024 + c4) = o;
    }
    for (int i = blockIdx.x * NTHR + tid; i < 256 * 128; i += gridDim.x * NTHR) {
        const int rr = i >> 7, n = i & 127, k = rr & 127, part = rr >> 7; const float th = (float)((k * n) & 127) * (6.283185307179586f / 128.0f);
        const float v = part ? sinf(th) : cosf(th); g_tab128[i] = (bf16_t)(pk2(v, 0.f) & 0xffffu);
    }
    for (int i = blockIdx.x * NTHR + tid; i < 32 * 32; i += gridDim.x * NTHR) {
        const int kk = i >> 5, j = i & 31, k1 = kk & 15, po = kk >> 4, n1 = j & 15, pi = j >> 4; const float th = (float)((k1 * n1) & 15) * (6.283185307179586f / 16.0f);
        float v; if (po == 0) v = pi ? -sinf(th) : cosf(th); else v = pi ? -cosf(th) : -sinf(th);
        g_tab16[i] = (bf16_t)(pk2(v, 0.f) & 0xffffu);
    }
}

constexpr int AT_KP = 144, AT_VP = 320, AT_K2 = 64 * AT_KP, AT_V = 2 * 64 * AT_KP, AT_STAGE = AT_V + 64 * AT_VP, AT_XP = 528;
typedef short v4i16_t __attribute__((ext_vector_type(4)));
__device__ __forceinline__ s16x4 tr_read(LAS const unsigned char* p) { return __builtin_bit_cast(s16x4, __builtin_amdgcn_ds_read_tr16_b64_v4i16((LAS v4i16_t*)p)); }
__device__ __forceinline__ bf16x8 cat8(s16x4 a, s16x4 b) { return (bf16x8){a[0], a[1], a[2], a[3], b[0], b[1], b[2], b[3]}; }
__device__ __forceinline__ bf16x8 neg8(bf16x8 a) { typedef int i32x4 __attribute__((ext_vector_type(4))); i32x4 v = __builtin_bit_cast(i32x4, a); v = v ^ (int)0x80008000; return __builtin_bit_cast(bf16x8, v); }
#define MFMA32(a, b, c) __builtin_amdgcn_mfma_f32_32x32x16_bf16((a), (b), (c), 0, 0, 0)

__device__ __forceinline__ void attn_phase(const Params& p, LAS unsigned char* lds, const bf16_t* Qb, const bf16_t* Kb, const bf16_t* Vb, const bf16_t* Zb, bf16_t* Ob, unsigned* ctr) {
    const int tid = threadIdx.x, lane = tid & 63, wave = __builtin_amdgcn_readfirstlane(tid >> 6), r32 = lane & 31, hi = lane >> 5;
    const int map = wave >> 2, qs = wave & 3;
    float lam;
    { const float a = wave_sum(p.lq1[lane] * p.lk1[lane]), b = wave_sum(p.lq2[lane] * p.lk2[lane]); lam = expf(a) - expf(b) + 0.2f; }
    const int g16 = lane >> 4, i16 = lane & 15, tq = i16 >> 2, tp = i16 & 3;
    LAS unsigned* qword = (LAS unsigned*)(lds + 3 * AT_STAGE);
    for (;;) {
        if (tid == 0) *qword = atomicAdd(ctr, 1u);
        BLK_SYNC();
        const int unit = (int)*qword;
        if (unit >= 2048) break;
        int R0s, S, h, q0;
        if (unit < 1024) { R0s = 0; S = SEQP; h = 7 - (unit >> 7); q0 = (unit & 127) * 128; }
        else { const int v = unit - 1024; h = 7 - (v >> 7); R0s = SEQP + ((v >> 4) & 7) * SEQS; S = SEQS; q0 = (v & 15) * 128; }
        const float slope2 = exp2f(-(float)(h + 1)) * LOG2E;
        const int qrow = R0s + q0 + qs * 32 + r32;
        bf16x8 qf[4];
        { const bf16_t* qp = Qb + (size_t)qrow * DM + h * 128 + map * 64 + hi * 8;
          float qq = 0.f;
#pragma unroll
          for (int st = 0; st < 4; ++st) { qf[st] = *(const bf16x8*)(qp + st * 16);
#pragma unroll
              for (int e = 0; e < 8; ++e) { const float qv = __uint_as_float(((unsigned)(unsigned short)qf[st][e]) << 16); qq = __builtin_fmaf(qv, qv, qq); } }
          qq += __shfl_xor(qq, 32);
#pragma unroll
          for (int sh = 1; sh < 32; sh <<= 1) qq = fmaxf(qq, __shfl_xor(qq, sh));
          LAS float* wst = (LAS float*)(lds + 3 * AT_STAGE + 64);
          if (lane == 0) wst[wave * 2] = qq;
        }
        const int dt0 = q0 >> 6, NTLS = S / 64;
        const float nslope2 = -slope2;
        const float qposf = (float)(q0 + qs * 32 + r32 - 4 * hi);
        float l = 0.f;
        f32x16 o[4];
#pragma unroll
        for (int db = 0; db < 4; ++db)
#pragma unroll
            for (int r = 0; r < 16; ++r) o[db][r] = 0.f;
        const int srow = tid >> 4, sch = tid & 15;
        const bf16_t* gk = Kb + (size_t)(R0s + srow) * DM + h * 128 + sch * 8;
        const ptrdiff_t vk = Vb - Kb;
        const int ldk = (sch >> 3) * AT_K2 + srow * AT_KP + (sch & 7) * 16, ldv = AT_V + srow * AT_VP + sch * 16;
#define AT_GSRC(i) (gk + ((i) >= 2 ? vk : 0) + (size_t)(((i) & 1) * 32) * DM)
#define AT_LDST(i) (((i) >= 2 ? ldv + ((i) & 1) * 32 * AT_VP : ldk + ((i) & 1) * 32 * AT_KP))
        int lbase = dt0, skipat = 0x3fffffff, ntl = 2;
#define TIDX(j) (lbase + (j) + ((lbase + (j) >= skipat) ? 2 : 0))
#pragma unroll 1
        for (int pass = 0; pass < 2; ++pass) {
        if (pass == 1) {
            float lr = l + __shfl_xor(l, 32);
#pragma unroll
            for (int sh = 1; sh < 32; sh <<= 1) lr = fminf(lr, __shfl_xor(lr, sh));
            LAS float* wst = (LAS float*)(lds + 3 * AT_STAGE + 64);
            if (lane == 0) wst[wave * 2 + 1] = lr;
            BLK_SYNC();
            float thr = -1.0e30f;
#pragma unroll
            for (int mm = 0; mm < 2; ++mm) { const int e = (2 * h + mm) * 2;
                const float kn2 = __uint_as_float(g_nrm[32 + e]) + __uint_as_float(g_nrm[32 + e + 1]);
                float qmx = 0.f, lmn = 1.0e30f;
#pragma unroll
                for (int w = 0; w < 4; ++w) { qmx = fmaxf(qmx, wst[(mm * 4 + w) * 2]); lmn = fminf(lmn, wst[(mm * 4 + w) * 2 + 1]); }
                thr = fmaxf(thr, sqrtf(qmx * kn2) * 1.02f - log2f(lmn) + 0.05f); }
            thr += 25.0f - log2f(1.0f - exp2f(-slope2));
            const float dminf = fminf(fmaxf(ceilf(thr / slope2), 1.0f), 1.0e6f); const int dmin = (int)dminf;
            int lo = q0 - dmin + 1; lo = lo < 0 ? 0 : lo; int hiK = q0 + 127 + dmin - 1; hiK = hiK > S - 1 ? S - 1 : hiK;
            int t_lo = lo >> 6, t_hi = hiK >> 6; if (t_hi > NTLS - 1) t_hi = NTLS - 1;
            lbase = t_lo; skipat = dt0; ntl = (t_hi - t_lo + 1) - 2;
        }
        if (ntl > 0) {
        u32x4 stg[4];
#pragma unroll
        for (int i = 0; i < 4; ++i) stg[i] = *(const u32x4*)(AT_GSRC(i) + (size_t)TIDX(0) * 64 * DM);
#pragma unroll
        for (int i = 0; i < 4; ++i) *(LAS u32x4*)(lds + AT_LDST(i)) = stg[i];
        if (ntl > 1) {
#pragma unroll
            for (int i = 0; i < 4; ++i) stg[i] = *(const u32x4*)(AT_GSRC(i) + (size_t)TIDX(1) * 64 * DM);
#pragma unroll
            for (int i = 0; i < 4; ++i) *(LAS u32x4*)(lds + AT_STAGE + AT_LDST(i)) = stg[i];
        }
        if (ntl > 2) {
#pragma unroll
            for (int i = 0; i < 4; ++i) stg[i] = *(const u32x4*)(AT_GSRC(i) + (size_t)TIDX(2) * 64 * DM);
        }
        __builtin_amdgcn_s_waitcnt(0x0F70);
        BLK_SYNC();
        const int koff = map * AT_K2 + r32 * AT_KP + hi * 16, voff = AT_V + (4 * hi + tq) * AT_VP + (16 * (g16 & 1) + 4 * tp) * 2;
        int soff = 0;
        for (int tt = 0; tt < ntl; ++tt) {
            const int s1off = (soff == 2 * AT_STAGE) ? 0 : soff + AT_STAGE, s2off = (s1off == 2 * AT_STAGE) ? 0 : s1off + AT_STAGE;
            f32x16 s0, s1;
#pragma unroll
            for (int r = 0; r < 16; ++r) { s0[r] = 0.f; s1[r] = 0.f; }
            bf16x8 kf0[4], kf1[4];
#pragma unroll
            for (int st = 0; st < 4; ++st) { kf0[st] = *(LAS const bf16x8*)(lds + soff + koff + st * 32); kf1[st] = *(LAS const bf16x8*)(lds + soff + koff + 32 * AT_KP + st * 32); }
#pragma unroll
            for (int st = 0; st < 4; ++st) s0 = MFMA32(kf0[st], qf[st], s0);
#pragma unroll
            for (int st = 0; st < 4; ++st) s1 = MFMA32(kf1[st], qf[st], s1);
            __builtin_amdgcn_sched_barrier(0);
            if (tt + 2 < ntl) {
#pragma unroll
                for (int i = 0; i < 4; ++i) *(LAS u32x4*)(lds + s2off + AT_LDST(i)) = stg[i];
            }
            if (tt + 3 < ntl) {
#pragma unroll
                for (int i = 0; i < 4; ++i) stg[i] = *(const u32x4*)(AT_GSRC(i) + (size_t)TIDX(tt + 3) * 64 * DM);
            }
            LAS const unsigned char* vbase = lds + soff + voff;
            bf16x8 vf[2][4];
#pragma unroll
            for (int ks = 0; ks < 4; ++ks) { LAS const unsigned char* a = vbase + (16 * ks) * AT_VP; vf[0][ks] = cat8(tr_read(a), tr_read(a + 8 * AT_VP)); }
            __builtin_amdgcn_sched_barrier(0);
            const float d0 = qposf - (float)(TIDX(tt) * 64);
            float rs = 0.f;
#pragma unroll
            for (int r = 0; r < 16; ++r) { const float c = (float)((r & 3) + 8 * (r >> 2));
                s0[r] = __builtin_amdgcn_exp2f(__builtin_fmaf(nslope2, fabsf(d0 - c), s0[r]));
                s1[r] = __builtin_amdgcn_exp2f(__builtin_fmaf(nslope2, fabsf(d0 - (32.0f + c)), s1[r]));
                rs += s0[r] + s1[r]; }
            l += rs;
            bf16x8 pf[4];
#pragma unroll
            for (int s = 0; s < 2; ++s) {
                u32x4 w0, w1;
                w0.x = pk2(s0[8 * s + 0], s0[8 * s + 1]); w0.y = pk2(s0[8 * s + 2], s0[8 * s + 3]); w0.z = pk2(s0[8 * s + 4], s0[8 * s + 5]); w0.w = pk2(s0[8 * s + 6], s0[8 * s + 7]);
                w1.x = pk2(s1[8 * s + 0], s1[8 * s + 1]); w1.y = pk2(s1[8 * s + 2], s1[8 * s + 3]); w1.z = pk2(s1[8 * s + 4], s1[8 * s + 5]); w1.w = pk2(s1[8 * s + 6], s1[8 * s + 7]);
                pf[s] = __builtin_bit_cast(bf16x8, w0); pf[2 + s] = __builtin_bit_cast(bf16x8, w1);
            }
            __builtin_amdgcn_sched_barrier(0);
#pragma unroll
            for (int db = 0; db < 4; ++db) {
                if (db < 3) {
#pragma unroll
                    for (int ks = 0; ks < 4; ++ks) { LAS const unsigned char* a = vbase + (16 * ks) * AT_VP + (db + 1) * 64; vf[(db + 1) & 1][ks] = cat8(tr_read(a), tr_read(a + 8 * AT_VP)); }
                }
#pragma unroll
                for (int ks = 0; ks < 4; ++ks) o[db] = MFMA32(vf[db & 1][ks], pf[ks], o[db]);
                __builtin_amdgcn_sched_barrier(0);
            }
            BLK_SYNC();
            soff = s1off;
        }
        }
        }
#undef TIDX
#undef AT_GSRC
#undef AT_LDST
        l += __shfl_xor(l, 32);
        const float inv = 1.0f / l;
#pragma unroll
        for (int db = 0; db < 4; ++db)
#pragma unroll
            for (int r = 0; r < 16; ++r) o[db][r] *= inv;
        LAS unsigned char* xq = lds + (qs * 32 + r32) * AT_XP;
        if (map == 1) {
#pragma unroll
            for (int db = 0; db < 4; ++db)
#pragma unroll
                for (int rg = 0; rg < 4; ++rg) { const int d = 32 * db + 8 * rg + 4 * hi;
                    *(LAS f32x4*)(xq + d * 4) = (f32x4){o[db][4 * rg], o[db][4 * rg + 1], o[db][4 * rg + 2], o[db][4 * rg + 3]}; }
        }
        BLK_SYNC();
        if (map == 0) {
            float ss = 0.f;
#pragma unroll
            for (int db = 0; db < 4; ++db)
#pragma unroll
                for (int rg = 0; rg < 4; ++rg) { const int d = 32 * db + 8 * rg + 4 * hi; const f32x4 o2 = *(LAS const f32x4*)(xq + d * 4);
#pragma unroll
                    for (int e = 0; e < 4; ++e) { const float v = o[db][4 * rg + e] - lam * o2[e]; o[db][4 * rg + e] = v; ss += v * v; } }
            ss += __shfl_xor(ss, 32);
            const float rn = rsqrtf(ss * (1.0f / 128.0f) + SUBLN_EPS) * 0.8f;
            const bf16_t* zp = Zb + (size_t)qrow * DM + h * 128; bf16_t* op = Ob + (size_t)qrow * DM + h * 128;
#pragma unroll
            for (int db = 0; db < 4; ++db)
#pragma unroll
                for (int rg = 0; rg < 4; ++rg) { const int d = 32 * db + 8 * rg + 4 * hi;
                    const f32x4 gg = *(const f32x4*)(p.subln + d); const u32x2 zz = *(const u32x2*)(zp + d);
                    const float v0 = o[db][4 * rg] * rn * gg[0] * silu_f(bf_lo(zz.x)), v1 = o[db][4 * rg + 1] * rn * gg[1] * silu_f(bf_hi(zz.x));
                    const float v2 = o[db][4 * rg + 2] * rn * gg[2] * silu_f(bf_lo(zz.y)), v3 = o[db][4 * rg + 3] * rn * gg[3] * silu_f(bf_hi(zz.y));
                    u32x2 w; w.x = pk2(v0, v1); w.y = pk2(v2, v3); *(u32x2*)(op + d) = w; }
        }
        BLK_SYNC();
    }
}

constexpr int FT_P = 320;
template <int MODE> __device__ __forceinline__ void fft_rows(int unit, int& rbase, int& cc, int& a0, int& a1, int& a2) {
    cc = unit & 7;
    if (MODE == 0) { a0 = unit >> 3; rbase = 0; a1 = 0; a2 = 0; }
    else if (MODE == 1) { a0 = unit >> 7; a1 = (unit >> 3) & 15; rbase = SEQP + a0 * SEQS; a2 = 0; }
    else { if (unit < 1024) { rbase = 0; a0 = unit >> 3; a1 = 128; } else { const int v = unit - 1024; rbase = SEQP + (v >> 7) * SEQS; a0 = (v >> 3) & 15; a1 = 16; } a2 = 0; }
}
template <int MODE> __device__ __forceinline__ const bf16_t* fft_src(const bf16_t* AB, int rbase, int cc, int a0, int a1, int rho, int ch16) {
    int grow, part;
    if (MODE == 0) { part = rho >> 7; grow = (rho & 127) * 128 + a0; }
    else if (MODE == 1) { part = (rho >> 4) & 1; grow = rbase + (rho & 15) * 128 + a1 * 8 + (rho >> 5); }
    else { part = rho >> 7; grow = rbase + a0 * 128 + (rho & 127); }
    return AB + (size_t)grow * 2048 + part * 1024 + cc * 128 + ch16 * 8;
}

template <int MODE> __device__ __forceinline__ void fft_pass(LAS unsigned char* lds, bf16_t* AB, const bf16_t* Z1, bf16_t* FG, int nunits, bf16_t* OUT, const int omask) {
    const int tid = threadIdx.x, lane = tid & 63, wave = __builtin_amdgcn_readfirstlane(tid >> 6), r32 = lane & 31, hi = lane >> 5;
    const int g16 = lane >> 4, i16 = lane & 15, tq = i16 >> 2, tp = i16 & 3;
    const int kb = wave & 3, cbh = wave >> 2;
    bf16x8 Cf[8], Sf[8];
    if (MODE != 1) {
        const int k = 32 * kb + r32;
#pragma unroll
        for (int s = 0; s < 8; ++s) { Cf[s] = *(const bf16x8*)(g_tab128 + k * 128 + 16 * s + 8 * hi); Sf[s] = *(const bf16x8*)(g_tab128 + (128 + k) * 128 + 16 * s + 8 * hi); }
    } else {
#pragma unroll
        for (int s = 0; s < 2; ++s) Cf[s] = *(const bf16x8*)(g_tab16 + r32 * 32 + 16 * s + 8 * hi);
    }
    int unit = blockIdx.x;
    if (unit >= nunits) return;
    int rbase, cc, a0, a1, a2;
    fft_rows<MODE>(unit, rbase, cc, a0, a1, a2);
    u32x4 stg[8];
#pragma unroll
    for (int i = 0; i < 8; ++i) { const int c = tid + 512 * i; stg[i] = *(const u32x4*)fft_src<MODE>(AB, rbase, cc, a0, a1, c >> 4, c & 15); }
    __builtin_amdgcn_s_waitcnt(0x0F70);
    for (;;) {
#pragma unroll
        for (int i = 0; i < 8; ++i) { const int c = tid + 512 * i; *(LAS u32x4*)(lds + (c >> 4) * FT_P + (c & 15) * 16) = stg[i]; }
        BLK_SYNC();
        const int nunit = unit + gridDim.x; const bool has_next = nunit < nunits;
        int nrbase = 0, ncc = 0, na0 = 0, na1 = 0, na2 = 0;
        if (has_next) { fft_rows<MODE>(nunit, nrbase, ncc, na0, na1, na2);
#pragma unroll
            for (int i = 0; i < 8; ++i) { const int c = tid + 512 * i; stg[i] = *(const u32x4*)fft_src<MODE>(AB, nrbase, ncc, na0, na1, c >> 4, c & 15); } }
        if (MODE == 0) {
            const int k1 = 32 * kb + r32, n2 = a0;
            const float ph = (float)((k1 * n2) & 16383) * (1.0f / 16384.0f); const float tc = __builtin_amdgcn_cosf(ph), ts = __builtin_amdgcn_sinf(ph);
#pragma unroll 1
            for (int cbi = 0; cbi < 2; ++cbi) { const int cb = 2 * cbh + cbi;
                LAS const unsigned char* ab = lds + (8 * hi + tq) * FT_P + (32 * cb + 16 * (g16 & 1) + 4 * tp) * 2;
                f32x16 yr, yi;
#pragma unroll
                for (int r = 0; r < 16; ++r) { yr[r] = 0.f; yi[r] = 0.f; }
#pragma unroll
                for (int s = 0; s < 8; ++s) {
                    const bf16x8 af = cat8(tr_read(ab + (16 * s) * FT_P), tr_read(ab + (16 * s + 4) * FT_P));
                    const bf16x8 bf = cat8(tr_read(ab + (128 + 16 * s) * FT_P), tr_read(ab + (128 + 16 * s + 4) * FT_P));
                    const bf16x8 naf = neg8(af), nbf = neg8(bf);
                    yr = MFMA32(af, Cf[s], yr); yr = MFMA32(nbf, Sf[s], yr);
                    yi = MFMA32(naf, Sf[s], yi); yi = MFMA32(nbf, Cf[s], yi);
                }
                bf16_t* orow = OUT + (size_t)((k1 * 128 + n2) & omask) * 2048 + cc * 128 + cb * 32 + 4 * hi;
#pragma unroll
                for (int rg = 0; rg < 4; ++rg) { float a[4], b[4];
#pragma unroll
                    for (int e = 0; e < 4; ++e) { const float vr = yr[4 * rg + e], vi = yi[4 * rg + e]; a[e] = vr * tc + vi * ts; b[e] = vi * tc - vr * ts; }
                    u32x2 w0, w1; w0.x = pk2(a[0], a[1]); w0.y = pk2(a[2], a[3]); w1.x = pk2(b[0], b[1]); w1.y = pk2(b[2], b[3]);
                    *(u32x2*)(orow + 8 * rg) = w0; *(u32x2*)(orow + 1024 + 8 * rg) = w1; }
            }
        } else if (MODE == 1) {
            const int k1 = r32 & 15, po = r32 >> 4, n2 = a1 * 8 + wave;
            const float ph = (float)((k1 * n2) & 2047) * (1.0f / 2048.0f); const float tc = __builtin_amdgcn_cosf(ph); float ts = __builtin_amdgcn_sinf(ph); if (po) ts = -ts;
#pragma unroll 1
            for (int cb = 0; cb < 4; ++cb) {
                LAS const unsigned char* ab = lds + (wave * 32 + 8 * hi + tq) * FT_P + (32 * cb + 16 * (g16 & 1) + 4 * tp) * 2;
                f32x16 y;
#pragma unroll
                for (int r = 0; r < 16; ++r) y[r] = 0.f;
                const bf16x8 f0 = cat8(tr_read(ab), tr_read(ab + 4 * FT_P)), f1 = cat8(tr_read(ab + 16 * FT_P), tr_read(ab + 20 * FT_P));
                y = MFMA32(f0, Cf[0], y); y = MFMA32(f1, Cf[1], y);
                bf16_t* orow = OUT + (size_t)((rbase + k1 * 128 + n2) & omask) * 2048 + po * 1024 + cc * 128 + cb * 32 + 4 * hi;
#pragma unroll
                for (int rg = 0; rg < 4; ++rg) { float a[4];
#pragma unroll
                    for (int e = 0; e < 4; ++e) { const float own = y[4 * rg + e], oth = __shfl_xor(own, 16); a[e] = own * tc + oth * ts; }
                    u32x2 w0; w0.x = pk2(a[0], a[1]); w0.y = pk2(a[2], a[3]); *(u32x2*)(orow + 8 * rg) = w0; }
            }
        } else {
            const int k2 = 32 * kb + r32, k1 = a0, N1 = a1; const float nrm = (N1 == 128) ? 6.905339660024879e-4f : 1.953125e-3f;
            const size_t orow_i = (size_t)(rbase + k1 + N1 * k2);
#pragma unroll 1
            for (int cbi = 0; cbi < 2; ++cbi) { const int cb = 2 * cbh + cbi;
                LAS const unsigned char* ab = lds + (8 * hi + tq) * FT_P + (32 * cb + 16 * (g16 & 1) + 4 * tp) * 2;
                f32x16 y;
#pragma unroll
                for (int r = 0; r < 16; ++r) y[r] = 0.f;
#pragma unroll
                for (int s = 0; s < 8; ++s) {
                    const bf16x8 af = cat8(tr_read(ab + (16 * s) * FT_P), tr_read(ab + (16 * s + 4) * FT_P));
                    const bf16x8 bf = cat8(tr_read(ab + (128 + 16 * s) * FT_P), tr_read(ab + (128 + 16 * s + 4) * FT_P));
                    y = MFMA32(af, Cf[s], y); y = MFMA32(bf, Sf[s], y);
                }
                const bf16_t* zrow = Z1 + orow_i * DM + cc * 128 + cb * 32 + 4 * hi; bf16_t* orow = FG + orow_i * DM + cc * 128 + cb * 32 + 4 * hi;
#pragma unroll
                for (int rg = 0; rg < 4; ++rg) { const u32x2 zz = *(const u32x2*)(zrow + 8 * rg);
                    const float v0 = y[4 * rg] * nrm * silu_f(bf_lo(zz.x)), v1 = y[4 * rg + 1] * nrm * silu_f(bf_hi(zz.x));
                    const float v2 = y[4 * rg + 2] * nrm * silu_f(bf_lo(zz.y)), v3 = y[4 * rg + 3] * nrm * silu_f(bf_hi(zz.y));
                    u32x2 w; w.x = pk2(v0, v1); w.y = pk2(v2, v3); *(u32x2*)(orow + 8 * rg) = w; }
            }
        }
        BLK_SYNC();
        if (!has_next) break;
        unit = nunit; rbase = nrbase; cc = ncc; a0 = na0; a1 = na1; a2 = na2;
    }
}

#ifndef PROBE
#define PROBE 0
#endif
#ifndef PHM
#define PHM 0xffff
#endif
__global__ void __launch_bounds__(NTHR, 2) fwd_kernel(Params p) {
    extern __shared__ __attribute__((aligned(16))) unsigned char lds_raw[];
    LAS unsigned char* lds = (LAS unsigned char*)lds_raw;
    cg::grid_group grid = cg::this_grid();
    if (threadIdx.x < 4) ((LAS unsigned*)(lds + XB_LDS_OFF))[threadIdx.x] = 0u;
    __syncthreads();
    const size_t REG = (size_t)MTOT * DM;
    bf16_t* R0 = (bf16_t*)p.ws; bf16_t* R1 = R0 + REG; bf16_t* R2 = R1 + REG; bf16_t* R3 = R2 + REG;
    bf16_t* XB = (bf16_t*)p.out;

    if (PHM & 1) phase0(p, lds, XB);
#if PROBE & 4
    phase0(p, lds, XB);
#endif

    grid.sync();
    const XcdBarrier xbar = xcd_barrier_post(g_bar, (volatile LAS unsigned*)(lds + XB_LDS_OFF));
#if PROBE & 16
    xcd_barrier(xbar); xcd_barrier(xbar); xcd_barrier(xbar); xcd_barrier(xbar); xcd_barrier(xbar); xcd_barrier(xbar); xcd_barrier(xbar); xcd_barrier(xbar);
#endif
    if (PHM & 2) {
        pg8::Gemm gm{XB, g_w0t, MTOT, 4096, 1024, 1024, 1024}; pg8::StaticOrder S; S.init(MTOT, 4096, gridDim.x, blockIdx.x);
        EpiRowBf16 E{R0, R1, R2, R3, DM, DM, 1024, g_r0, 0, QSCALE, g_nrm};
        pg8::gemm_phase<EpiRowBf16, pg8::StaticOrder, true, true>(lds, gm, S, E);
#if PROBE & 1
        pg8::gemm_phase<EpiRowBf16, pg8::StaticOrder, true, true>(lds, gm, S, E);
#endif
    }
    xcd_barrier(xbar);
    if ((PHM & 512) && blockIdx.x < 32) {
        const int fu = blockIdx.x, g = fu >> 2; pg8::Gemm gm{g_tab128, g_ws1 + g * 128, 256, 1024, 128, 128, 1024}; OneUnit S{fu & 3}; EpiFold E{g_w1t, g};
        pg8::gemm_phase<EpiFold, OneUnit, false, true>(lds, gm, S, E);
    }
#if PROBE & 2
    attn_phase(p, lds, R0, R1, R2, R3, (bf16_t*)p.out + REG, &g_ctr[1]);
#endif
    if (PHM & 4) attn_phase(p, lds, R0, R1, R2, R3, R0, &g_ctr[0]);
    xcd_barrier(xbar);
    if (PHM & 8) {
        pg8::Gemm gm{R0, g_wo0t, MTOT, 1024, 1024, 1024, 1024}; pg8::StaticOrder S; S.init(MTOT, 1024, gridDim.x, blockIdx.x);
        EpiResid E{p.xp, p.xs, p.out, R3, g_ss1};
        pg8::gemm_phase<EpiResid, pg8::StaticOrder, true, true>(lds, gm, S, E);
#if PROBE & 1
        { EpiResid E2{p.xp, p.xs, p.out, R3, g_r0}; pg8::gemm_phase<EpiResid, pg8::StaticOrder, true, true>(lds, gm, S, E2); }
#endif
    }
    xcd_barrier(xbar);
    if (PHM & 16) {
        pg8::Gemm gm{R3, g_w1t, MTOT, 3072, 1024, 1024, 1024}; pg8::StaticOrder S; S.init(MTOT, 3072, gridDim.x, blockIdx.x);
        EpiRowBf16 E{R1, R0, R0, R0, 2048, DM, 2048, g_ss1, 1, 1.0f, nullptr};
        pg8::gemm_phase<EpiRowBf16, pg8::StaticOrder, true, true>(lds, gm, S, E);
#if PROBE & 1
        pg8::gemm_phase<EpiRowBf16, pg8::StaticOrder, true, true>(lds, gm, S, E);
#endif
    }
    xcd_barrier(xbar);
#if PROBE & 64
    fft_pass<0>(lds, R1, nullptr, nullptr, 1024, R3, 16383);
    fft_pass<1>(lds, R1, nullptr, nullptr, 1024, R3, 16383);
#endif
    if (PHM & 32) fft_pass<0>(lds, R1, nullptr, nullptr, 1024, R1, 0x7fffffff);
    if (PHM & 64) fft_pass<1>(lds, R1, nullptr, nullptr, 1024, R1, 0x7fffffff);
    xcd_barrier(xbar);
    if (PHM & 128) fft_pass<2>(lds, R1, R0, R3, 2048, nullptr, 0);
#if PROBE & 8
    fft_pass<2>(lds, R1, R0, R3, 2048, nullptr, 0);
#endif
    xcd_barrier(xbar);
    if (PHM & 256) {
        pg8::Gemm gm{R3, g_wo1t, MTOT, 1024, 1024, 1024, 1024}; pg8::StaticOrder S; S.init(MTOT, 1024, gridDim.x, blockIdx.x);
        EpiResid E{p.out, p.out + (size_t)SEQP * DM, p.out, nullptr, g_ss2};
        pg8::gemm_phase<EpiResid, pg8::StaticOrder, true, true>(lds, gm, S, E);
    }
    xcd_barrier(xbar);
    const int lane = threadIdx.x & 63, wave = threadIdx.x >> 6;
    for (int row = blockIdx.x * 8 + wave; row < MTOT; row += gridDim.x * 8) {
        const float rs = rsqrtf(g_ss2[row] * (1.0f / 1024.0f) + EPS); float* orow = p.out + (size_t)row * DM;
#pragma unroll
        for (int i = 0; i < 4; ++i) { const int c = 4 * (lane + 64 * i); f32x4 v = *(const f32x4*)(orow + c); const f32x4 gg = *(const f32x4*)(p.final_norm + c);
            v[0] *= rs * gg[0]; v[1] *= rs * gg[1]; v[2] *= rs * gg[2]; v[3] *= rs * gg[3]; *(f32x4*)(orow + c) = v; }
    }
}

extern "C" void kernel_launch(void* const* d_in, const int* in_sizes, int n_in, void* d_out, int out_size, void* d_ws, size_t ws_size, hipStream_t stream) {
    static int grid = 0;
    if (grid == 0) {
        int dev = 0, cus = 0, per_cu = 0;
        if (n_in != 14 || ws_size < (size_t)4 * MTOT * DM * 2) { fprintf(stderr, "kernel_launch: unexpected problem shape (n_in %d, ws %zu)\n", n_in, ws_size); grid = -1; return; }
        hipGetDevice(&dev); hipDeviceGetAttribute(&cus, hipDeviceAttributeMultiprocessorCount, dev);
        if (hipFuncSetAttribute((const void*)fwd_kernel, hipFuncAttributeMaxDynamicSharedMemorySize, LDS_TOTAL) != hipSuccess) { fprintf(stderr, "kernel_launch: hipFuncSetAttribute failed\n"); grid = -1; return; }
        if (hipOccupancyMaxActiveBlocksPerMultiprocessor(&per_cu, (const void*)fwd_kernel, NTHR, LDS_TOTAL) != hipSuccess || per_cu < 1) { fprintf(stderr, "kernel_launch: occupancy query says %d blocks per CU\n", per_cu); per_cu = 1; }
        (void)hipGetLastError();
        grid = cus * 1;
    }
    if (grid < 0) return;
    Params p{};
    p.xp = (const float*)d_in[0]; p.xs = (const float*)d_in[1]; p.attn_norm = (const float*)d_in[2]; p.w_in0 = (const float*)d_in[3];
    p.lq1 = (const float*)d_in[4]; p.lk1 = (const float*)d_in[5]; p.lq2 = (const float*)d_in[6]; p.lk2 = (const float*)d_in[7];
    p.subln = (const float*)d_in[8]; p.w_out0 = (const float*)d_in[9]; p.fnet_norm = (const float*)d_in[10]; p.w_in1 = (const float*)d_in[11];
    p.w_out1 = (const float*)d_in[12]; p.final_norm = (const float*)d_in[13];
    p.out = (float*)d_out; p.ws = (unsigned char*)d_ws;
    void* args[] = {&p};
    const hipError_t e = hipLaunchCooperativeKernel((const void*)fwd_kernel, dim3(grid), dim3(NTHR), args, LDS_TOTAL, stream);
    if (e != hipSuccess) fprintf(stderr, "kernel_launch: cooperative launch failed: %s (grid %d)\n", hipGetErrorString(e), grid);
}
```

```cpp
#include <hip/hip_runtime.h>
#include <hip/hip_cooperative_groups.h>
#include <cstdio>
#include <cstdint>
namespace cg = cooperative_groups;
namespace pg8 {
#define PG8_LAS __attribute__((address_space(3)))
typedef unsigned short bf16_t;
typedef short bf16x8 __attribute__((ext_vector_type(8)));
typedef float f32x4 __attribute__((ext_vector_type(4)));
typedef unsigned u32x4 __attribute__((ext_vector_type(4)));
constexpr int BM = 256, BK = 64, HALF = 128, HTB = HALF * BK * 2  , STAGE_BYTES = 8 * HTB, NXCD = 8, WGM = 8;

__host__ __device__ __forceinline__ int lds_byte(int r, int c) { const int st = (r >> 4) * 2 + (c >> 5), rr = r & 15, cc = c & 31, ob = rr * 64 + cc * 2; return st * 1024 + (ob ^ (((ob >> 9) & 1) << 5)); }
__host__ __device__ __forceinline__ void stage_rc(int b, int& R, int& C) { const int st = b / 1024, sb = b % 1024, swz = sb ^ (((sb >> 9) & 1) << 5); R = (st >> 1) * 16 + swz / 64; C = (st & 1) * 32 + (swz % 64) / 2; }
__host__ __device__ __forceinline__ int perm32(int rho) { const int n = rho >> 4, i = rho & 15; return 8 * (i >> 2) + 4 * n + (i & 3); }

struct Unit { int pm, pn; };
struct Gemm { const bf16_t* A; const bf16_t* Bt; int M, N, K, lda, ldb; };

struct StaticOrder {
    int nM, nN, nwg, G, c;
    __host__ __device__ void init(int M, int N, int G_, int c_) { nM = M / BM; nN = N / BM; nwg = nM * nN; G = G_; c = c_; }
    __host__ __device__ bool next(int i, Unit& u) const {
        const long L = (long)i * G + c; if (L >= nwg) return false;
        int wgid = (int)L; { const int q = nwg / NXCD, r = nwg % NXCD, xcd = wgid % NXCD, off = wgid / NXCD; wgid = (xcd < r ? xcd * (q + 1) : r * (q + 1) + (xcd - r) * q) + off; }
        const int nig = WGM * nN, gid = wgid / nig, fm = gid * WGM, gsz = (nM - fm) < WGM ? (nM - fm) : WGM;
        u.pm = fm + ((wgid % nig) % gsz); u.pn = (wgid % nig) / gsz; return true;
    }
    __device__ __forceinline__ void a_ready(const Unit&) const {}
    __device__ __forceinline__ void done(const Unit&) const {}
};
template <class Epi, class Sched, bool ALIGN_EPI = false, bool SP2 = false>
__device__ __forceinline__ void gemm_phase(PG8_LAS unsigned char* lds, const Gemm g, const Sched& S, const Epi& E) {
    const int tid = threadIdx.x, wid = __builtin_amdgcn_readfirstlane(tid >> 6), lane = tid & 63, wr = wid >> 2, wc = wid & 3, fr = lane & 15, fq = lane >> 4;
    const int K = g.K, nt = K / BK;
    unsigned voffA[2], voffB[2];
#pragma unroll
    for (int i = 0; i < 2; ++i) { int R, C; stage_rc(tid * 16 + i * 8192, R, C); const int Rb = Epi::PERM ? ((R & ~31) + perm32(R & 31)) : R;
        voffA[i] = (unsigned)(R * g.lda + C) * 2u; voffB[i] = (unsigned)(Rb * g.ldb + C) * 2u; }
    const size_t kstep = (size_t)(BK * 2);
    const size_t hstepA = (size_t)HALF * g.lda * 2, hstepB = (size_t)HALF * g.ldb * 2;
    const size_t tstepA = 2 * hstepA, tstepB = 2 * hstepB;
    const unsigned ldsw = (unsigned)wid * 1024u;
    const int aoff = lds_byte(wr * 64 + fr, fq * 8), boff = lds_byte(wc * 32 + fr, fq * 8);
#define PG8_SA(b, h) (((b) * 2 + (h)) * HTB)
#define PG8_SB(b, h) ((4 + (b) * 2 + (h)) * HTB)
#define PG8_STAGE(bufoff, gbase, voff) do { _Pragma("unroll") for (int _i = 0; _i < 2; ++_i) \
        __builtin_amdgcn_global_load_lds((const unsigned*)((const char*)(gbase) + (voff)[_i]), (PG8_LAS unsigned*)(lds + (bufoff) + ldsw + _i * 8192), 16, 0, 0); } while (0)
#define PG8_LDA(dst, b, h) do { _Pragma("unroll") for (int m = 0; m < 4; ++m) _Pragma("unroll") for (int k = 0; k < 2; ++k) dst[m][k] = *(const PG8_LAS bf16x8*)(lds + PG8_SA(b, h) + aoff + m * 2048 + k * 1024); } while (0)
#define PG8_LDB(dst, b, h) do { _Pragma("unroll") for (int n = 0; n < 2; ++n) _Pragma("unroll") for (int k = 0; k < 2; ++k) dst[n][k] = *(const PG8_LAS bf16x8*)(lds + PG8_SB(b, h) + boff + n * 2048 + k * 1024); } while (0)
#define PG8_MMA(ai, bj, At, Bt) do { __builtin_amdgcn_s_setprio(1); _Pragma("unroll") for (int m = 0; m < 4; ++m) _Pragma("unroll") for (int n = 0; n < 2; ++n) _Pragma("unroll") for (int k = 0; k < 2; ++k) \
        acc[ai][bj][m][n] = __builtin_amdgcn_mfma_f32_16x16x32_bf16(Bt[n][k], At[m][k], acc[ai][bj][m][n], 0, 0, 0); __builtin_amdgcn_s_setprio(0); } while (0)
#define PG8_WAIT_V(n) asm volatile("s_waitcnt vmcnt(" #n ")" ::: "memory")
#define PG8_WAIT_L(n) asm volatile("s_waitcnt lgkmcnt(" #n ")" ::: "memory")
#define PG8_BAR __builtin_amdgcn_s_barrier()
#define PG8_SCHED __builtin_amdgcn_sched_barrier(0)
    Unit cur, nxt; int ui = 0;
    if (!S.next(0, cur)) return;
    f32x4 acc[2][2][4][2];
#pragma unroll
    for (int a = 0; a < 2; ++a)
#pragma unroll
        for (int b = 0; b < 2; ++b)
#pragma unroll
            for (int m = 0; m < 4; ++m)
#pragma unroll
                for (int n = 0; n < 2; ++n) acc[a][b][m][n] = (f32x4){0.f, 0.f, 0.f, 0.f};
    bf16x8 At[4][2], B0[2][2], B1[2][2];
    const char* cA = (const char*)g.A + (size_t)cur.pm * tstepA; const char* cB = (const char*)g.Bt + (size_t)cur.pn * tstepB;
    S.a_ready(cur);
    if constexpr (SP2) {
        PG8_STAGE(PG8_SB(0, 0), cB, voffB); PG8_STAGE(PG8_SB(0, 1), cB + hstepB, voffB); PG8_STAGE(PG8_SA(0, 0), cA, voffA); PG8_STAGE(PG8_SA(0, 1), cA + hstepA, voffA);
        if (wr == 1) PG8_BAR;
        PG8_WAIT_V(2); PG8_BAR;
        PG8_STAGE(PG8_SB(1, 0), cB + kstep, voffB); PG8_STAGE(PG8_SA(1, 0), cA + kstep, voffA); PG8_STAGE(PG8_SB(1, 1), cB + hstepB + kstep, voffB);
        PG8_WAIT_V(6); PG8_BAR;
    } else {
        PG8_STAGE(PG8_SB(0, 0), cB, voffB); PG8_STAGE(PG8_SA(0, 0), cA, voffA); PG8_STAGE(PG8_SB(0, 1), cB + hstepB, voffB); PG8_STAGE(PG8_SA(0, 1), cA + hstepA, voffA);
        if (wr == 1) PG8_BAR;
        PG8_WAIT_V(4); PG8_BAR;
        PG8_STAGE(PG8_SB(1, 0), cB + kstep, voffB); PG8_STAGE(PG8_SA(1, 0), cA + kstep, voffA); PG8_STAGE(PG8_SB(1, 1), cB + hstepB + kstep, voffB);
        PG8_WAIT_V(6); PG8_BAR;
    }
    for (;;) {
        const bool has_next = S.next(ui + 1, nxt);
        const char* nA = has_next ? (const char*)g.A + (size_t)nxt.pm * tstepA : cA; const char* nB = has_next ? (const char*)g.Bt + (size_t)nxt.pn * tstepB : cB;
        for (int t = 0; t < nt; t += 2) {
            const bool last = (t == nt - 2);
            const char* a1 = cA + (size_t)(t + 1) * kstep;
            const char* a2 = last ? nA : cA + (size_t)(t + 2) * kstep; const char* b2 = last ? nB : cB + (size_t)(t + 2) * kstep;
            const char* a3 = a2 + kstep; const char* b3 = b2 + kstep;
            if (last && has_next) S.a_ready(nxt);
            if constexpr (SP2) {
            PG8_LDB(B0, 0, 0); PG8_LDB(B1, 0, 1); PG8_SCHED; PG8_LDA(At, 0, 0); PG8_STAGE(PG8_SA(1, 1), a1 + hstepA, voffA);
            PG8_WAIT_V(8); PG8_WAIT_L(0); PG8_BAR; PG8_MMA(0, 0, At, B0); PG8_MMA(0, 1, At, B1); PG8_BAR; PG8_SCHED;
            PG8_LDA(At, 0, 1); PG8_STAGE(PG8_SB(0, 0), b2, voffB); PG8_STAGE(PG8_SB(0, 1), b2 + hstepB, voffB); PG8_STAGE(PG8_SA(0, 0), a2, voffA);
            PG8_WAIT_V(8); PG8_WAIT_L(0); PG8_BAR; PG8_MMA(1, 0, At, B0); PG8_MMA(1, 1, At, B1); PG8_BAR; PG8_SCHED;
            PG8_LDB(B0, 1, 0); PG8_LDB(B1, 1, 1); PG8_SCHED; PG8_LDA(At, 1, 0); PG8_STAGE(PG8_SA(0, 1), a2 + hstepA, voffA);
            PG8_WAIT_V(8); PG8_WAIT_L(0); PG8_BAR; PG8_MMA(0, 0, At, B0); PG8_MMA(0, 1, At, B1); PG8_BAR; PG8_SCHED;
            PG8_LDA(At, 1, 1); PG8_STAGE(PG8_SB(1, 0), b3, voffB); PG8_STAGE(PG8_SB(1, 1), b3 + hstepB, voffB); PG8_STAGE(PG8_SA(1, 0), a3, voffA);
            PG8_WAIT_V(8); PG8_WAIT_L(0); PG8_BAR; PG8_MMA(1, 0, At, B0); PG8_MMA(1, 1, At, B1); PG8_BAR; PG8_SCHED;
            } else {
            PG8_LDB(B0, 0, 0); PG8_SCHED; PG8_LDA(At, 0, 0); PG8_STAGE(PG8_SA(1, 1), a1 + hstepA, voffA);
            PG8_WAIT_L(8); PG8_BAR; PG8_WAIT_L(0); PG8_MMA(0, 0, At, B0); PG8_BAR; PG8_SCHED;
            PG8_LDB(B1, 0, 1); PG8_STAGE(PG8_SB(0, 0), b2, voffB);
            PG8_BAR; PG8_WAIT_L(0); PG8_MMA(0, 1, At, B1); PG8_BAR;
            PG8_LDA(At, 0, 1); PG8_STAGE(PG8_SA(0, 0), a2, voffA);
            PG8_BAR; PG8_WAIT_L(0); PG8_MMA(1, 0, At, B0); PG8_BAR; PG8_SCHED;
            PG8_STAGE(PG8_SB(0, 1), b2 + hstepB, voffB);
            PG8_WAIT_V(6); PG8_BAR; PG8_MMA(1, 1, At, B1); PG8_BAR;
            PG8_LDB(B0, 1, 0); PG8_SCHED; PG8_LDA(At, 1, 0); PG8_STAGE(PG8_SA(0, 1), a2 + hstepA, voffA);
            PG8_WAIT_L(8); PG8_BAR; PG8_WAIT_L(0); PG8_MMA(0, 0, At, B0); PG8_BAR; PG8_SCHED;
            PG8_LDB(B1, 1, 1); PG8_STAGE(PG8_SB(1, 0), b3, voffB);
            PG8_BAR; PG8_WAIT_L(0); PG8_MMA(0, 1, At, B1); PG8_BAR;
            PG8_LDA(At, 1, 1); PG8_STAGE(PG8_SA(1, 0), a3, voffA);
            PG8_BAR; PG8_WAIT_L(0); PG8_MMA(1, 0, At, B0); PG8_BAR; PG8_SCHED;
            PG8_STAGE(PG8_SB(1, 1), b3 + hstepB, voffB);
            PG8_WAIT_V(6); PG8_BAR; PG8_MMA(1, 1, At, B1); PG8_BAR;
            }
        }
        if constexpr (ALIGN_EPI) { if (wr == 0) PG8_BAR; }
        if constexpr (!Epi::AFTER_DRAIN) { E(acc, cur, wr, wc, fr, fq); S.done(cur); }
        if (!has_next) break;
#pragma unroll
        for (int a = 0; a < 2; ++a)
#pragma unroll
            for (int b = 0; b < 2; ++b)
#pragma unroll
                for (int m = 0; m < 4; ++m)
#pragma unroll
                    for (int n = 0; n < 2; ++n) acc[a][b][m][n] = (f32x4){0.f, 0.f, 0.f, 0.f};
        cur = nxt; cA = nA; cB = nB; ++ui;
        if constexpr (ALIGN_EPI) { if (wr == 1) PG8_BAR; }
    }
    PG8_WAIT_V(0);
    if constexpr (!ALIGN_EPI) { if (wr == 0) PG8_BAR; }
    PG8_BAR;
    if constexpr (Epi::AFTER_DRAIN) { E.fused(acc, cur, wr, wc, fr, fq, lds, wid, lane); S.done(cur); }
#undef PG8_SA
#undef PG8_SB
#undef PG8_STAGE
#undef PG8_LDA
#undef PG8_LDB
#undef PG8_MMA
#undef PG8_WAIT_V
#undef PG8_WAIT_L
#undef PG8_BAR
#undef PG8_SCHED
}
}
#ifndef LAS
#define LAS __attribute__((address_space(3)))
#endif

#define XB_TMO      128
#define XB_XCNT(j)  (256  + 64 * (j))
#define XB_XSUB(j)  (1280 + 64 * (j))
#define XB_XGEN(j)  (2304 + 64 * (j))
#define XB_TOP      3328
#define XB_TOPGEN   3392
#define XCD_BAR_WORDS 3456
#define XB_SPIN_CAP (1u << 18)

__device__ __forceinline__ unsigned xb_ld(unsigned* p)              { return __hip_atomic_load(p, __ATOMIC_RELAXED, __HIP_MEMORY_SCOPE_AGENT); }
__device__ __forceinline__ unsigned xb_add(unsigned* p, unsigned v) { return __hip_atomic_fetch_add(p, v, __ATOMIC_RELAXED, __HIP_MEMORY_SCOPE_AGENT); }
__device__ __forceinline__ unsigned xb_xcc_id() { return (unsigned)__builtin_amdgcn_s_getreg((3 << 11) | 20) & 0xFu; }
#define XB_SPIN(cond, bar) do { unsigned _sp = 0; while (cond) { __builtin_amdgcn_s_sleep(1); \
    if ((++_sp & 255u) == 0u) { if (xb_ld(&(bar)[XB_TMO])) break; if (_sp > XB_SPIN_CAP) { atomicAdd(&(bar)[XB_TMO], 1u); break; } } } } while (0)

struct XcdBarrier {
    unsigned* bar; unsigned x;
    volatile LAS unsigned* st;
};

__device__ __forceinline__ XcdBarrier xcd_barrier_post(unsigned* bar, volatile LAS unsigned* st) {
    XcdBarrier b; b.bar = bar; b.x = xb_xcc_id(); b.st = st;
    if (threadIdx.x == 0) (void)xb_add(&bar[XB_XCNT(b.x)], 1u);
    return b;
}
__device__ __forceinline__ void xcd_barrier_complete(unsigned* bar, unsigned x, unsigned& nloc, unsigned& nx) {
    const unsigned G = gridDim.x * gridDim.y * gridDim.z;
    unsigned sum, cnt, mine, sp = 0u;
    for (;;) {
        sum = 0u; cnt = 0u; mine = 0u;
#pragma unroll
        for (unsigned j = 0; j < 16; ++j) { const unsigned c = xb_ld(&bar[XB_XCNT(j)]); sum += c; cnt += (c > 0u) ? 1u : 0u; mine = (j == x) ? c : mine; }
        if (sum == G) break;
        __builtin_amdgcn_s_sleep(1);
        if ((++sp & 255u) == 0u) { if (xb_ld(&bar[XB_TMO])) break; if (sp > XB_SPIN_CAP) { atomicAdd(&bar[XB_TMO], 1u); break; } }
    }
    nloc = mine > 0u ? mine : 1u; nx = cnt > 0u ? cnt : 1u;
}

__device__ __forceinline__ void xcd_barrier(const XcdBarrier& b) {
    asm volatile("s_waitcnt vmcnt(0)" ::: "memory");
    __syncthreads();
    if (threadIdx.x == 0) {
        unsigned* bar = b.bar;
        __builtin_amdgcn_s_waitcnt(0);
        unsigned nloc = b.st[0], nx = b.st[1];
        if (nloc == 0u) { xcd_barrier_complete(bar, b.x, nloc, nx); b.st[0] = nloc; b.st[1] = nx; }
        const unsigned old = xb_add(&bar[XB_XSUB(b.x)], 1u);
        const unsigned gen = old / nloc;
        if (old + 1u == (gen + 1u) * nloc) {
            __builtin_amdgcn_fence(__ATOMIC_RELEASE, "agent");
            asm volatile("s_waitcnt vmcnt(0)" ::: "memory");
            const unsigned og = xb_add(&bar[XB_TOP], 1u);
            const unsigned tg = og / nx;
            if (og + 1u == (tg + 1u) * nx) xb_add(&bar[XB_TOPGEN], 1u);
            else XB_SPIN(xb_ld(&bar[XB_TOPGEN]) == tg, bar);
            __builtin_amdgcn_fence(__ATOMIC_ACQUIRE, "agent");
            xb_add(&bar[XB_XGEN(b.x)], 1u);
            asm volatile("s_waitcnt vmcnt(0)" ::: "memory");
        } else {
            XB_SPIN(xb_ld(&bar[XB_XGEN(b.x)]) == gen, bar);
            __builtin_amdgcn_fence(__ATOMIC_ACQUIRE, "agent");
            asm volatile("s_waitcnt vmcnt(0)" ::: "memory");
        }
    }
    __syncthreads();
}


__device__ __attribute__((aligned(256))) unsigned g_bar[XCD_BAR_WORDS];
#ifndef LAS
#define LAS __attribute__((address_space(3)))
#endif
typedef unsigned short bf16_t;
typedef short bf16x8 __attribute__((ext_vector_type(8)));
typedef short s16x4 __attribute__((ext_vector_type(4)));
typedef float f32x4 __attribute__((ext_vector_type(4)));
typedef float f32x16 __attribute__((ext_vector_type(16)));
typedef unsigned u32x4 __attribute__((ext_vector_type(4)));
typedef unsigned u32x2 __attribute__((ext_vector_type(2)));
typedef float f32x2_t __attribute__((ext_vector_type(2)));
typedef __bf16 bf16x2_t __attribute__((ext_vector_type(2)));

constexpr int DM = 1024, MTOT = 32768, SEQP = 16384, SEQS = 2048;
constexpr int NTHR = 512;
constexpr float EPS = 1e-6f, SUBLN_EPS = 1e-5f, LOG2E = 1.4426950408889634f;
constexpr float QSCALE = 0.125f * LOG2E;
constexpr int XB_LDS_OFF = 131072, LDS_TOTAL = 131072 + 256;

__device__ __attribute__((aligned(256))) bf16_t g_w0t[4096 * 1024];
__device__ __attribute__((aligned(256))) bf16_t g_wo0t[1024 * 1024];
__device__ __attribute__((aligned(256))) bf16_t g_ws1[1024 * 1024];
__device__ __attribute__((aligned(256))) bf16_t g_w1t[3072 * 1024];
__device__ __attribute__((aligned(256))) bf16_t g_wo1t[1024 * 1024];
__device__ __attribute__((aligned(256))) bf16_t g_tab128[256 * 128];
__device__ __attribute__((aligned(256))) bf16_t g_tab16[32 * 32];
__device__ __attribute__((aligned(256))) float g_r0[MTOT];
__device__ __attribute__((aligned(256))) float g_ss1[MTOT];
__device__ __attribute__((aligned(256))) float g_ss2[MTOT];
__device__ __attribute__((aligned(256))) unsigned g_nrm[64];
__device__ __attribute__((aligned(256))) unsigned g_ctr[4];

struct Params {
    const float* xp; const float* xs; const float* attn_norm; const float* w_in0; const float* lq1; const float* lk1; const float* lq2; const float* lk2;
    const float* subln; const float* w_out0; const float* fnet_norm; const float* w_in1; const float* w_out1; const float* final_norm;
    float* out; unsigned char* ws; unsigned* bar;
};

__device__ __forceinline__ unsigned pk2(float lo, float hi) { f32x2_t v = {lo, hi}; bf16x2_t b = __builtin_convertvector(v, bf16x2_t); return __builtin_bit_cast(unsigned, b); }
__device__ __forceinline__ float bf_lo(unsigned u) { return __uint_as_float(u << 16); }
__device__ __forceinline__ float bf_hi(unsigned u) { return __uint_as_float(u & 0xffff0000u); }
__device__ __forceinline__ float wave_sum(float v) { v += __shfl_xor(v, 32); v += __shfl_xor(v, 16); v += __shfl_xor(v, 8); v += __shfl_xor(v, 4); v += __shfl_xor(v, 2); v += __shfl_xor(v, 1); return v; }
__device__ __forceinline__ float silu_f(float z) { return z / (1.0f + __expf(-z)); }
__device__ __forceinline__ int crow(int r, int hi) { return (r & 3) + 8 * (r >> 2) + 4 * hi; }
#define BLK_SYNC() __syncthreads()

struct EpiRowBf16 {
    static constexpr bool PERM = true, AFTER_DRAIN = false;
    bf16_t* b0; bf16_t* b1; bf16_t* b2; bf16_t* b3; int ld0, ld1; int split_cols; const float* rstat; int stat_is_sumsq; float scale0; unsigned* nrm;
    __device__ __forceinline__ void operator()(const pg8::f32x4 (&acc)[2][2][4][2], const pg8::Unit& u, int wr, int wc, int fr, int fq) const {
        const int row0 = u.pm * 256 + wr * 64 + fr; int colt = u.pn * 256; const int t = colt / split_cols; colt -= t * split_cols;
        bf16_t* b = (t == 0) ? b0 : (t == 1) ? b1 : (t == 2) ? b2 : b3; const int ld = (t == 0) ? ld0 : ld1; const float sc = (t == 0) ? scale0 : 1.0f;
        const int col0 = colt + wc * 32 + 8 * fq; const bool donrm = (nrm != nullptr) && (t < 2); float mx[2] = {0.f, 0.f};
#pragma unroll
        for (int ai = 0; ai < 2; ++ai)
#pragma unroll
            for (int m = 0; m < 4; ++m) {
                const int row = row0 + ai * 128 + m * 16; float rs = rstat[row];
                if (stat_is_sumsq) rs = rsqrtf(rs * (1.0f / 1024.0f) + EPS);
                rs *= sc; bf16_t* rowp = b + (size_t)row * ld + col0;
#pragma unroll
                for (int bj = 0; bj < 2; ++bj) { const pg8::f32x4 v0 = acc[ai][bj][m][0] * rs, v1 = acc[ai][bj][m][1] * rs;
                    u32x4 w; w.x = pk2(v0[0], v0[1]); w.y = pk2(v0[2], v0[3]); w.z = pk2(v1[0], v1[1]); w.w = pk2(v1[2], v1[3]);
                    *(u32x4*)(rowp + bj * 128) = w;
                    if (donrm) { float ps = (v0[0] * v0[0] + v0[1] * v0[1]) + (v0[2] * v0[2] + v0[3] * v0[3]) + (v1[0] * v1[0] + v1[1] * v1[1]) + (v1[2] * v1[2] + v1[3] * v1[3]);
                        ps += __shfl_xor(ps, 16); ps += __shfl_xor(ps, 32); mx[bj] = fmaxf(mx[bj], ps); } }
            }
        if (donrm) {
#pragma unroll
            for (int bj = 0; bj < 2; ++bj) { float v = mx[bj]; v = fmaxf(v, __shfl_xor(v, 1)); v = fmaxf(v, __shfl_xor(v, 2)); v = fmaxf(v, __shfl_xor(v, 4)); v = fmaxf(v, __shfl_xor(v, 8));
                if ((threadIdx.x & 63) == 0) atomicMax(nrm + t * 32 + ((colt + bj * 128 + wc * 32) >> 6) * 2 + (wc & 1), __float_as_uint(v)); }
        }
    }
};
struct EpiFold {
    static constexpr bool PERM = true, AFTER_DRAIN = false;
    bf16_t* O; int g;
    __device__ __forceinline__ void operator()(const pg8::f32x4 (&acc)[2][2][4][2], const pg8::Unit& u, int wr, int wc, int fr, int fq) const {
        const int col0 = u.pn * 256 + wc * 32 + 8 * fq;
#pragma unroll
        for (int ai = 0; ai < 2; ++ai)
#pragma unroll
            for (int m = 0; m < 4; ++m) {
                const int j = wr * 64 + m * 16 + fr; bf16_t* rowp = O + (size_t)(ai * 1024 + g * 128 + j) * 1024 + col0;
#pragma unroll
                for (int bj = 0; bj < 2; ++bj) { const pg8::f32x4 v0 = acc[ai][bj][m][0], v1 = acc[ai][bj][m][1];
                    u32x4 w; w.x = pk2(v0[0], v0[1]); w.y = pk2(v0[2], v0[3]); w.z = pk2(v1[0], v1[1]); w.w = pk2(v1[2], v1[3]);
                    *(u32x4*)(rowp + bj * 128) = w; }
            }
    }
};
struct EpiResid {
    static constexpr bool PERM = false, AFTER_DRAIN = false;
    const float* resA; const float* resB; float* out; bf16_t* outb; float* ss;
    __device__ __forceinline__ void operator()(const pg8::f32x4 (&acc)[2][2][4][2], const pg8::Unit& u, int wr, int wc, int fr, int fq) const {
        const int row0 = u.pm * 256 + wr * 64 + fr; const int col0 = u.pn * 256 + wc * 32 + 4 * fq;
#pragma unroll
        for (int ai = 0; ai < 2; ++ai)
#pragma unroll
            for (int m = 0; m < 4; ++m) {
                const int row = row0 + ai * 128 + m * 16;
                const float* rp = (row < SEQP) ? (resA + (size_t)row * DM) : (resB + (size_t)(row - SEQP) * DM);
                float s = 0.f;
#pragma unroll
                for (int bj = 0; bj < 2; ++bj)
#pragma unroll
                    for (int n = 0; n < 2; ++n) { const int col = col0 + bj * 128 + n * 16;
                        const pg8::f32x4 r = *(const pg8::f32x4*)(rp + col); const pg8::f32x4 v = r + acc[ai][bj][m][n];
                        *(pg8::f32x4*)(out + (size_t)row * DM + col) = v;
                        if (outb) { u32x2 w; w.x = pk2(v[0], v[1]); w.y = pk2(v[2], v[3]); *(u32x2*)(outb + (size_t)row * DM + col) = w; }
                        s += (v[0] * v[0] + v[1] * v[1]) + (v[2] * v[2] + v[3] * v[3]); }
                s += __shfl_xor(s, 16); s += __shfl_xor(s, 32);
                if (fq == 0) atomicAdd(ss + row, s);
            }
    }
};
struct OneUnit { int pn; __device__ bool next(int i, pg8::Unit& u) const { if (i > 0) return false; u.pm = 0; u.pn = pn; return true; }
    __device__ __forceinline__ void a_ready(const pg8::Unit&) const {} __device__ __forceinline__ void done(const pg8::Unit&) const {} };

__device__ __forceinline__ void transpose_item(const float* W, int ldw, const float* gain, bf16_t* WT, LAS float* scr, int item, int nblk, int lane) {
    const int kb = item / nblk, nb = item % nblk, k0 = 64 * kb, n0 = 32 * nb;
#pragma unroll 8
    for (int i = 0; i < 32; ++i) { const int kk = 2 * i + (lane >> 5); const float gk = gain ? gain[k0 + kk] : 1.0f; scr[kk * 33 + (lane & 31)] = W[(size_t)(k0 + kk) * ldw + n0 + (lane & 31)] * gk; }
    asm volatile("s_waitcnt lgkmcnt(0)" ::: "memory");
    const int c = lane & 7;
#pragma unroll
    for (int j = 0; j < 4; ++j) { const int n = (lane >> 3) + 8 * j; const LAS float* s = scr + (8 * c) * 33 + n;
        u32x4 o; o.x = pk2(s[0 * 33], s[1 * 33]); o.y = pk2(s[2 * 33], s[3 * 33]); o.z = pk2(s[4 * 33], s[5 * 33]); o.w = pk2(s[6 * 33], s[7 * 33]);
        *(u32x4*)(WT + (size_t)(n0 + n) * 1024 + k0 + 8 * c) = o; }
    asm volatile("s_waitcnt lgkmcnt(0)" ::: "memory");
}

__device__ __forceinline__ void phase0(const Params& p, LAS unsigned char* lds, bf16_t* XB) {
    const int tid = threadIdx.x, lane = tid & 63, wave = tid >> 6;
    const int gw = blockIdx.x * 8 + wave, NGW = gridDim.x * 8;
    for (int row = gw; row < MTOT; row += NGW) {
        const float* xr = (row < SEQP) ? (p.xp + (size_t)row * DM) : (p.xs + (size_t)(row - SEQP) * DM);
        f32x4 v[4]; float ss = 0.f;
#pragma unroll
        for (int i = 0; i < 4; ++i) { v[i] = *(const f32x4*)(xr + 4 * (lane + 64 * i)); ss += (v[i][0] * v[i][0] + v[i][1] * v[i][1]) + (v[i][2] * v[i][2] + v[i][3] * v[i][3]); }
        ss = wave_sum(ss);
        if (lane == 0) g_r0[row] = rsqrtf(ss * (1.0f / 1024.0f) + EPS);
#pragma unroll
        for (int i = 0; i < 4; ++i) { u32x2 w; w.x = pk2(v[i][0], v[i][1]); w.y = pk2(v[i][2], v[i][3]); *(u32x2*)(XB + (size_t)row * DM + 4 * (lane + 64 * i)) = w; }
    }
    for (int i = blockIdx.x * NTHR + tid; i < MTOT; i += gridDim.x * NTHR) { g_ss1[i] = 0.f; g_ss2[i] = 0.f; }
    if (blockIdx.x == 0 && tid < 64) { g_nrm[tid] = 0u; if (tid < 4) g_ctr[tid] = 0u; }
    if (blockIdx.x == 0) for (int i = tid; i < XCD_BAR_WORDS; i += NTHR) g_bar[i] = 0u;
    LAS float* scr = (LAS float*)(lds + wave * 8704);
    constexpr int I0 = 16 * 128, I1 = 16 * 32, NIT = I0 + 3 * I1;
    for (int it = gw; it < NIT; it += NGW) {
        int r = it;
        if (r < I0) { transpose_item(p.w_in0, 4096, p.attn_norm, g_w0t, scr, r, 128, lane); continue; } r -= I0;
        if (r < I1) { transpose_item(p.w_out0, 1024, nullptr, g_wo0t, scr, r, 32, lane); continue; } r -= I1;
        if (r < I1) { transpose_item(p.w_in1 + 1024, 2048, p.fnet_norm, g_w1t + (size_t)2048 * 1024, scr, r, 32, lane); continue; } r -= I1;
        transpose_item(p.w_out1, 1024, nullptr, g_wo1t, scr, r, 32, lane);
    }
    for (int i = blockIdx.x * NTHR + tid; i < 1024 * 256; i += gridDim.x * NTHR) {
        const int k = i >> 8, c4 = (i & 255) * 4; const f32x4 w = *(const f32x4*)(p.w_in1 + (size_t)k * 2048 + c4); const float gk = p.fnet_norm[k];
        u32x2 o; o.x = pk2(w[0] * gk, w[1] * gk); o.y = pk2(w[2] * gk, w[3] * gk); *(u32x2*)(g_ws1 + (size_t)k * 1024 + c4) = o;
    }
    for (int i = blockIdx.x * NTHR + tid; i < 256 * 128; i += gridDim.x * NTHR) {
        const int rr = i >> 7, n = i & 127, k = rr & 127, part = rr >> 7; const float th = (float)((k * n) & 127) * (6.283185307179586f / 128.0f);
        const float v = part ? sinf(th) : cosf(th); g_tab128[i] = (bf16_t)(pk2(v, 0.f) & 0xffffu);
    }
    for (int i = blockIdx.x * NTHR + tid; i < 32 * 32; i += gridDim.x * NTHR) {
        const int kk = i >> 5, j = i & 31, k1 = kk & 15, po = kk >> 4, n1 = j & 15, pi = j >> 4; const float th = (float)((k1 * n1) & 15) * (6.283185307179586f / 16.0f);
        float v; if (po == 0) v = pi ? -sinf(th) : cosf(th); else v = pi ? -cosf(th) : -sinf(th);
        g_tab16[i] = (bf16_t)(pk2(v, 0.f) & 0xffffu);
    }
}

constexpr int AT_KP = 144, AT_VP = 320, AT_K2 = 64 * AT_KP, AT_V = 2 * 64 * AT_KP, AT_STAGE = AT_V + 64 * AT_VP, AT_XP = 528;
typedef short v4i16_t __attribute__((ext_vector_type(4)));
__device__ __forceinline__ s16x4 tr_read(LAS const unsigned char* p) { return __builtin_bit_cast(s16x4, __builtin_amdgcn_ds_read_tr16_b64_v4i16((LAS v4i16_t*)p)); }
__device__ __forceinline__ bf16x8 cat8(s16x4 a, s16x4 b) { return (bf16x8){a[0], a[1], a[2], a[3], b[0], b[1], b[2], b[3]}; }
__device__ __forceinline__ bf16x8 neg8(bf16x8 a) { typedef int i32x4 __attribute__((ext_vector_type(4))); i32x4 v = __builtin_bit_cast(i32x4, a); v = v ^ (int)0x80008000; return __builtin_bit_cast(bf16x8, v); }
#define MFMA32(a, b, c) __builtin_amdgcn_mfma_f32_32x32x16_bf16((a), (b), (c), 0, 0, 0)

__device__ __forceinline__ void attn_phase(const Params& p, LAS unsigned char* lds, const bf16_t* Qb, const bf16_t* Kb, const bf16_t* Vb, const bf16_t* Zb, bf16_t* Ob, unsigned* ctr) {
    const int tid = threadIdx.x, lane = tid & 63, wave = __builtin_amdgcn_readfirstlane(tid >> 6), r32 = lane & 31, hi = lane >> 5;
    const int map = wave >> 2, qs = wave & 3;
    float lam;
    { const float a = wave_sum(p.lq1[lane] * p.lk1[lane]), b = wave_sum(p.lq2[lane] * p.lk2[lane]); lam = expf(a) - expf(b) + 0.2f; }
    const int g16 = lane >> 4, i16 = lane & 15, tq = i16 >> 2, tp = i16 & 3;
    LAS unsigned* qword = (LAS unsigned*)(lds + 3 * AT_STAGE);
    for (;;) {
        if (tid == 0) *qword = atomicAdd(ctr, 1u);
        BLK_SYNC();
        const int unit = (int)*qword;
        if (unit >= 2048) break;
        int R0s, S, h, q0;
        if (unit < 1024) { R0s = 0; S = SEQP; h = 7 - (unit >> 7); q0 = (unit & 127) * 128; }
        else { const int v = unit - 1024; h = 7 - (v >> 7); R0s = SEQP + ((v >> 4) & 7) * SEQS; S = SEQS; q0 = (v & 15) * 128; }
        const float slope2 = exp2f(-(float)(h + 1)) * LOG2E;
        const int qrow = R0s + q0 + qs * 32 + r32;
        bf16x8 qf[4];
        { const bf16_t* qp = Qb + (size_t)qrow * DM + h * 128 + map * 64 + hi * 8;
          float qq = 0.f;
#pragma unroll
          for (int st = 0; st < 4; ++st) { qf[st] = *(const bf16x8*)(qp + st * 16);
#pragma unroll
              for (int e = 0; e < 8; ++e) { const float qv = __uint_as_float(((unsigned)(unsigned short)qf[st][e]) << 16); qq = __builtin_fmaf(qv, qv, qq); } }
          qq += __shfl_xor(qq, 32);
#pragma unroll
          for (int sh = 1; sh < 32; sh <<= 1) qq = fmaxf(qq, __shfl_xor(qq, sh));
          LAS float* wst = (LAS float*)(lds + 3 * AT_STAGE + 64);
          if (lane == 0) wst[wave * 2] = qq;
        }
        const int dt0 = q0 >> 6, NTLS = S / 64;
        const float nslope2 = -slope2;
        const float qposf = (float)(q0 + qs * 32 + r32 - 4 * hi);
        float l = 0.f;
        f32x16 o[4];
#pragma unroll
        for (int db = 0; db < 4; ++db)
#pragma unroll
            for (int r = 0; r < 16; ++r) o[db][r] = 0.f;
        const int srow = tid >> 4, sch = tid & 15;
        const bf16_t* gk = Kb + (size_t)(R0s + srow) * DM + h * 128 + sch * 8;
        const ptrdiff_t vk = Vb - Kb;
        const int ldk = (sch >> 3) * AT_K2 + srow * AT_KP + (sch & 7) * 16, ldv = AT_V + srow * AT_VP + sch * 16;
#define AT_GSRC(i) (gk + ((i) >= 2 ? vk : 0) + (size_t)(((i) & 1) * 32) * DM)
#define AT_LDST(i) (((i) >= 2 ? ldv + ((i) & 1) * 32 * AT_VP : ldk + ((i) & 1) * 32 * AT_KP))
        int lbase = dt0, skipat = 0x3fffffff, ntl = 2;
#define TIDX(j) (lbase + (j) + ((lbase + (j) >= skipat) ? 2 : 0))
#pragma unroll 1
        for (int pass = 0; pass < 2; ++pass) {
        if (pass == 1) {
            float lr = l + __shfl_xor(l, 32);
#pragma unroll
            for (int sh = 1; sh < 32; sh <<= 1) lr = fminf(lr, __shfl_xor(lr, sh));
            LAS float* wst = (LAS float*)(lds + 3 * AT_STAGE + 64);
            if (lane == 0) wst[wave * 2 + 1] = lr;
            BLK_SYNC();
            float thr = -1.0e30f;
#pragma unroll
            for (int mm = 0; mm < 2; ++mm) { const int e = (2 * h + mm) * 2;
                const float kn2 = __uint_as_float(g_nrm[32 + e]) + __uint_as_float(g_nrm[32 + e + 1]);
                float qmx = 0.f, lmn = 1.0e30f;
#pragma unroll
                for (int w = 0; w < 4; ++w) { qmx = fmaxf(qmx, wst[(mm * 4 + w) * 2]); lmn = fminf(lmn, wst[(mm * 4 + w) * 2 + 1]); }
                thr = fmaxf(thr, sqrtf(qmx * kn2) * 1.02f - log2f(lmn) + 0.05f); }
            thr += 25.0f - log2f(1.0f - exp2f(-slope2));
            const float dminf = fminf(fmaxf(ceilf(thr / slope2), 1.0f), 1.0e6f); const int dmin = (int)dminf;
            int lo = q0 - dmin + 1; lo = lo < 0 ? 0 : lo; int hiK = q0 + 127 + dmin - 1; hiK = hiK > S - 1 ? S - 1 : hiK;
            int t_lo = lo >> 6, t_hi = hiK >> 6; if (t_hi > NTLS - 1) t_hi = NTLS - 1;
            lbase = t_lo; skipat = dt0; ntl = (t_hi - t_lo + 1) - 2;
        }
        if (ntl > 0) {
        u32x4 stg[4];
#pragma unroll
        for (int i = 0; i < 4; ++i) stg[i] = *(const u32x4*)(AT_GSRC(i) + (size_t)TIDX(0) * 64 * DM);
#pragma unroll
        for (int i = 0; i < 4; ++i) *(LAS u32x4*)(lds + AT_LDST(i)) = stg[i];
        if (ntl > 1) {
#pragma unroll
            for (int i = 0; i < 4; ++i) stg[i] = *(const u32x4*)(AT_GSRC(i) + (size_t)TIDX(1) * 64 * DM);
#pragma unroll
            for (int i = 0; i < 4; ++i) *(LAS u32x4*)(lds + AT_STAGE + AT_LDST(i)) = stg[i];
        }
        if (ntl > 2) {
#pragma unroll
            for (int i = 0; i < 4; ++i) stg[i] = *(const u32x4*)(AT_GSRC(i) + (size_t)TIDX(2) * 64 * DM);
        }
        __builtin_amdgcn_s_waitcnt(0x0F70);
        BLK_SYNC();
        const int koff = map * AT_K2 + r32 * AT_KP + hi * 16, voff = AT_V + (4 * hi + tq) * AT_VP + (16 * (g16 & 1) + 4 * tp) * 2;
        int soff = 0;
        for (int tt = 0; tt < ntl; ++tt) {
            const int s1off = (soff == 2 * AT_STAGE) ? 0 : soff + AT_STAGE, s2off = (s1off == 2 * AT_STAGE) ? 0 : s1off + AT_STAGE;
            f32x16 s0, s1;
#pragma unroll
            for (int r = 0; r < 16; ++r) { s0[r] = 0.f; s1[r] = 0.f; }
            bf16x8 kf0[4], kf1[4];
#pragma unroll
            for (int st = 0; st < 4; ++st) { kf0[st] = *(LAS const bf16x8*)(lds + soff + koff + st * 32); kf1[st] = *(LAS const bf16x8*)(lds + soff + koff + 32 * AT_KP + st * 32); }
#pragma unroll
            for (int st = 0; st < 4; ++st) s0 = MFMA32(kf0[st], qf[st], s0);
#pragma unroll
            for (int st = 0; st < 4; ++st) s1 = MFMA32(kf1[st], qf[st], s1);
            __builtin_amdgcn_sched_barrier(0);
            if (tt + 2 < ntl) {
#pragma unroll
                for (int i = 0; i < 4; ++i) *(LAS u32x4*)(lds + s2off + AT_LDST(i)) = stg[i];
            }
            if (tt + 3 < ntl) {
#pragma unroll
                for (int i = 0; i < 4; ++i) stg[i] = *(const u32x4*)(AT_GSRC(i) + (size_t)TIDX(tt + 3) * 64 * DM);
            }
            LAS const unsigned char* vbase = lds + soff + voff;
            bf16x8 vf[2][4];
#pragma unroll
            for (int ks = 0; ks < 4; ++ks) { LAS const unsigned char* a = vbase + (16 * ks) * AT_VP; vf[0][ks] = cat8(tr_read(a), tr_read(a + 8 * AT_VP)); }
            __builtin_amdgcn_sched_barrier(0);
            const float d0 = qposf - (float)(TIDX(tt) * 64);
            float rs = 0.f;
#pragma unroll
            for (int r = 0; r < 16; ++r) { const float c = (float)((r & 3) + 8 * (r >> 2));
                s0[r] = __builtin_amdgcn_exp2f(__builtin_fmaf(nslope2, fabsf(d0 - c), s0[r]));
                s1[r] = __builtin_amdgcn_exp2f(__builtin_fmaf(nslope2, fabsf(d0 - (32.0f + c)), s1[r]));
                rs += s0[r] + s1[r]; }
            l += rs;
            bf16x8 pf[4];
#pragma unroll
            for (int s = 0; s < 2; ++s) {
                u32x4 w0, w1;
                w0.x = pk2(s0[8 * s + 0], s0[8 * s + 1]); w0.y = pk2(s0[8 * s + 2], s0[8 * s + 3]); w0.z = pk2(s0[8 * s + 4], s0[8 * s + 5]); w0.w = pk2(s0[8 * s + 6], s0[8 * s + 7]);
                w1.x = pk2(s1[8 * s + 0], s1[8 * s + 1]); w1.y = pk2(s1[8 * s + 2], s1[8 * s + 3]); w1.z = pk2(s1[8 * s + 4], s1[8 * s + 5]); w1.w = pk2(s1[8 * s + 6], s1[8 * s + 7]);
                pf[s] = __builtin_bit_cast(bf16x8, w0); pf[2 + s] = __builtin_bit_cast(bf16x8, w1);
            }
            __builtin_amdgcn_sched_barrier(0);
#pragma unroll
            for (int db = 0; db < 4; ++db) {
                if (db < 3) {
#pragma unroll
                    for (int ks = 0; ks < 4; ++ks) { LAS const unsigned char* a = vbase + (16 * ks) * AT_VP + (db + 1) * 64; vf[(db + 1) & 1][ks] = cat8(tr_read(a), tr_read(a + 8 * AT_VP)); }
                }
#pragma unroll
                for (int ks = 0; ks < 4; ++ks) o[db] = MFMA32(vf[db & 1][ks], pf[ks], o[db]);
                __builtin_amdgcn_sched_barrier(0);
            }
            BLK_SYNC();
            soff = s1off;
        }
        }
        }
#undef TIDX
#undef AT_GSRC
#undef AT_LDST
        l += __shfl_xor(l, 32);
        const float inv = 1.0f / l;
#pragma unroll
        for (int db = 0; db < 4; ++db)
#pragma unroll
            for (int r = 0; r < 16; ++r) o[db][r] *= inv;
        LAS unsigned char* xq = lds + (qs * 32 + r32) * AT_XP;
        if (map == 1) {
#pragma unroll
            for (int db = 0; db < 4; ++db)
#pragma unroll
                for (int rg = 0; rg < 4; ++rg) { const int d = 32 * db + 8 * rg + 4 * hi;
                    *(LAS f32x4*)(xq + d * 4) = (f32x4){o[db][4 * rg], o[db][4 * rg + 1], o[db][4 * rg + 2], o[db][4 * rg + 3]}; }
        }
        BLK_SYNC();
        if (map == 0) {
            float ss = 0.f;
#pragma unroll
            for (int db = 0; db < 4; ++db)
#pragma unroll
                for (int rg = 0; rg < 4; ++rg) { const int d = 32 * db + 8 * rg + 4 * hi; const f32x4 o2 = *(LAS const f32x4*)(xq + d * 4);
#pragma unroll
                    for (int e = 0; e < 4; ++e) { const float v = o[db][4 * rg + e] - lam * o2[e]; o[db][4 * rg + e] = v; ss += v * v; } }
            ss += __shfl_xor(ss, 32);
            const float rn = rsqrtf(ss * (1.0f / 128.0f) + SUBLN_EPS) * 0.8f;
            const bf16_t* zp = Zb + (size_t)qrow * DM + h * 128; bf16_t* op = Ob + (size_t)qrow * DM + h * 128;
#pragma unroll
            for (int db = 0; db < 4; ++db)
#pragma unroll
                for (int rg = 0; rg < 4; ++rg) { const int d = 32 * db + 8 * rg + 4 * hi;
                    const f32x4 gg = *(const f32x4*)(p.subln + d); const u32x2 zz = *(const u32x2*)(zp + d);
                    const float v0 = o[db][4 * rg] * rn * gg[0] * silu_f(bf_lo(zz.x)), v1 = o[db][4 * rg + 1] * rn * gg[1] * silu_f(bf_hi(zz.x));
                    const float v2 = o[db][4 * rg + 2] * rn * gg[2] * silu_f(bf_lo(zz.y)), v3 = o[db][4 * rg + 3] * rn * gg[3] * silu_f(bf_hi(zz.y));
                    u32x2 w; w.x = pk2(v0, v1); w.y = pk2(v2, v3); *(u32x2*)(op + d) = w; }
        }
        BLK_SYNC();
    }
}

constexpr int FT_P = 320;
template <int MODE> __device__ __forceinline__ void fft_rows(int unit, int& rbase, int& cc, int& a0, int& a1, int& a2) {
    cc = unit & 7;
    if (MODE == 0) { a0 = unit >> 3; rbase = 0; a1 = 0; a2 = 0; }
    else if (MODE == 1) { a0 = unit >> 7; a1 = (unit >> 3) & 15; rbase = SEQP + a0 * SEQS; a2 = 0; }
    else { if (unit < 1024) { rbase = 0; a0 = unit >> 3; a1 = 128; } else { const int v = unit - 1024; rbase = SEQP + (v >> 7) * SEQS; a0 = (v >> 3) & 15; a1 = 16; } a2 = 0; }
}
template <int MODE> __device__ __forceinline__ const bf16_t* fft_src(const bf16_t* AB, int rbase, int cc, int a0, int a1, int rho, int ch16) {
    int grow, part;
    if (MODE == 0) { part = rho >> 7; grow = (rho & 127) * 128 + a0; }
    else if (MODE == 1) { part = (rho >> 4) & 1; grow = rbase + (rho & 15) * 128 + a1 * 8 + (rho >> 5); }
    else { part = rho >> 7; grow = rbase + a0 * 128 + (rho & 127); }
    return AB + (size_t)grow * 2048 + part * 1024 + cc * 128 + ch16 * 8;
}

template <int MODE> __device__ __forceinline__ void fft_pass(LAS unsigned char* lds, bf16_t* AB, const bf16_t* Z1, bf16_t* FG, int nunits, bf16_t* OUT, const int omask) {
    const int tid = threadIdx.x, lane = tid & 63, wave = __builtin_amdgcn_readfirstlane(tid >> 6), r32 = lane & 31, hi = lane >> 5;
    const int g16 = lane >> 4, i16 = lane & 15, tq = i16 >> 2, tp = i16 & 3;
    const int kb = wave & 3, cbh = wave >> 2;
    bf16x8 Cf[8], Sf[8];
    if (MODE != 1) {
        const int k = 32 * kb + r32;
#pragma unroll
        for (int s = 0; s < 8; ++s) { Cf[s] = *(const bf16x8*)(g_tab128 + k * 128 + 16 * s + 8 * hi); Sf[s] = *(const bf16x8*)(g_tab128 + (128 + k) * 128 + 16 * s + 8 * hi); }
    } else {
#pragma unroll
        for (int s = 0; s < 2; ++s) Cf[s] = *(const bf16x8*)(g_tab16 + r32 * 32 + 16 * s + 8 * hi);
    }
    int unit = blockIdx.x;
    if (unit >= nunits) return;
    int rbase, cc, a0, a1, a2;
    fft_rows<MODE>(unit, rbase, cc, a0, a1, a2);
    u32x4 stg[8];
#pragma unroll
    for (int i = 0; i < 8; ++i) { const int c = tid + 512 * i; stg[i] = *(const u32x4*)fft_src<MODE>(AB, rbase, cc, a0, a1, c >> 4, c & 15); }
    __builtin_amdgcn_s_waitcnt(0x0F70);
    for (;;) {
#pragma unroll
        for (int i = 0; i < 8; ++i) { const int c = tid + 512 * i; *(LAS u32x4*)(lds + (c >> 4) * FT_P + (c & 15) * 16) = stg[i]; }
        BLK_SYNC();
        const int nunit = unit + gridDim.x; const bool has_next = nunit < nunits;
        int nrbase = 0, ncc = 0, na0 = 0, na1 = 0, na2 = 0;
        if (has_next) { fft_rows<MODE>(nunit, nrbase, ncc, na0, na1, na2);
#pragma unroll
            for (int i = 0; i < 8; ++i) { const int c = tid + 512 * i; stg[i] = *(const u32x4*)fft_src<MODE>(AB, nrbase, ncc, na0, na1, c >> 4, c & 15); } }
        if (MODE == 0) {
            const int k1 = 32 * kb + r32, n2 = a0;
            const float ph = (float)((k1 * n2) & 16383) * (1.0f / 16384.0f); const float tc = __builtin_amdgcn_cosf(ph), ts = __builtin_amdgcn_sinf(ph);
#pragma unroll 1
            for (int cbi = 0; cbi < 2; ++cbi) { const int cb = 2 * cbh + cbi;
                LAS const unsigned char* ab = lds + (8 * hi + tq) * FT_P + (32 * cb + 16 * (g16 & 1) + 4 * tp) * 2;
                f32x16 yr, yi;
#pragma unroll
                for (int r = 0; r < 16; ++r) { yr[r] = 0.f; yi[r] = 0.f; }
#pragma unroll
                for (int s = 0; s < 8; ++s) {
                    const bf16x8 af = cat8(tr_read(ab + (16 * s) * FT_P), tr_read(ab + (16 * s + 4) * FT_P));
                    const bf16x8 bf = cat8(tr_read(ab + (128 + 16 * s) * FT_P), tr_read(ab + (128 + 16 * s + 4) * FT_P));
                    const bf16x8 naf = neg8(af), nbf = neg8(bf);
                    yr = MFMA32(af, Cf[s], yr); yr = MFMA32(nbf, Sf[s], yr);
                    yi = MFMA32(naf, Sf[s], yi); yi = MFMA32(nbf, Cf[s], yi);
                }
                bf16_t* orow = OUT + (size_t)((k1 * 128 + n2) & omask) * 2048 + cc * 128 + cb * 32 + 4 * hi;
#pragma unroll
                for (int rg = 0; rg < 4; ++rg) { float a[4], b[4];
#pragma unroll
                    for (int e = 0; e < 4; ++e) { const float vr = yr[4 * rg + e], vi = yi[4 * rg + e]; a[e] = vr * tc + vi * ts; b[e] = vi * tc - vr * ts; }
                    u32x2 w0, w1; w0.x = pk2(a[0], a[1]); w0.y = pk2(a[2], a[3]); w1.x = pk2(b[0], b[1]); w1.y = pk2(b[2], b[3]);
                    *(u32x2*)(orow + 8 * rg) = w0; *(u32x2*)(orow + 1024 + 8 * rg) = w1; }
            }
        } else if (MODE == 1) {
            const int k1 = r32 & 15, po = r32 >> 4, n2 = a1 * 8 + wave;
            const float ph = (float)((k1 * n2) & 2047) * (1.0f / 2048.0f); const float tc = __builtin_amdgcn_cosf(ph); float ts = __builtin_amdgcn_sinf(ph); if (po) ts = -ts;
#pragma unroll 1
            for (int cb = 0; cb < 4; ++cb) {
                LAS const unsigned char* ab = lds + (wave * 32 + 8 * hi + tq) * FT_P + (32 * cb + 16 * (g16 & 1) + 4 * tp) * 2;
                f32x16 y;
#pragma unroll
                for (int r = 0; r < 16; ++r) y[r] = 0.f;
                const bf16x8 f0 = cat8(tr_read(ab), tr_read(ab + 4 * FT_P)), f1 = cat8(tr_read(ab + 16 * FT_P), tr_read(ab + 20 * FT_P));
                y = MFMA32(f0, Cf[0], y); y = MFMA32(f1, Cf[1], y);
                bf16_t* orow = OUT + (size_t)((rbase + k1 * 128 + n2) & omask) * 2048 + po * 1024 + cc * 128 + cb * 32 + 4 * hi;
#pragma unroll
                for (int rg = 0; rg < 4; ++rg) { float a[4];
#pragma unroll
                    for (int e = 0; e < 4; ++e) { const float own = y[4 * rg + e], oth = __shfl_xor(own, 16); a[e] = own * tc + oth * ts; }
                    u32x2 w0; w0.x = pk2(a[0], a[1]); w0.y = pk2(a[2], a[3]); *(u32x2*)(orow + 8 * rg) = w0; }
            }
        } else {
            const int k2 = 32 * kb + r32, k1 = a0, N1 = a1; const float nrm = (N1 == 128) ? 6.905339660024879e-4f : 1.953125e-3f;
            const size_t orow_i = (size_t)(rbase + k1 + N1 * k2);
#pragma unroll 1
            for (int cbi = 0; cbi < 2; ++cbi) { const int cb = 2 * cbh + cbi;
                LAS const unsigned char* ab = lds + (8 * hi + tq) * FT_P + (32 * cb + 16 * (g16 & 1) + 4 * tp) * 2;
                f32x16 y;
#pragma unroll
                for (int r = 0; r < 16; ++r) y[r] = 0.f;
#pragma unroll
                for (int s = 0; s < 8; ++s) {
                    const bf16x8 af = cat8(tr_read(ab + (16 * s) * FT_P), tr_read(ab + (16 * s + 4) * FT_P));
                    const bf16x8 bf = cat8(tr_read(ab + (128 + 16 * s) * FT_P), tr_read(ab + (128 + 16 * s + 4) * FT_P));
                    y = MFMA32(af, Cf[s], y); y = MFMA32(bf, Sf[s], y);
                }
                const bf16_t* zrow = Z1 + orow_i * DM + cc * 128 + cb * 32 + 4 * hi; bf16_t* orow = FG + orow_i * DM + cc * 128 + cb * 32 + 4 * hi;
#pragma unroll
                for (int rg = 0; rg < 4; ++rg) { const u32x2 zz = *(const u32x2*)(zrow + 8 * rg);
                    const float v0 = y[4 * rg] * nrm * silu_f(bf_lo(zz.x)), v1 = y[4 * rg + 1] * nrm * silu_f(bf_hi(zz.x));
                    const float v2 = y[4 * rg + 2] * nrm * silu_f(bf_lo(zz.y)), v3 = y[4 * rg + 3] * nrm * silu_f(bf_hi(zz.y));
                    u32x2 w; w.x = pk2(v0, v1); w.y = pk2(v2, v3); *(u32x2*)(orow + 8 * rg) = w; }
            }
        }
        BLK_SYNC();
        if (!has_next) break;
        unit = nunit; rbase = nrbase; cc = ncc; a0 = na0; a1 = na1; a2 = na2;
    }
}

#ifndef PROBE
#define PROBE 0
#endif
#ifndef PHM
#define PHM 0xffff
#endif
__global__ void __launch_bounds__(NTHR, 2) fwd_kernel(Params p) {
    extern __shared__ __attribute__((aligned(16))) unsigned char lds_raw[];
    LAS unsigned char* lds = (LAS unsigned char*)lds_raw;
    cg::grid_group grid = cg::this_grid();
    if (threadIdx.x < 4) ((LAS unsigned*)(lds + XB_LDS_OFF))[threadIdx.x] = 0u;
    __syncthreads();
    XcdBarrier xbar0; xbar0.bar = p.bar; xbar0.x = 0; xbar0.st = (volatile LAS unsigned*)(lds + XB_LDS_OFF);
    if (p.bar) xbar0 = xcd_barrier_post(p.bar, (volatile LAS unsigned*)(lds + XB_LDS_OFF));
    const size_t REG = (size_t)MTOT * DM;
    bf16_t* R0 = (bf16_t*)p.ws; bf16_t* R1 = R0 + REG; bf16_t* R2 = R1 + REG; bf16_t* R3 = R2 + REG;
    bf16_t* XB = (bf16_t*)p.out;

    if (PHM & 1) phase0(p, lds, XB);
#if PROBE & 4
    phase0(p, lds, XB);
#endif

    XcdBarrier xbar;
    if (p.bar) { xbar = xbar0; xcd_barrier(xbar); }
    else { grid.sync(); xbar = xcd_barrier_post(g_bar, (volatile LAS unsigned*)(lds + XB_LDS_OFF)); }
#if PROBE & 16
    xcd_barrier(xbar); xcd_barrier(xbar); xcd_barrier(xbar); xcd_barrier(xbar); xcd_barrier(xbar); xcd_barrier(xbar); xcd_barrier(xbar); xcd_barrier(xbar);
#endif
    if (PHM & 2) {
        pg8::Gemm gm{XB, g_w0t, MTOT, 4096, 1024, 1024, 1024}; pg8::StaticOrder S; S.init(MTOT, 4096, gridDim.x, blockIdx.x);
        EpiRowBf16 E{R0, R1, R2, R3, DM, DM, 1024, g_r0, 0, QSCALE, g_nrm};
        pg8::gemm_phase<EpiRowBf16, pg8::StaticOrder, true, true>(lds, gm, S, E);
#if PROBE & 1
        pg8::gemm_phase<EpiRowBf16, pg8::StaticOrder, true, true>(lds, gm, S, E);
#endif
    }
    xcd_barrier(xbar);
    if ((PHM & 512) && blockIdx.x < 32) {
        const int fu = blockIdx.x, g = fu >> 2; pg8::Gemm gm{g_tab128, g_ws1 + g * 128, 256, 1024, 128, 128, 1024}; OneUnit S{fu & 3}; EpiFold E{g_w1t, g};
        pg8::gemm_phase<EpiFold, OneUnit, false, true>(lds, gm, S, E);
    }
#if PROBE & 2
    attn_phase(p, lds, R0, R1, R2, R3, (bf16_t*)p.out + REG, &g_ctr[1]);
#endif
    if (PHM & 4) attn_phase(p, lds, R0, R1, R2, R3, R0, &g_ctr[0]);
    xcd_barrier(xbar);
    if (PHM & 8) {
        pg8::Gemm gm{R0, g_wo0t, MTOT, 1024, 1024, 1024, 1024}; pg8::StaticOrder S; S.init(MTOT, 1024, gridDim.x, blockIdx.x);
        EpiResid E{p.xp, p.xs, p.out, R3, g_ss1};
        pg8::gemm_phase<EpiResid, pg8::StaticOrder, true, true>(lds, gm, S, E);
#if PROBE & 1
        { EpiResid E2{p.xp, p.xs, p.out, R3, g_r0}; pg8::gemm_phase<EpiResid, pg8::StaticOrder, true, true>(lds, gm, S, E2); }
#endif
    }
    xcd_barrier(xbar);
    if (PHM & 16) {
        pg8::Gemm gm{R3, g_w1t, MTOT, 3072, 1024, 1024, 1024}; pg8::StaticOrder S; S.init(MTOT, 3072, gridDim.x, blockIdx.x);
        EpiRowBf16 E{R1, R0, R0, R0, 2048, DM, 2048, g_ss1, 1, 1.0f, nullptr};
        pg8::gemm_phase<EpiRowBf16, pg8::StaticOrder, true, true>(lds, gm, S, E);
#if PROBE & 1
        pg8::gemm_phase<EpiRowBf16, pg8::StaticOrder, true, true>(lds, gm, S, E);
#endif
    }
    xcd_barrier(xbar);
#if PROBE & 64
    fft_pass<0>(lds, R1, nullptr, nullptr, 1024, R3, 16383);
    fft_pass<1>(lds, R1, nullptr, nullptr, 1024, R3, 16383);
#endif
    if (PHM & 32) fft_pass<0>(lds, R1, nullptr, nullptr, 1024, R1, 0x7fffffff);
    if (PHM & 64) fft_pass<1>(lds, R1, nullptr, nullptr, 1024, R1, 0x7fffffff);
    xcd_barrier(xbar);
    if (PHM & 128) fft_pass<2>(lds, R1, R0, R3, 2048, nullptr, 0);
#if PROBE & 8
    fft_pass<2>(lds, R1, R0, R3, 2048, nullptr, 0);
#endif
    xcd_barrier(xbar);
    if (PHM & 256) {
        pg8::Gemm gm{R3, g_wo1t, MTOT, 1024, 1024, 1024, 1024}; pg8::StaticOrder S; S.init(MTOT, 1024, gridDim.x, blockIdx.x);
        EpiResid E{p.out, p.out + (size_t)SEQP * DM, p.out, nullptr, g_ss2};
        pg8::gemm_phase<EpiResid, pg8::StaticOrder, true, true>(lds, gm, S, E);
    }
    xcd_barrier(xbar);
    const int lane = threadIdx.x & 63, wave = threadIdx.x >> 6;
    for (int row = blockIdx.x * 8 + wave; row < MTOT; row += gridDim.x * 8) {
        const float rs = rsqrtf(g_ss2[row] * (1.0f / 1024.0f) + EPS); float* orow = p.out + (size_t)row * DM;
#pragma unroll
        for (int i = 0; i < 4; ++i) { const int c = 4 * (lane + 64 * i); f32x4 v = *(const f32x4*)(orow + c); const f32x4 gg = *(const f32x4*)(p.final_norm + c);
            v[0] *= rs * gg[0]; v[1] *= rs * gg[1]; v[2] *= rs * gg[2]; v[3] *= rs * gg[3]; *(f32x4*)(orow + c) = v; }
    }
}

extern "C" void kernel_launch(void* const* d_in, const int* in_sizes, int n_in, void* d_out, int out_size, void* d_ws, size_t ws_size, hipStream_t stream) {
    static int grid = 0;
    if (grid == 0) {
        int dev = 0, cus = 0, per_cu = 0;
        if (n_in != 14 || ws_size < (size_t)4 * MTOT * DM * 2) { fprintf(stderr, "kernel_launch: unexpected problem shape (n_in %d, ws %zu)\n", n_in, ws_size); grid = -1; return; }
        hipGetDevice(&dev); hipDeviceGetAttribute(&cus, hipDeviceAttributeMultiprocessorCount, dev);
        if (hipFuncSetAttribute((const void*)fwd_kernel, hipFuncAttributeMaxDynamicSharedMemorySize, LDS_TOTAL) != hipSuccess) { fprintf(stderr, "kernel_launch: hipFuncSetAttribute failed\n"); grid = -1; return; }
        if (hipOccupancyMaxActiveBlocksPerMultiprocessor(&per_cu, (const void*)fwd_kernel, NTHR, LDS_TOTAL) != hipSuccess || per_cu < 1) { fprintf(stderr, "kernel_launch: occupancy query says %d blocks per CU\n", per_cu); per_cu = 1; }
        (void)hipGetLastError();
        grid = cus * 1;
    }
    if (grid < 0) return;
    Params p{};
    const size_t WS_MAP = (size_t)4 * MTOT * DM * 2;
    if (ws_size >= WS_MAP + sizeof(unsigned) * XCD_BAR_WORDS) {
        p.bar = (unsigned*)((unsigned char*)d_ws + WS_MAP);
        if (hipMemsetAsync(p.bar, 0, sizeof(unsigned) * XCD_BAR_WORDS, stream) != hipSuccess) { fprintf(stderr, "kernel_launch: barrier memset failed\n"); return; }
    }
    p.xp = (const float*)d_in[0]; p.xs = (const float*)d_in[1]; p.attn_norm = (const float*)d_in[2]; p.w_in0 = (const float*)d_in[3];
    p.lq1 = (const float*)d_in[4]; p.lk1 = (const float*)d_in[5]; p.lq2 = (const float*)d_in[6]; p.lk2 = (const float*)d_in[7];
    p.subln = (const float*)d_in[8]; p.w_out0 = (const float*)d_in[9]; p.fnet_norm = (const float*)d_in[10]; p.w_in1 = (const float*)d_in[11];
    p.w_out1 = (const float*)d_in[12]; p.final_norm = (const float*)d_in[13];
    p.out = (float*)d_out; p.ws = (unsigned char*)d_ws;
    void* args[] = {&p};
    const hipError_t e = hipLaunchCooperativeKernel((const void*)fwd_kernel, dim3(grid), dim3(NTHR), args, LDS_TOTAL, stream);
    if (e != hipSuccess) fprintf(stderr, "kernel_launch: cooperative launch failed: %s (grid %d)\n", hipGetErrorString(e), grid);
}
```

```cpp
#include <hip/hip_runtime.h>
#include <hip/hip_cooperative_groups.h>
#include <cstdio>
#include <cstdint>
namespace cg = cooperative_groups;
namespace pg8 {
#define PG8_LAS __attribute__((address_space(3)))
typedef unsigned short bf16_t;
typedef short bf16x8 __attribute__((ext_vector_type(8)));
typedef float f32x4 __attribute__((ext_vector_type(4)));
typedef unsigned u32x4 __attribute__((ext_vector_type(4)));
constexpr int BM = 256, BK = 64, HALF = 128, HTB = HALF * BK * 2  , STAGE_BYTES = 8 * HTB, NXCD = 8, WGM = 8;

__host__ __device__ __forceinline__ int lds_byte(int r, int c) { const int st = (r >> 4) * 2 + (c >> 5), rr = r & 15, cc = c & 31, ob = rr * 64 + cc * 2; return st * 1024 + (ob ^ (((ob >> 9) & 1) << 5)); }
__host__ __device__ __forceinline__ void stage_rc(int b, int& R, int& C) { const int st = b / 1024, sb = b % 1024, swz = sb ^ (((sb >> 9) & 1) << 5); R = (st >> 1) * 16 + swz / 64; C = (st & 1) * 32 + (swz % 64) / 2; }
__host__ __device__ __forceinline__ int perm32(int rho) { const int n = rho >> 4, i = rho & 15; return 8 * (i >> 2) + 4 * n + (i & 3); }

struct Unit { int pm, pn; };
struct Gemm { const bf16_t* A; const bf16_t* Bt; int M, N, K, lda, ldb; };

struct StaticOrder {
    int nM, nN, nwg, G, c;
    __host__ __device__ void init(int M, int N, int G_, int c_) { nM = M / BM; nN = N / BM; nwg = nM * nN; G = G_; c = c_; }
    __host__ __device__ bool next(int i, Unit& u) const {
        const long L = (long)i * G + c; if (L >= nwg) return false;
        int wgid = (int)L; { const int q = nwg / NXCD, r = nwg % NXCD, xcd = wgid % NXCD, off = wgid / NXCD; wgid = (xcd < r ? xcd * (q + 1) : r * (q + 1) + (xcd - r) * q) + off; }
        const int nig = WGM * nN, gid = wgid / nig, fm = gid * WGM, gsz = (nM - fm) < WGM ? (nM - fm) : WGM;
        u.pm = fm + ((wgid % nig) % gsz); u.pn = (wgid % nig) / gsz; return true;
    }
    __device__ __forceinline__ void a_ready(const Unit&) const {}
    __device__ __forceinline__ void done(const Unit&) const {}
};
template <class Epi, class Sched, bool ALIGN_EPI = false, bool SP2 = false>
__device__ __forceinline__ void gemm_phase(PG8_LAS unsigned char* lds, const Gemm g, const Sched& S, const Epi& E) {
    const int tid = threadIdx.x, wid = __builtin_amdgcn_readfirstlane(tid >> 6), lane = tid & 63, wr = wid >> 2, wc = wid & 3, fr = lane & 15, fq = lane >> 4;
    const int K = g.K, nt = K / BK;
    unsigned voffA[2], voffB[2];
#pragma unroll
    for (int i = 0; i < 2; ++i) { int R, C; stage_rc(tid * 16 + i * 8192, R, C); const int Rb = Epi::PERM ? ((R & ~31) + perm32(R & 31)) : R;
        voffA[i] = (unsigned)(R * g.lda + C) * 2u; voffB[i] = (unsigned)(Rb * g.ldb + C) * 2u; }
    const size_t kstep = (size_t)(BK * 2);
    const size_t hstepA = (size_t)HALF * g.lda * 2, hstepB = (size_t)HALF * g.ldb * 2;
    const size_t tstepA = 2 * hstepA, tstepB = 2 * hstepB;
    const unsigned ldsw = (unsigned)wid * 1024u;
    const int aoff = lds_byte(wr * 64 + fr, fq * 8), boff = lds_byte(wc * 32 + fr, fq * 8);
#define PG8_SA(b, h) (((b) * 2 + (h)) * HTB)
#define PG8_SB(b, h) ((4 + (b) * 2 + (h)) * HTB)
#define PG8_STAGE(bufoff, gbase, voff) do { _Pragma("unroll") for (int _i = 0; _i < 2; ++_i) \
        __builtin_amdgcn_global_load_lds((const unsigned*)((const char*)(gbase) + (voff)[_i]), (PG8_LAS unsigned*)(lds + (bufoff) + ldsw + _i * 8192), 16, 0, 0); } while (0)
#define PG8_LDA(dst, b, h) do { _Pragma("unroll") for (int m = 0; m < 4; ++m) _Pragma("unroll") for (int k = 0; k < 2; ++k) dst[m][k] = *(const PG8_LAS bf16x8*)(lds + PG8_SA(b, h) + aoff + m * 2048 + k * 1024); } while (0)
#define PG8_LDB(dst, b, h) do { _Pragma("unroll") for (int n = 0; n < 2; ++n) _Pragma("unroll") for (int k = 0; k < 2; ++k) dst[n][k] = *(const PG8_LAS bf16x8*)(lds + PG8_SB(b, h) + boff + n * 2048 + k * 1024); } while (0)
#define PG8_MMA(ai, bj, At, Bt) do { __builtin_amdgcn_s_setprio(1); _Pragma("unroll") for (int m = 0; m < 4; ++m) _Pragma("unroll") for (int n = 0; n < 2; ++n) _Pragma("unroll") for (int k = 0; k < 2; ++k) \
        acc[ai][bj][m][n] = __builtin_amdgcn_mfma_f32_16x16x32_bf16(Bt[n][k], At[m][k], acc[ai][bj][m][n], 0, 0, 0); __builtin_amdgcn_s_setprio(0); } while (0)
#define PG8_WAIT_V(n) asm volatile("s_waitcnt vmcnt(" #n ")" ::: "memory")
#define PG8_WAIT_L(n) asm volatile("s_waitcnt lgkmcnt(" #n ")" ::: "memory")
#define PG8_BAR __builtin_amdgcn_s_barrier()
#define PG8_SCHED __builtin_amdgcn_sched_barrier(0)
    Unit cur, nxt; int ui = 0;
    if (!S.next(0, cur)) return;
    f32x4 acc[2][2][4][2];
#pragma unroll
    for (int a = 0; a < 2; ++a)
#pragma unroll
        for (int b = 0; b < 2; ++b)
#pragma unroll
            for (int m = 0; m < 4; ++m)
#pragma unroll
                for (int n = 0; n < 2; ++n) acc[a][b][m][n] = (f32x4){0.f, 0.f, 0.f, 0.f};
    bf16x8 At[4][2], B0[2][2], B1[2][2];
    const char* cA = (const char*)g.A + (size_t)cur.pm * tstepA; const char* cB = (const char*)g.Bt + (size_t)cur.pn * tstepB;
    S.a_ready(cur);
    if constexpr (SP2) {
        PG8_STAGE(PG8_SB(0, 0), cB, voffB); PG8_STAGE(PG8_SB(0, 1), cB + hstepB, voffB); PG8_STAGE(PG8_SA(0, 0), cA, voffA); PG8_STAGE(PG8_SA(0, 1), cA + hstepA, voffA);
        if (wr == 1) PG8_BAR;
        PG8_WAIT_V(2); PG8_BAR;
        PG8_STAGE(PG8_SB(1, 0), cB + kstep, voffB); PG8_STAGE(PG8_SA(1, 0), cA + kstep, voffA); PG8_STAGE(PG8_SB(1, 1), cB + hstepB + kstep, voffB);
        PG8_WAIT_V(6); PG8_BAR;
    } else {
        PG8_STAGE(PG8_SB(0, 0), cB, voffB); PG8_STAGE(PG8_SA(0, 0), cA, voffA); PG8_STAGE(PG8_SB(0, 1), cB + hstepB, voffB); PG8_STAGE(PG8_SA(0, 1), cA + hstepA, voffA);
        if (wr == 1) PG8_BAR;
        PG8_WAIT_V(4); PG8_BAR;
        PG8_STAGE(PG8_SB(1, 0), cB + kstep, voffB); PG8_STAGE(PG8_SA(1, 0), cA + kstep, voffA); PG8_STAGE(PG8_SB(1, 1), cB + hstepB + kstep, voffB);
        PG8_WAIT_V(6); PG8_BAR;
    }
    for (;;) {
        const bool has_next = S.next(ui + 1, nxt);
        const char* nA = has_next ? (const char*)g.A + (size_t)nxt.pm * tstepA : cA; const char* nB = has_next ? (const char*)g.Bt + (size_t)nxt.pn * tstepB : cB;
        for (int t = 0; t < nt; t += 2) {
            const bool last = (t == nt - 2);
            const char* a1 = cA + (size_t)(t + 1) * kstep;
            const char* a2 = last ? nA : cA + (size_t)(t + 2) * kstep; const char* b2 = last ? nB : cB + (size_t)(t + 2) * kstep;
            const char* a3 = a2 + kstep; const char* b3 = b2 + kstep;
            if (last && has_next) S.a_ready(nxt);
            if constexpr (SP2) {
            PG8_LDB(B0, 0, 0); PG8_LDB(B1, 0, 1); PG8_SCHED; PG8_LDA(At, 0, 0); PG8_STAGE(PG8_SA(1, 1), a1 + hstepA, voffA);
            PG8_WAIT_V(8); PG8_WAIT_L(0); PG8_BAR; PG8_MMA(0, 0, At, B0); PG8_MMA(0, 1, At, B1); PG8_BAR; PG8_SCHED;
            PG8_LDA(At, 0, 1); PG8_STAGE(PG8_SB(0, 0), b2, voffB); PG8_STAGE(PG8_SB(0, 1), b2 + hstepB, voffB); PG8_STAGE(PG8_SA(0, 0), a2, voffA);
            PG8_WAIT_V(8); PG8_WAIT_L(0); PG8_BAR; PG8_MMA(1, 0, At, B0); PG8_MMA(1, 1, At, B1); PG8_BAR; PG8_SCHED;
            PG8_LDB(B0, 1, 0); PG8_LDB(B1, 1, 1); PG8_SCHED; PG8_LDA(At, 1, 0); PG8_STAGE(PG8_SA(0, 1), a2 + hstepA, voffA);
            PG8_WAIT_V(8); PG8_WAIT_L(0); PG8_BAR; PG8_MMA(0, 0, At, B0); PG8_MMA(0, 1, At, B1); PG8_BAR; PG8_SCHED;
            PG8_LDA(At, 1, 1); PG8_STAGE(PG8_SB(1, 0), b3, voffB); PG8_STAGE(PG8_SB(1, 1), b3 + hstepB, voffB); PG8_STAGE(PG8_SA(1, 0), a3, voffA);
            PG8_WAIT_V(8); PG8_WAIT_L(0); PG8_BAR; PG8_MMA(1, 0, At, B0); PG8_MMA(1, 1, At, B1); PG8_BAR; PG8_SCHED;
            } else {
            PG8_LDB(B0, 0, 0); PG8_SCHED; PG8_LDA(At, 0, 0); PG8_STAGE(PG8_SA(1, 1), a1 + hstepA, voffA);
            PG8_WAIT_L(8); PG8_BAR; PG8_WAIT_L(0); PG8_MMA(0, 0, At, B0); PG8_BAR; PG8_SCHED;
            PG8_LDB(B1, 0, 1); PG8_STAGE(PG8_SB(0, 0), b2, voffB);
            PG8_BAR; PG8_WAIT_L(0); PG8_MMA(0, 1, At, B1); PG8_BAR;
            PG8_LDA(At, 0, 1); PG8_STAGE(PG8_SA(0, 0), a2, voffA);
            PG8_BAR; PG8_WAIT_L(0); PG8_MMA(1, 0, At, B0); PG8_BAR; PG8_SCHED;
            PG8_STAGE(PG8_SB(0, 1), b2 + hstepB, voffB);
            PG8_WAIT_V(6); PG8_BAR; PG8_MMA(1, 1, At, B1); PG8_BAR;
            PG8_LDB(B0, 1, 0); PG8_SCHED; PG8_LDA(At, 1, 0); PG8_STAGE(PG8_SA(0, 1), a2 + hstepA, voffA);
            PG8_WAIT_L(8); PG8_BAR; PG8_WAIT_L(0); PG8_MMA(0, 0, At, B0); PG8_BAR; PG8_SCHED;
            PG8_LDB(B1, 1, 1); PG8_STAGE(PG8_SB(1, 0), b3, voffB);
            PG8_BAR; PG8_WAIT_L(0); PG8_MMA(0, 1, At, B1); PG8_BAR;
            PG8_LDA(At, 1, 1); PG8_STAGE(PG8_SA(1, 0), a3, voffA);
            PG8_BAR; PG8_WAIT_L(0); PG8_MMA(1, 0, At, B0); PG8_BAR; PG8_SCHED;
            PG8_STAGE(PG8_SB(1, 1), b3 + hstepB, voffB);
            PG8_WAIT_V(6); PG8_BAR; PG8_MMA(1, 1, At, B1); PG8_BAR;
            }
        }
        if constexpr (ALIGN_EPI) { if (wr == 0) PG8_BAR; }
        if constexpr (!Epi::AFTER_DRAIN) { E(acc, cur, wr, wc, fr, fq); S.done(cur); }
        if (!has_next) break;
#pragma unroll
        for (int a = 0; a < 2; ++a)
#pragma unroll
            for (int b = 0; b < 2; ++b)
#pragma unroll
                for (int m = 0; m < 4; ++m)
#pragma unroll
                    for (int n = 0; n < 2; ++n) acc[a][b][m][n] = (f32x4){0.f, 0.f, 0.f, 0.f};
        cur = nxt; cA = nA; cB = nB; ++ui;
        if constexpr (ALIGN_EPI) { if (wr == 1) PG8_BAR; }
    }
    PG8_WAIT_V(0);
    if constexpr (!ALIGN_EPI) { if (wr == 0) PG8_BAR; }
    PG8_BAR;
    if constexpr (Epi::AFTER_DRAIN) { E.fused(acc, cur, wr, wc, fr, fq, lds, wid, lane); S.done(cur); }
#undef PG8_SA
#undef PG8_SB
#undef PG8_STAGE
#undef PG8_LDA
#undef PG8_LDB
#undef PG8_MMA
#undef PG8_WAIT_V
#undef PG8_WAIT_L
#undef PG8_BAR
#undef PG8_SCHED
}
}
#ifndef LAS
#define LAS __attribute__((address_space(3)))
#endif

#define XB_TMO      128
#define XB_XCNT(j)  (256  + 64 * (j))
#define XB_XSUB(j)  (1280 + 64 * (j))
#define XB_XGEN(j)  (2304 + 64 * (j))
#define XB_TOP      3328
#define XB_TOPGEN   3392
#define XCD_BAR_WORDS 3456
#define XB_SPIN_CAP (1u << 18)

__device__ __forceinline__ unsigned xb_ld(unsigned* p)              { return __hip_atomic_load(p, __ATOMIC_RELAXED, __HIP_MEMORY_SCOPE_AGENT); }
__device__ __forceinline__ unsigned xb_add(unsigned* p, unsigned v) { return __hip_atomic_fetch_add(p, v, __ATOMIC_RELAXED, __HIP_MEMORY_SCOPE_AGENT); }
__device__ __forceinline__ unsigned xb_xcc_id() { return (unsigned)__builtin_amdgcn_s_getreg((3 << 11) | 20) & 0xFu; }
#define XB_SPIN(cond, bar) do { unsigned _sp = 0; while (cond) { __builtin_amdgcn_s_sleep(1); \
    if ((++_sp & 255u) == 0u) { if (xb_ld(&(bar)[XB_TMO])) break; if (_sp > XB_SPIN_CAP) { atomicAdd(&(bar)[XB_TMO], 1u); break; } } } } while (0)

struct XcdBarrier {
    unsigned* bar; unsigned x;
    volatile LAS unsigned* st;
};

__device__ __forceinline__ XcdBarrier xcd_barrier_post(unsigned* bar, volatile LAS unsigned* st) {
    XcdBarrier b; b.bar = bar; b.x = xb_xcc_id(); b.st = st;
    if (threadIdx.x == 0) (void)xb_add(&bar[XB_XCNT(b.x)], 1u);
    return b;
}
__device__ __forceinline__ void xcd_barrier_complete(unsigned* bar, unsigned x, unsigned& nloc, unsigned& nx) {
    const unsigned G = gridDim.x * gridDim.y * gridDim.z;
    unsigned sum, cnt, mine, sp = 0u;
    for (;;) {
        sum = 0u; cnt = 0u; mine = 0u;
#pragma unroll
        for (unsigned j = 0; j < 16; ++j) { const unsigned c = xb_ld(&bar[XB_XCNT(j)]); sum += c; cnt += (c > 0u) ? 1u : 0u; mine = (j == x) ? c : mine; }
        if (sum == G) break;
        __builtin_amdgcn_s_sleep(1);
        if ((++sp & 255u) == 0u) { if (xb_ld(&bar[XB_TMO])) break; if (sp > XB_SPIN_CAP) { atomicAdd(&bar[XB_TMO], 1u); break; } }
    }
    nloc = mine > 0u ? mine : 1u; nx = cnt > 0u ? cnt : 1u;
}

__device__ __forceinline__ void xcd_barrier(const XcdBarrier& b) {
    asm volatile("s_waitcnt vmcnt(0)" ::: "memory");
    __syncthreads();
    if (threadIdx.x == 0) {
        unsigned* bar = b.bar;
        __builtin_amdgcn_s_waitcnt(0);
        unsigned nloc = b.st[0], nx = b.st[1];
        if (nloc == 0u) { xcd_barrier_complete(bar, b.x, nloc, nx); b.st[0] = nloc; b.st[1] = nx; }
        const unsigned old = xb_add(&bar[XB_XSUB(b.x)], 1u);
        const unsigned gen = old / nloc;
        if (old + 1u == (gen + 1u) * nloc) {
            __builtin_amdgcn_fence(__ATOMIC_RELEASE, "agent");
            asm volatile("s_waitcnt vmcnt(0)" ::: "memory");
            const unsigned og = xb_add(&bar[XB_TOP], 1u);
            const unsigned tg = og / nx;
            if (og + 1u == (tg + 1u) * nx) xb_add(&bar[XB_TOPGEN], 1u);
            else XB_SPIN(xb_ld(&bar[XB_TOPGEN]) == tg, bar);
            __builtin_amdgcn_fence(__ATOMIC_ACQUIRE, "agent");
            xb_add(&bar[XB_XGEN(b.x)], 1u);
            asm volatile("s_waitcnt vmcnt(0)" ::: "memory");
        } else {
            XB_SPIN(xb_ld(&bar[XB_XGEN(b.x)]) == gen, bar);
            __builtin_amdgcn_fence(__ATOMIC_ACQUIRE, "agent");
            asm volatile("s_waitcnt vmcnt(0)" ::: "memory");
        }
    }
    __syncthreads();
}


__device__ __attribute__((aligned(256))) unsigned g_bar[XCD_BAR_WORDS];
#ifndef LAS
#define LAS __attribute__((address_space(3)))
#endif
typedef unsigned short bf16_t;
typedef short bf16x8 __attribute__((ext_vector_type(8)));
typedef short s16x4 __attribute__((ext_vector_type(4)));
typedef float f32x4 __attribute__((ext_vector_type(4)));
typedef float f32x16 __attribute__((ext_vector_type(16)));
typedef unsigned u32x4 __attribute__((ext_vector_type(4)));
typedef unsigned u32x2 __attribute__((ext_vector_type(2)));
typedef float f32x2_t __attribute__((ext_vector_type(2)));
typedef __bf16 bf16x2_t __attribute__((ext_vector_type(2)));

constexpr int DM = 1024, MTOT = 32768, SEQP = 16384, SEQS = 2048;
constexpr int NTHR = 512;
constexpr float EPS = 1e-6f, SUBLN_EPS = 1e-5f, LOG2E = 1.4426950408889634f;
constexpr float QSCALE = 0.125f * LOG2E;
constexpr int XB_LDS_OFF = 131072, LDS_TOTAL = 131072 + 256;

__device__ __attribute__((aligned(256))) bf16_t g_w0t[4096 * 1024];
__device__ __attribute__((aligned(256))) bf16_t g_wo0t[1024 * 1024];
__device__ __attribute__((aligned(256))) bf16_t g_ws1[1024 * 1024];
__device__ __attribute__((aligned(256))) bf16_t g_w1t[3072 * 1024];
__device__ __attribute__((aligned(256))) bf16_t g_wo1t[1024 * 1024];
__device__ __attribute__((aligned(256))) bf16_t g_tab128[256 * 128];
__device__ __attribute__((aligned(256))) bf16_t g_tab16[32 * 32];
__device__ __attribute__((aligned(256))) float g_r0[MTOT];
__device__ __attribute__((aligned(256))) float g_ss1[MTOT];
__device__ __attribute__((aligned(256))) float g_ss2[MTOT];
__device__ __attribute__((aligned(256))) unsigned g_nrm[64];
__device__ __attribute__((aligned(256))) unsigned g_ctr[4];

struct Params {
    const float* xp; const float* xs; const float* attn_norm; const float* w_in0; const float* lq1; const float* lk1; const float* lq2; const float* lk2;
    const float* subln; const float* w_out0; const float* fnet_norm; const float* w_in1; const float* w_out1; const float* final_norm;
    float* out; unsigned char* ws; unsigned* bar;
};

__device__ __forceinline__ unsigned pk2(float lo, float hi) { f32x2_t v = {lo, hi}; bf16x2_t b = __builtin_convertvector(v, bf16x2_t); return __builtin_bit_cast(unsigned, b); }
__device__ __forceinline__ float bf_lo(unsigned u) { return __uint_as_float(u << 16); }
__device__ __forceinline__ float bf_hi(unsigned u) { return __uint_as_float(u & 0xffff0000u); }
__device__ __forceinline__ float wave_sum(float v) { v += __shfl_xor(v, 32); v += __shfl_xor(v, 16); v += __shfl_xor(v, 8); v += __shfl_xor(v, 4); v += __shfl_xor(v, 2); v += __shfl_xor(v, 1); return v; }
__device__ __forceinline__ float silu_f(float z) { return z / (1.0f + __expf(-z)); }
__device__ __forceinline__ int crow(int r, int hi) { return (r & 3) + 8 * (r >> 2) + 4 * hi; }
#define BLK_SYNC() __syncthreads()

struct EpiRowBf16 {
    static constexpr bool PERM = true, AFTER_DRAIN = false;
    bf16_t* b0; bf16_t* b1; bf16_t* b2; bf16_t* b3; int ld0, ld1; int split_cols; const float* rstat; int stat_is_sumsq; float scale0; unsigned* nrm;
    __device__ __forceinline__ void operator()(const pg8::f32x4 (&acc)[2][2][4][2], const pg8::Unit& u, int wr, int wc, int fr, int fq) const {
        const int row0 = u.pm * 256 + wr * 64 + fr; int colt = u.pn * 256; const int t = colt / split_cols; colt -= t * split_cols;
        bf16_t* b = (t == 0) ? b0 : (t == 1) ? b1 : (t == 2) ? b2 : b3; const int ld = (t == 0) ? ld0 : ld1; const float sc = (t == 0) ? scale0 : 1.0f;
        const int col0 = colt + wc * 32 + 8 * fq; const bool donrm = (nrm != nullptr) && (t < 2); float mx[2] = {0.f, 0.f};
#pragma unroll
        for (int ai = 0; ai < 2; ++ai)
#pragma unroll
            for (int m = 0; m < 4; ++m) {
                const int row = row0 + ai * 128 + m * 16; float rs = rstat[row];
                if (stat_is_sumsq) rs = rsqrtf(rs * (1.0f / 1024.0f) + EPS);
                rs *= sc; bf16_t* rowp = b + (size_t)row * ld + col0;
#pragma unroll
                for (int bj = 0; bj < 2; ++bj) { const pg8::f32x4 v0 = acc[ai][bj][m][0] * rs, v1 = acc[ai][bj][m][1] * rs;
                    u32x4 w; w.x = pk2(v0[0], v0[1]); w.y = pk2(v0[2], v0[3]); w.z = pk2(v1[0], v1[1]); w.w = pk2(v1[2], v1[3]);
                    *(u32x4*)(rowp + bj * 128) = w;
                    if (donrm) { float ps = (v0[0] * v0[0] + v0[1] * v0[1]) + (v0[2] * v0[2] + v0[3] * v0[3]) + (v1[0] * v1[0] + v1[1] * v1[1]) + (v1[2] * v1[2] + v1[3] * v1[3]);
                        ps += __shfl_xor(ps, 16); ps += __shfl_xor(ps, 32); mx[bj] = fmaxf(mx[bj], ps); } }
            }
        if (donrm) {
#pragma unroll
            for (int bj = 0; bj < 2; ++bj) { float v = mx[bj]; v = fmaxf(v, __shfl_xor(v, 1)); v = fmaxf(v, __shfl_xor(v, 2)); v = fmaxf(v, __shfl_xor(v, 4)); v = fmaxf(v, __shfl_xor(v, 8));
                if ((threadIdx.x & 63) == 0) atomicMax(nrm + t * 32 + ((colt + bj * 128 + wc * 32) >> 6) * 2 + (wc & 1), __float_as_uint(v)); }
        }
    }
};
struct EpiFold {
    static constexpr bool PERM = true, AFTER_DRAIN = false;
    bf16_t* O; int g;
    __device__ __forceinline__ void operator()(const pg8::f32x4 (&acc)[2][2][4][2], const pg8::Unit& u, int wr, int wc, int fr, int fq) const {
        const int col0 = u.pn * 256 + wc * 32 + 8 * fq;
#pragma unroll
        for (int ai = 0; ai < 2; ++ai)
#pragma unroll
            for (int m = 0; m < 4; ++m) {
                const int j = wr * 64 + m * 16 + fr; bf16_t* rowp = O + (size_t)(ai * 1024 + g * 128 + j) * 1024 + col0;
#pragma unroll
                for (int bj = 0; bj < 2; ++bj) { const pg8::f32x4 v0 = acc[ai][bj][m][0], v1 = acc[ai][bj][m][1];
                    u32x4 w; w.x = pk2(v0[0], v0[1]); w.y = pk2(v0[2], v0[3]); w.z = pk2(v1[0], v1[1]); w.w = pk2(v1[2], v1[3]);
                    *(u32x4*)(rowp + bj * 128) = w; }
            }
    }
};
struct EpiResid {
    static constexpr bool PERM = false, AFTER_DRAIN = false;
    const float* resA; const float* resB; float* out; bf16_t* outb; float* ss;
    __device__ __forceinline__ void operator()(const pg8::f32x4 (&acc)[2][2][4][2], const pg8::Unit& u, int wr, int wc, int fr, int fq) const {
        const int row0 = u.pm * 256 + wr * 64 + fr; const int col0 = u.pn * 256 + wc * 32 + 4 * fq;
#pragma unroll
        for (int ai = 0; ai < 2; ++ai)
#pragma unroll
            for (int m = 0; m < 4; ++m) {
                const int row = row0 + ai * 128 + m * 16;
                const float* rp = (row < SEQP) ? (resA + (size_t)row * DM) : (resB + (size_t)(row - SEQP) * DM);
                float s = 0.f;
#pragma unroll
                for (int bj = 0; bj < 2; ++bj)
#pragma unroll
                    for (int n = 0; n < 2; ++n) { const int col = col0 + bj * 128 + n * 16;
                        const pg8::f32x4 r = *(const pg8::f32x4*)(rp + col); const pg8::f32x4 v = r + acc[ai][bj][m][n];
                        *(pg8::f32x4*)(out + (size_t)row * DM + col) = v;
                        if (outb) { u32x2 w; w.x = pk2(v[0], v[1]); w.y = pk2(v[2], v[3]); *(u32x2*)(outb + (size_t)row * DM + col) = w; }
                        s += (v[0] * v[0] + v[1] * v[1]) + (v[2] * v[2] + v[3] * v[3]); }
                s += __shfl_xor(s, 16); s += __shfl_xor(s, 32);
                if (fq == 0) atomicAdd(ss + row, s);
            }
    }
};
struct OneUnit { int pn; __device__ bool next(int i, pg8::Unit& u) const { if (i > 0) return false; u.pm = 0; u.pn = pn; return true; }
    __device__ __forceinline__ void a_ready(const pg8::Unit&) const {} __device__ __forceinline__ void done(const pg8::Unit&) const {} };

__device__ __forceinline__ void transpose_item(const float* W, int ldw, const float* gain, bf16_t* WT, LAS float* scr, int item, int nblk, int lane) {
    const int kb = item / nblk, nb = item % nblk, k0 = 64 * kb, n0 = 32 * nb;
#pragma unroll 8
    for (int i = 0; i < 32; ++i) { const int kk = 2 * i + (lane >> 5); const float gk = gain ? gain[k0 + kk] : 1.0f; scr[kk * 33 + (lane & 31)] = W[(size_t)(k0 + kk) * ldw + n0 + (lane & 31)] * gk; }
    asm volatile("s_waitcnt lgkmcnt(0)" ::: "memory");
    const int c = lane & 7;
#pragma unroll
    for (int j = 0; j < 4; ++j) { const int n = (lane >> 3) + 8 * j; const LAS float* s = scr + (8 * c) * 33 + n;
        u32x4 o; o.x = pk2(s[0 * 33], s[1 * 33]); o.y = pk2(s[2 * 33], s[3 * 33]); o.z = pk2(s[4 * 33], s[5 * 33]); o.w = pk2(s[6 * 33], s[7 * 33]);
        *(u32x4*)(WT + (size_t)(n0 + n) * 1024 + k0 + 8 * c) = o; }
    asm volatile("s_waitcnt lgkmcnt(0)" ::: "memory");
}

__device__ __forceinline__ void phase0(const Params& p, LAS unsigned char* lds, bf16_t* XB) {
    const int tid = threadIdx.x, lane = tid & 63, wave = tid >> 6;
    const int gw = blockIdx.x * 8 + wave, NGW = gridDim.x * 8;
    for (int row = gw; row < MTOT; row += NGW) {
        const float* xr = (row < SEQP) ? (p.xp + (size_t)row * DM) : (p.xs + (size_t)(row - SEQP) * DM);
        f32x4 v[4]; float ss = 0.f;
#pragma unroll
        for (int i = 0; i < 4; ++i) { v[i] = *(const f32x4*)(xr + 4 * (lane + 64 * i)); ss += (v[i][0] * v[i][0] + v[i][1] * v[i][1]) + (v[i][2] * v[i][2] + v[i][3] * v[i][3]); }
        ss = wave_sum(ss);
        if (lane == 0) g_r0[row] = rsqrtf(ss * (1.0f / 1024.0f) + EPS);
#pragma unroll
        for (int i = 0; i < 4; ++i) { u32x2 w; w.x = pk2(v[i][0], v[i][1]); w.y = pk2(v[i][2], v[i][3]); *(u32x2*)(XB + (size_t)row * DM + 4 * (lane + 64 * i)) = w; }
    }
    for (int i = blockIdx.x * NTHR + tid; i < MTOT; i += gridDim.x * NTHR) { g_ss1[i] = 0.f; g_ss2[i] = 0.f; }
    if (blockIdx.x == 0 && tid < 64) { g_nrm[tid] = 0u; if (tid < 4) g_ctr[tid] = 0u; }
    if (blockIdx.x == 0) for (int i = tid; i < XCD_BAR_WORDS; i += NTHR) g_bar[i] = 0u;
    LAS float* scr = (LAS float*)(lds + wave * 8704);
    constexpr int I0 = 16 * 128, I1 = 16 * 32, I2 = 16 * 64, NIT = I0 + 2 * I1 + I2;
    for (int it = gw; it < NIT; it += NGW) {
        int r = it;
        if (r < I0) { transpose_item(p.w_in0, 4096, p.attn_norm, g_w0t, scr, r, 128, lane); continue; } r -= I0;
        if (r < I1) { transpose_item(p.w_out0, 1024, nullptr, g_wo0t, scr, r, 32, lane); continue; } r -= I1;
        if (r < I2) { transpose_item(p.w_in1, 2048, p.fnet_norm, g_w1t, scr, r, 64, lane); continue; } r -= I2;
        transpose_item(p.w_out1, 1024, nullptr, g_wo1t, scr, r, 32, lane);
    }
    for (int i = blockIdx.x * NTHR + tid; i < 256 * 128; i += gridDim.x * NTHR) {
        const int rr = i >> 7, n = i & 127, k = rr & 127, part = rr >> 7; const float th = (float)((k * n) & 127) * (6.283185307179586f / 128.0f);
        const float v = part ? sinf(th) : cosf(th); g_tab128[i] = (bf16_t)(pk2(v, 0.f) & 0xffffu);
    }
    for (int i = blockIdx.x * NTHR + tid; i < 32 * 32; i += gridDim.x * NTHR) {
        const int kk = i >> 5, j = i & 31, k1 = kk & 15, po = kk >> 4, n1 = j & 15, pi = j >> 4; const float th = (float)((k1 * n1) & 15) * (6.283185307179586f / 16.0f);
        float v; if (po == 0) v = pi ? -sinf(th) : cosf(th); else v = pi ? -cosf(th) : -sinf(th);
        g_tab16[i] = (bf16_t)(pk2(v, 0.f) & 0xffffu);
    }
}

constexpr int AT_KP = 144, AT_VP = 320, AT_K2 = 64 * AT_KP, AT_V = 2 * 64 * AT_KP, AT_STAGE = AT_V + 64 * AT_VP, AT_XP = 528;
typedef short v4i16_t __attribute__((ext_vector_type(4)));
__device__ __forceinline__ s16x4 tr_read(LAS const unsigned char* p) { return __builtin_bit_cast(s16x4, __builtin_amdgcn_ds_read_tr16_b64_v4i16((LAS v4i16_t*)p)); }
__device__ __forceinline__ bf16x8 cat8(s16x4 a, s16x4 b) { return (bf16x8){a[0], a[1], a[2], a[3], b[0], b[1], b[2], b[3]}; }
__device__ __forceinline__ bf16x8 neg8(bf16x8 a) { typedef int i32x4 __attribute__((ext_vector_type(4))); i32x4 v = __builtin_bit_cast(i32x4, a); v = v ^ (int)0x80008000; return __builtin_bit_cast(bf16x8, v); }
#define MFMA32(a, b, c) __builtin_amdgcn_mfma_f32_32x32x16_bf16((a), (b), (c), 0, 0, 0)

__device__ __forceinline__ void attn_phase(const Params& p, LAS unsigned char* lds, const bf16_t* Qb, const bf16_t* Kb, const bf16_t* Vb, const bf16_t* Zb, bf16_t* Ob, unsigned* ctr) {
    const int tid = threadIdx.x, lane = tid & 63, wave = __builtin_amdgcn_readfirstlane(tid >> 6), r32 = lane & 31, hi = lane >> 5;
    const int map = wave >> 2, qs = wave & 3;
    float lam;
    { const float a = wave_sum(p.lq1[lane] * p.lk1[lane]), b = wave_sum(p.lq2[lane] * p.lk2[lane]); lam = expf(a) - expf(b) + 0.2f; }
    const int g16 = lane >> 4, i16 = lane & 15, tq = i16 >> 2, tp = i16 & 3;
    LAS unsigned* qword = (LAS unsigned*)(lds + 3 * AT_STAGE);
    for (;;) {
        if (tid == 0) *qword = atomicAdd(ctr, 1u);
        BLK_SYNC();
        const int unit = (int)*qword;
        if (unit >= 2048) break;
        int R0s, S, h, q0;
        if (unit < 1024) { R0s = 0; S = SEQP; h = 7 - (unit >> 7); q0 = (unit & 127) * 128; }
        else { const int v = unit - 1024; h = 7 - (v >> 7); R0s = SEQP + ((v >> 4) & 7) * SEQS; S = SEQS; q0 = (v & 15) * 128; }
        const float slope2 = exp2f(-(float)(h + 1)) * LOG2E;
        const int qrow = R0s + q0 + qs * 32 + r32;
        bf16x8 qf[4];
        { const bf16_t* qp = Qb + (size_t)qrow * DM + h * 128 + map * 64 + hi * 8;
          float qq = 0.f;
#pragma unroll
          for (int st = 0; st < 4; ++st) { qf[st] = *(const bf16x8*)(qp + st * 16);
#pragma unroll
              for (int e = 0; e < 8; ++e) { const float qv = __uint_as_float(((unsigned)(unsigned short)qf[st][e]) << 16); qq = __builtin_fmaf(qv, qv, qq); } }
          qq += __shfl_xor(qq, 32);
#pragma unroll
          for (int sh = 1; sh < 32; sh <<= 1) qq = fmaxf(qq, __shfl_xor(qq, sh));
          LAS float* wst = (LAS float*)(lds + 3 * AT_STAGE + 64);
          if (lane == 0) wst[wave * 2] = qq;
        }
        const int dt0 = q0 >> 6, NTLS = S / 64;
        const float nslope2 = -slope2;
        const float qposf = (float)(q0 + qs * 32 + r32 - 4 * hi);
        float l = 0.f;
        f32x16 o[4];
#pragma unroll
        for (int db = 0; db < 4; ++db)
#pragma unroll
            for (int r = 0; r < 16; ++r) o[db][r] = 0.f;
        const int srow = tid >> 4, sch = tid & 15;
        const bf16_t* gk = Kb + (size_t)(R0s + srow) * DM + h * 128 + sch * 8;
        const ptrdiff_t vk = Vb - Kb;
        const int ldk = (sch >> 3) * AT_K2 + srow * AT_KP + (sch & 7) * 16, ldv = AT_V + srow * AT_VP + sch * 16;
#define AT_GSRC(i) (gk + ((i) >= 2 ? vk : 0) + (size_t)(((i) & 1) * 32) * DM)
#define AT_LDST(i) (((i) >= 2 ? ldv + ((i) & 1) * 32 * AT_VP : ldk + ((i) & 1) * 32 * AT_KP))
        int lbase = dt0, skipat = 0x3fffffff, ntl = 2;
#define TIDX(j) (lbase + (j) + ((lbase + (j) >= skipat) ? 2 : 0))
#pragma unroll 1
        for (int pass = 0; pass < 2; ++pass) {
        if (pass == 1) {
            float lr = l + __shfl_xor(l, 32);
#pragma unroll
            for (int sh = 1; sh < 32; sh <<= 1) lr = fminf(lr, __shfl_xor(lr, sh));
            LAS float* wst = (LAS float*)(lds + 3 * AT_STAGE + 64);
            if (lane == 0) wst[wave * 2 + 1] = lr;
            BLK_SYNC();
            float thr = -1.0e30f;
#pragma unroll
            for (int mm = 0; mm < 2; ++mm) { const int e = (2 * h + mm) * 2;
                const float kn2 = __uint_as_float(g_nrm[32 + e]) + __uint_as_float(g_nrm[32 + e + 1]);
                float qmx = 0.f, lmn = 1.0e30f;
#pragma unroll
                for (int w = 0; w < 4; ++w) { qmx = fmaxf(qmx, wst[(mm * 4 + w) * 2]); lmn = fminf(lmn, wst[(mm * 4 + w) * 2 + 1]); }
                thr = fmaxf(thr, sqrtf(qmx * kn2) * 1.02f - log2f(lmn) + 0.05f); }
            thr += 25.0f - log2f(1.0f - exp2f(-slope2));
            const float dminf = fminf(fmaxf(ceilf(thr / slope2), 1.0f), 1.0e6f); const int dmin = (int)dminf;
            int lo = q0 - dmin + 1; lo = lo < 0 ? 0 : lo; int hiK = q0 + 127 + dmin - 1; hiK = hiK > S - 1 ? S - 1 : hiK;
            int t_lo = lo >> 6, t_hi = hiK >> 6; if (t_hi > NTLS - 1) t_hi = NTLS - 1;
            lbase = t_lo; skipat = dt0; ntl = (t_hi - t_lo + 1) - 2;
        }
        if (ntl > 0) {
        u32x4 stg[4];
#pragma unroll
        for (int i = 0; i < 4; ++i) stg[i] = *(const u32x4*)(AT_GSRC(i) + (size_t)TIDX(0) * 64 * DM);
#pragma unroll
        for (int i = 0; i < 4; ++i) *(LAS u32x4*)(lds + AT_LDST(i)) = stg[i];
        if (ntl > 1) {
#pragma unroll
            for (int i = 0; i < 4; ++i) stg[i] = *(const u32x4*)(AT_GSRC(i) + (size_t)TIDX(1) * 64 * DM);
#pragma unroll
            for (int i = 0; i < 4; ++i) *(LAS u32x4*)(lds + AT_STAGE + AT_LDST(i)) = stg[i];
        }
        if (ntl > 2) {
#pragma unroll
            for (int i = 0; i < 4; ++i) stg[i] = *(const u32x4*)(AT_GSRC(i) + (size_t)TIDX(2) * 64 * DM);
        }
        __builtin_amdgcn_s_waitcnt(0x0F70);
        BLK_SYNC();
        const int koff = map * AT_K2 + r32 * AT_KP + hi * 16, voff = AT_V + (4 * hi + tq) * AT_VP + (16 * (g16 & 1) + 4 * tp) * 2;
        int soff = 0;
        for (int tt = 0; tt < ntl; ++tt) {
            const int s1off = (soff == 2 * AT_STAGE) ? 0 : soff + AT_STAGE, s2off = (s1off == 2 * AT_STAGE) ? 0 : s1off + AT_STAGE;
            f32x16 s0, s1;
#pragma unroll
            for (int r = 0; r < 16; ++r) { s0[r] = 0.f; s1[r] = 0.f; }
            bf16x8 kf0[4], kf1[4];
#pragma unroll
            for (int st = 0; st < 4; ++st) { kf0[st] = *(LAS const bf16x8*)(lds + soff + koff + st * 32); kf1[st] = *(LAS const bf16x8*)(lds + soff + koff + 32 * AT_KP + st * 32); }
#pragma unroll
            for (int st = 0; st < 4; ++st) s0 = MFMA32(kf0[st], qf[st], s0);
#pragma unroll
            for (int st = 0; st < 4; ++st) s1 = MFMA32(kf1[st], qf[st], s1);
            __builtin_amdgcn_sched_barrier(0);
            if (tt + 2 < ntl) {
#pragma unroll
                for (int i = 0; i < 4; ++i) *(LAS u32x4*)(lds + s2off + AT_LDST(i)) = stg[i];
            }
            if (tt + 3 < ntl) {
#pragma unroll
                for (int i = 0; i < 4; ++i) stg[i] = *(const u32x4*)(AT_GSRC(i) + (size_t)TIDX(tt + 3) * 64 * DM);
            }
            LAS const unsigned char* vbase = lds + soff + voff;
            bf16x8 vf[2][4];
#pragma unroll
            for (int ks = 0; ks < 4; ++ks) { LAS const unsigned char* a = vbase + (16 * ks) * AT_VP; vf[0][ks] = cat8(tr_read(a), tr_read(a + 8 * AT_VP)); }
            __builtin_amdgcn_sched_barrier(0);
            const float d0 = qposf - (float)(TIDX(tt) * 64);
            float rs = 0.f;
#pragma unroll
            for (int r = 0; r < 16; ++r) { const float c = (float)((r & 3) + 8 * (r >> 2));
                s0[r] = __builtin_amdgcn_exp2f(__builtin_fmaf(nslope2, fabsf(d0 - c), s0[r]));
                s1[r] = __builtin_amdgcn_exp2f(__builtin_fmaf(nslope2, fabsf(d0 - (32.0f + c)), s1[r]));
                rs += s0[r] + s1[r]; }
            l += rs;
            bf16x8 pf[4];
#pragma unroll
            for (int s = 0; s < 2; ++s) {
                u32x4 w0, w1;
                w0.x = pk2(s0[8 * s + 0], s0[8 * s + 1]); w0.y = pk2(s0[8 * s + 2], s0[8 * s + 3]); w0.z = pk2(s0[8 * s + 4], s0[8 * s + 5]); w0.w = pk2(s0[8 * s + 6], s0[8 * s + 7]);
                w1.x = pk2(s1[8 * s + 0], s1[8 * s + 1]); w1.y = pk2(s1[8 * s + 2], s1[8 * s + 3]); w1.z = pk2(s1[8 * s + 4], s1[8 * s + 5]); w1.w = pk2(s1[8 * s + 6], s1[8 * s + 7]);
                pf[s] = __builtin_bit_cast(bf16x8, w0); pf[2 + s] = __builtin_bit_cast(bf16x8, w1);
            }
            __builtin_amdgcn_sched_barrier(0);
#pragma unroll
            for (int db = 0; db < 4; ++db) {
                if (db < 3) {
#pragma unroll
                    for (int ks = 0; ks < 4; ++ks) { LAS const unsigned char* a = vbase + (16 * ks) * AT_VP + (db + 1) * 64; vf[(db + 1) & 1][ks] = cat8(tr_read(a), tr_read(a + 8 * AT_VP)); }
                }
#pragma unroll
                for (int ks = 0; ks < 4; ++ks) o[db] = MFMA32(vf[db & 1][ks], pf[ks], o[db]);
                __builtin_amdgcn_sched_barrier(0);
            }
            BLK_SYNC();
            soff = s1off;
        }
        }
        }
#undef TIDX
#undef AT_GSRC
#undef AT_LDST
        l += __shfl_xor(l, 32);
        const float inv = 1.0f / l;
#pragma unroll
        for (int db = 0; db < 4; ++db)
#pragma unroll
            for (int r = 0; r < 16; ++r) o[db][r] *= inv;
        LAS unsigned char* xq = lds + (qs * 32 + r32) * AT_XP;
        if (map == 1) {
#pragma unroll
            for (int db = 0; db < 4; ++db)
#pragma unroll
                for (int rg = 0; rg < 4; ++rg) { const int d = 32 * db + 8 * rg + 4 * hi;
                    *(LAS f32x4*)(xq + d * 4) = (f32x4){o[db][4 * rg], o[db][4 * rg + 1], o[db][4 * rg + 2], o[db][4 * rg + 3]}; }
        }
        BLK_SYNC();
        if (map == 0) {
            float ss = 0.f;
#pragma unroll
            for (int db = 0; db < 4; ++db)
#pragma unroll
                for (int rg = 0; rg < 4; ++rg) { const int d = 32 * db + 8 * rg + 4 * hi; const f32x4 o2 = *(LAS const f32x4*)(xq + d * 4);
#pragma unroll
                    for (int e = 0; e < 4; ++e) { const float v = o[db][4 * rg + e] - lam * o2[e]; o[db][4 * rg + e] = v; ss += v * v; } }
            ss += __shfl_xor(ss, 32);
            const float rn = rsqrtf(ss * (1.0f / 128.0f) + SUBLN_EPS) * 0.8f;
            const bf16_t* zp = Zb + (size_t)qrow * DM + h * 128; bf16_t* op = Ob + (size_t)qrow * DM + h * 128;
#pragma unroll
            for (int db = 0; db < 4; ++db)
#pragma unroll
                for (int rg = 0; rg < 4; ++rg) { const int d = 32 * db + 8 * rg + 4 * hi;
                    const f32x4 gg = *(const f32x4*)(p.subln + d); const u32x2 zz = *(const u32x2*)(zp + d);
                    const float v0 = o[db][4 * rg] * rn * gg[0] * silu_f(bf_lo(zz.x)), v1 = o[db][4 * rg + 1] * rn * gg[1] * silu_f(bf_hi(zz.x));
                    const float v2 = o[db][4 * rg + 2] * rn * gg[2] * silu_f(bf_lo(zz.y)), v3 = o[db][4 * rg + 3] * rn * gg[3] * silu_f(bf_hi(zz.y));
                    u32x2 w; w.x = pk2(v0, v1); w.y = pk2(v2, v3); *(u32x2*)(op + d) = w; }
        }
        BLK_SYNC();
    }
}

constexpr int FT_P = 320, FT_U = 256 * FT_P, FT_UP = 272;
template <int MODE> __device__ __forceinline__ void fft_rows(int unit, int& rbase, int& cc, int& a0, int& a1, int& a2) {
    cc = unit & 7;
    if (MODE == 0) { a0 = unit >> 3; rbase = 0; a1 = 0; a2 = 0; }
    else if (MODE == 1) { a0 = unit >> 7; a1 = (unit >> 3) & 15; rbase = SEQP + a0 * SEQS; a2 = 0; }
    else { if (unit < 1024) { rbase = 0; a0 = unit >> 3; a1 = 128; } else { const int v = unit - 1024; rbase = SEQP + (v >> 7) * SEQS; a0 = (v >> 3) & 15; a1 = 16; } a2 = 0; }
}
template <int MODE> __device__ __forceinline__ const bf16_t* fft_src(const bf16_t* AB, int rbase, int cc, int a0, int a1, int rho, int ch16) {
    if (MODE == 0) return AB + (size_t)(rho * 128 + a0) * 1024 + cc * 128 + ch16 * 8;
    if (MODE == 1) return AB + (size_t)(rbase + (rho & 15) * 128 + a1 * 8 + (rho >> 4)) * 1024 + cc * 128 + ch16 * 8;
    return AB + (size_t)(rbase + a0 * 128 + (rho & 127)) * 2048 + (rho >> 7) * 1024 + cc * 128 + ch16 * 8;
}

template <int MODE> __device__ __forceinline__ void fft_pass(LAS unsigned char* lds, bf16_t* AB, const bf16_t* Z1, bf16_t* FG, int nunits, bf16_t* OUT, const int omask) {
    const int tid = threadIdx.x, lane = tid & 63, wave = __builtin_amdgcn_readfirstlane(tid >> 6), r32 = lane & 31, hi = lane >> 5;
    const int g16 = lane >> 4, i16 = lane & 15, tq = i16 >> 2, tp = i16 & 3;
    const int kb = wave & 3, cbh = wave >> 2;
    bf16x8 Cf[8], Sf[8], Df[2];
    { const int k = 32 * kb + r32;
#pragma unroll
      for (int s = 0; s < 8; ++s) { Cf[s] = *(const bf16x8*)(g_tab128 + k * 128 + 16 * s + 8 * hi); Sf[s] = *(const bf16x8*)(g_tab128 + (128 + k) * 128 + 16 * s + 8 * hi); } }
    if (MODE == 1) {
#pragma unroll
        for (int s = 0; s < 2; ++s) Df[s] = *(const bf16x8*)(g_tab16 + r32 * 32 + 16 * s + 8 * hi);
    }
    int unit = blockIdx.x;
    if (unit >= nunits) return;
    int rbase, cc, a0, a1, a2;
    fft_rows<MODE>(unit, rbase, cc, a0, a1, a2);
    constexpr int NCH = (MODE == 2) ? 8 : 4;
    u32x4 stg[NCH];
#pragma unroll
    for (int i = 0; i < NCH; ++i) { const int c = tid + 512 * i; stg[i] = *(const u32x4*)fft_src<MODE>(AB, rbase, cc, a0, a1, c >> 4, c & 15); }
    __builtin_amdgcn_s_waitcnt(0x0F70);
    for (;;) {
        if (MODE == 2) {
#pragma unroll
            for (int i = 0; i < NCH; ++i) { const int c = tid + 512 * i; *(LAS u32x4*)(lds + (c >> 4) * FT_P + (c & 15) * 16) = stg[i]; }
        } else {
#pragma unroll
            for (int i = 0; i < NCH; ++i) { const int c = tid + 512 * i; *(LAS u32x4*)(lds + FT_U + (c >> 4) * FT_UP + (c & 15) * 16) = stg[i]; }
        }
        BLK_SYNC();
        const int nunit = unit + gridDim.x; const bool has_next = nunit < nunits;
        int nrbase = 0, ncc = 0, na0 = 0, na1 = 0, na2 = 0;
        if (has_next) { fft_rows<MODE>(nunit, nrbase, ncc, na0, na1, na2);
#pragma unroll
            for (int i = 0; i < NCH; ++i) { const int c = tid + 512 * i; stg[i] = *(const u32x4*)fft_src<MODE>(AB, nrbase, ncc, na0, na1, c >> 4, c & 15); } }
        if (MODE != 2) {
#pragma unroll 1
            for (int rbi = 0; rbi < 2; ++rbi) { const int rho = 32 * (2 * cbh + rbi) + r32;
                LAS const unsigned char* up = lds + FT_U + rho * FT_UP + hi * 16;
                f32x16 ya, yb;
#pragma unroll
                for (int r = 0; r < 16; ++r) { ya[r] = 0.f; yb[r] = 0.f; }
#pragma unroll
                for (int s = 0; s < 8; ++s) { const bf16x8 uf = *(LAS const bf16x8*)(up + s * 32); ya = MFMA32(Cf[s], uf, ya); yb = MFMA32(Sf[s], uf, yb); }
                const int rowa = (MODE == 0) ? rho : ((rho >> 4) * 32 + (rho & 15)), rowb = rowa + ((MODE == 0) ? 128 : 16);
                LAS unsigned char* pa = lds + rowa * FT_P + (32 * kb + 4 * hi) * 2; LAS unsigned char* pb = lds + rowb * FT_P + (32 * kb + 4 * hi) * 2;
#pragma unroll
                for (int rg = 0; rg < 4; ++rg) { u32x2 wa, wb; wa.x = pk2(ya[4 * rg], ya[4 * rg + 1]); wa.y = pk2(ya[4 * rg + 2], ya[4 * rg + 3]); wb.x = pk2(yb[4 * rg], yb[4 * rg + 1]); wb.y = pk2(yb[4 * rg + 2], yb[4 * rg + 3]);
                    *(LAS u32x2*)(pa + 16 * rg) = wa; *(LAS u32x2*)(pb + 16 * rg) = wb; }
            }
            BLK_SYNC();
        }
        if (MODE == 0) {
            const int k1 = 32 * kb + r32, n2 = a0;
            const float ph = (float)((k1 * n2) & 16383) * (1.0f / 16384.0f); const float tc = __builtin_amdgcn_cosf(ph), ts = __builtin_amdgcn_sinf(ph);
#pragma unroll 1
            for (int cbi = 0; cbi < 2; ++cbi) { const int cb = 2 * cbh + cbi;
                LAS const unsigned char* ab = lds + (8 * hi + tq) * FT_P + (32 * cb + 16 * (g16 & 1) + 4 * tp) * 2;
                f32x16 yr, yi;
#pragma unroll
                for (int r = 0; r < 16; ++r) { yr[r] = 0.f; yi[r] = 0.f; }
#pragma unroll
                for (int s = 0; s < 8; ++s) {
                    const bf16x8 af = cat8(tr_read(ab + (16 * s) * FT_P), tr_read(ab + (16 * s + 4) * FT_P));
                    const bf16x8 bf = cat8(tr_read(ab + (128 + 16 * s) * FT_P), tr_read(ab + (128 + 16 * s + 4) * FT_P));
                    const bf16x8 naf = neg8(af), nbf = neg8(bf);
                    yr = MFMA32(af, Cf[s], yr); yr = MFMA32(nbf, Sf[s], yr);
                    yi = MFMA32(naf, Sf[s], yi); yi = MFMA32(nbf, Cf[s], yi);
                }
                bf16_t* orow = OUT + (size_t)((k1 * 128 + n2) & omask) * 2048 + cc * 128 + cb * 32 + 4 * hi;
#pragma unroll
                for (int rg = 0; rg < 4; ++rg) { float a[4], b[4];
#pragma unroll
                    for (int e = 0; e < 4; ++e) { const float vr = yr[4 * rg + e], vi = yi[4 * rg + e]; a[e] = vr * tc + vi * ts; b[e] = vi * tc - vr * ts; }
                    u32x2 w0, w1; w0.x = pk2(a[0], a[1]); w0.y = pk2(a[2], a[3]); w1.x = pk2(b[0], b[1]); w1.y = pk2(b[2], b[3]);
                    *(u32x2*)(orow + 8 * rg) = w0; *(u32x2*)(orow + 1024 + 8 * rg) = w1; }
            }
        } else if (MODE == 1) {
            const int k1 = r32 & 15, po = r32 >> 4, n2 = a1 * 8 + wave;
            const float ph = (float)((k1 * n2) & 2047) * (1.0f / 2048.0f); const float tc = __builtin_amdgcn_cosf(ph); float ts = __builtin_amdgcn_sinf(ph); if (po) ts = -ts;
#pragma unroll 1
            for (int cb = 0; cb < 4; ++cb) {
                LAS const unsigned char* ab = lds + (wave * 32 + 8 * hi + tq) * FT_P + (32 * cb + 16 * (g16 & 1) + 4 * tp) * 2;
                f32x16 y;
#pragma unroll
                for (int r = 0; r < 16; ++r) y[r] = 0.f;
                const bf16x8 f0 = cat8(tr_read(ab), tr_read(ab + 4 * FT_P)), f1 = cat8(tr_read(ab + 16 * FT_P), tr_read(ab + 20 * FT_P));
                y = MFMA32(f0, Df[0], y); y = MFMA32(f1, Df[1], y);
                bf16_t* orow = OUT + (size_t)((rbase + k1 * 128 + n2) & omask) * 2048 + po * 1024 + cc * 128 + cb * 32 + 4 * hi;
#pragma unroll
                for (int rg = 0; rg < 4; ++rg) { float a[4];
#pragma unroll
                    for (int e = 0; e < 4; ++e) { const float own = y[4 * rg + e], oth = __shfl_xor(own, 16); a[e] = own * tc + oth * ts; }
                    u32x2 w0; w0.x = pk2(a[0], a[1]); w0.y = pk2(a[2], a[3]); *(u32x2*)(orow + 8 * rg) = w0; }
            }
        } else {
            const int k2 = 32 * kb + r32, k1 = a0, N1 = a1; const float nrm = (N1 == 128) ? 6.905339660024879e-4f : 1.953125e-3f;
            const size_t orow_i = (size_t)(rbase + k1 + N1 * k2);
#pragma unroll 1
            for (int cbi = 0; cbi < 2; ++cbi) { const int cb = 2 * cbh + cbi;
                LAS const unsigned char* ab = lds + (8 * hi + tq) * FT_P + (32 * cb + 16 * (g16 & 1) + 4 * tp) * 2;
                f32x16 y;
#pragma unroll
                for (int r = 0; r < 16; ++r) y[r] = 0.f;
#pragma unroll
                for (int s = 0; s < 8; ++s) {
                    const bf16x8 af = cat8(tr_read(ab + (16 * s) * FT_P), tr_read(ab + (16 * s + 4) * FT_P));
                    const bf16x8 bf = cat8(tr_read(ab + (128 + 16 * s) * FT_P), tr_read(ab + (128 + 16 * s + 4) * FT_P));
                    y = MFMA32(af, Cf[s], y); y = MFMA32(bf, Sf[s], y);
                }
                const bf16_t* zrow = Z1 + orow_i * DM + cc * 128 + cb * 32 + 4 * hi; bf16_t* orow = FG + orow_i * DM + cc * 128 + cb * 32 + 4 * hi;
#pragma unroll
                for (int rg = 0; rg < 4; ++rg) { const u32x2 zz = *(const u32x2*)(zrow + 8 * rg);
                    const float v0 = y[4 * rg] * nrm * silu_f(bf_lo(zz.x)), v1 = y[4 * rg + 1] * nrm * silu_f(bf_hi(zz.x));
                    const float v2 = y[4 * rg + 2] * nrm * silu_f(bf_lo(zz.y)), v3 = y[4 * rg + 3] * nrm * silu_f(bf_hi(zz.y));
                    u32x2 w; w.x = pk2(v0, v1); w.y = pk2(v2, v3); *(u32x2*)(orow + 8 * rg) = w; }
            }
        }
        BLK_SYNC();
        if (!has_next) break;
        unit = nunit; rbase = nrbase; cc = ncc; a0 = na0; a1 = na1; a2 = na2;
    }
}

#ifndef PROBE
#define PROBE 0
#endif
#ifndef PHM
#define PHM 0xffff
#endif
__global__ void __launch_bounds__(NTHR, 2) fwd_kernel(Params p) {
    extern __shared__ __attribute__((aligned(16))) unsigned char lds_raw[];
    LAS unsigned char* lds = (LAS unsigned char*)lds_raw;
    cg::grid_group grid = cg::this_grid();
    if (threadIdx.x < 4) ((LAS unsigned*)(lds + XB_LDS_OFF))[threadIdx.x] = 0u;
    __syncthreads();
    XcdBarrier xbar0; xbar0.bar = p.bar; xbar0.x = 0; xbar0.st = (volatile LAS unsigned*)(lds + XB_LDS_OFF);
    if (p.bar) xbar0 = xcd_barrier_post(p.bar, (volatile LAS unsigned*)(lds + XB_LDS_OFF));
    const size_t REG = (size_t)MTOT * DM;
    bf16_t* R0 = (bf16_t*)p.ws; bf16_t* R1 = R0 + REG; bf16_t* R2 = R1 + REG; bf16_t* R3 = R2 + REG;
    bf16_t* XB = (bf16_t*)p.out;

    if (PHM & 1) phase0(p, lds, XB);
#if PROBE & 4
    phase0(p, lds, XB);
#endif

    XcdBarrier xbar;
    if (p.bar) { xbar = xbar0; xcd_barrier(xbar); }
    else { grid.sync(); xbar = xcd_barrier_post(g_bar, (volatile LAS unsigned*)(lds + XB_LDS_OFF)); }
#if PROBE & 16
    xcd_barrier(xbar); xcd_barrier(xbar); xcd_barrier(xbar); xcd_barrier(xbar); xcd_barrier(xbar); xcd_barrier(xbar); xcd_barrier(xbar); xcd_barrier(xbar);
#endif
    if (PHM & 2) {
        pg8::Gemm gm{XB, g_w0t, MTOT, 4096, 1024, 1024, 1024}; pg8::StaticOrder S; S.init(MTOT, 4096, gridDim.x, blockIdx.x);
        EpiRowBf16 E{R0, R1, R2, R3, DM, DM, 1024, g_r0, 0, QSCALE, g_nrm};
        pg8::gemm_phase<EpiRowBf16, pg8::StaticOrder, true, true>(lds, gm, S, E);
#if PROBE & 1
        pg8::gemm_phase<EpiRowBf16, pg8::StaticOrder, true, true>(lds, gm, S, E);
#endif
    }
    xcd_barrier(xbar);
#if PROBE & 2
    attn_phase(p, lds, R0, R1, R2, R3, (bf16_t*)p.out + REG, &g_ctr[1]);
#endif
    if (PHM & 4) attn_phase(p, lds, R0, R1, R2, R3, R0, &g_ctr[0]);
    xcd_barrier(xbar);
    if (PHM & 8) {
        pg8::Gemm gm{R0, g_wo0t, MTOT, 1024, 1024, 1024, 1024}; pg8::StaticOrder S; S.init(MTOT, 1024, gridDim.x, blockIdx.x);
        EpiResid E{p.xp, p.xs, p.out, R3, g_ss1};
        pg8::gemm_phase<EpiResid, pg8::StaticOrder, true, true>(lds, gm, S, E);
#if PROBE & 1
        { EpiResid E2{p.xp, p.xs, p.out, R3, g_r0}; pg8::gemm_phase<EpiResid, pg8::StaticOrder, true, true>(lds, gm, S, E2); }
#endif
    }
    xcd_barrier(xbar);
    if (PHM & 16) {
        pg8::Gemm gm{R3, g_w1t, MTOT, 2048, 1024, 1024, 1024}; pg8::StaticOrder S; S.init(MTOT, 2048, gridDim.x, blockIdx.x);
        EpiRowBf16 E{R0, R1, R1, R1, DM, DM, 1024, g_ss1, 1, 1.0f, nullptr};
        pg8::gemm_phase<EpiRowBf16, pg8::StaticOrder, true, true>(lds, gm, S, E);
#if PROBE & 1
        pg8::gemm_phase<EpiRowBf16, pg8::StaticOrder, true, true>(lds, gm, S, E);
#endif
    }
    xcd_barrier(xbar);
    if (PHM & 32) fft_pass<0>(lds, R0, nullptr, nullptr, 1024, R2, 0x7fffffff);
    if (PHM & 64) fft_pass<1>(lds, R0, nullptr, nullptr, 1024, R2, 0x7fffffff);
    xcd_barrier(xbar);
    if (PHM & 128) fft_pass<2>(lds, R2, R1, R0, 2048, nullptr, 0);
    xcd_barrier(xbar);
    if (PHM & 256) {
        pg8::Gemm gm{R0, g_wo1t, MTOT, 1024, 1024, 1024, 1024}; pg8::StaticOrder S; S.init(MTOT, 1024, gridDim.x, blockIdx.x);
        EpiResid E{p.out, p.out + (size_t)SEQP * DM, p.out, nullptr, g_ss2};
        pg8::gemm_phase<EpiResid, pg8::StaticOrder, true, true>(lds, gm, S, E);
    }
    xcd_barrier(xbar);
    const int lane = threadIdx.x & 63, wave = threadIdx.x >> 6;
    for (int row = blockIdx.x * 8 + wave; row < MTOT; row += gridDim.x * 8) {
        const float rs = rsqrtf(g_ss2[row] * (1.0f / 1024.0f) + EPS); float* orow = p.out + (size_t)row * DM;
#pragma unroll
        for (int i = 0; i < 4; ++i) { const int c = 4 * (lane + 64 * i); f32x4 v = *(const f32x4*)(orow + c); const f32x4 gg = *(const f32x4*)(p.final_norm + c);
            v[0] *= rs * gg[0]; v[1] *= rs * gg[1]; v[2] *= rs * gg[2]; v[3] *= rs * gg[3]; *(f32x4*)(orow + c) = v; }
    }
}

extern "C" void kernel_launch(void* const* d_in, const int* in_sizes, int n_in, void* d_out, int out_size, void* d_ws, size_t ws_size, hipStream_t stream) {
    static int grid = 0;
    if (grid == 0) {
        int dev = 0, cus = 0, per_cu = 0;
        if (n_in != 14 || ws_size < (size_t)4 * MTOT * DM * 2) { fprintf(stderr, "kernel_launch: unexpected problem shape (n_in %d, ws %zu)\n", n_in, ws_size); grid = -1; return; }
        hipGetDevice(&dev); hipDeviceGetAttribute(&cus, hipDeviceAttributeMultiprocessorCount, dev);
        if (hipFuncSetAttribute((const void*)fwd_kernel, hipFuncAttributeMaxDynamicSharedMemorySize, LDS_TOTAL) != hipSuccess) { fprintf(stderr, "kernel_launch: hipFuncSetAttribute failed\n"); grid = -1; return; }
        if (hipOccupancyMaxActiveBlocksPerMultiprocessor(&per_cu, (const void*)fwd_kernel, NTHR, LDS_TOTAL) != hipSuccess || per_cu < 1) { fprintf(stderr, "kernel_launch: occupancy query says %d blocks per CU\n", per_cu); per_cu = 1; }
        (void)hipGetLastError();
        grid = cus * 1;
    }
    if (grid < 0) return;
    Params p{};
    const size_t WS_MAP = (size_t)4 * MTOT * DM * 2;
    if (ws_size >= WS_MAP + sizeof(unsigned) * XCD_BAR_WORDS) {
        p.bar = (unsigned*)((unsigned char*)d_ws + WS_MAP);
        if (hipMemsetAsync(p.bar, 0, sizeof(unsigned) * XCD_BAR_WORDS, stream) != hipSuccess) { fprintf(stderr, "kernel_launch: barrier memset failed\n"); return; }
    }
    p.xp = (const float*)d_in[0]; p.xs = (const float*)d_in[1]; p.attn_norm = (const float*)d_in[2]; p.w_in0 = (const float*)d_in[3];
    p.lq1 = (const float*)d_in[4]; p.lk1 = (const float*)d_in[5]; p.lq2 = (const float*)d_in[6]; p.lk2 = (const float*)d_in[7];
    p.subln = (const float*)d_in[8]; p.w_out0 = (const float*)d_in[9]; p.fnet_norm = (const float*)d_in[10]; p.w_in1 = (const float*)d_in[11];
    p.w_out1 = (const float*)d_in[12]; p.final_norm = (const float*)d_in[13];
    p.out = (float*)d_out; p.ws = (unsigned char*)d_ws;
    void* args[] = {&p};
    const hipError_t e = hipLaunchCooperativeKernel((const void*)fwd_kernel, dim3(grid), dim3(NTHR), args, LDS_TOTAL, stream);
    if (e != hipSuccess) fprintf(stderr, "kernel_launch: cooperative launch failed: %s (grid %d)\n", hipGetErrorString(e), grid);
}
```
